# Optimizing an MI355X kernel written in HIP

```python
import math
import jax, jax.numpy as jnp
from jax import lax
import numpy as np

D_MODEL = 1024
BATCH = 8
SEQ = 4096
DEPTH = 1

CONV_C = 1024
CONV_W = 31
FOX_HEADS = 16
FOX_HD = 64
FOX_W = FOX_HEADS * FOX_HD
Q_BLOCK = 128
IN_SPLITS = (CONV_C, CONV_C, FOX_W, FOX_W, FOX_W, FOX_HEADS, D_MODEL, D_MODEL)
IN_COLS = sum(IN_SPLITS)
PEER_HEADS = 8
PEER_NKEYS = 128
PEER_EXPERTS = PEER_NKEYS * PEER_NKEYS
PEER_DK = 256
PEER_TOPK = 16
PEER_CHUNK = 128
EPS = 1e-6
NEG = -1e30

kernel_name = "hybrid_conv_fox_peer_block"


def rmsnorm(x, g):
    xf = x.astype(jnp.float32)
    y = xf * lax.rsqrt(jnp.mean(xf * xf, axis=-1, keepdims=True) + EPS)
    return (y * g.astype(jnp.float32)).astype(x.dtype)


def layernorm(x, g, b):
    xf = x.astype(jnp.float32)
    mu = jnp.mean(xf, axis=-1, keepdims=True)
    var = jnp.mean(jnp.square(xf - mu), axis=-1, keepdims=True)
    y = (xf - mu) * lax.rsqrt(var + EPS)
    return (y * g.astype(jnp.float32) + b.astype(jnp.float32)).astype(x.dtype)


def conformer_conv(z_val, z_gate, conv_w, conv_b, ln_g, ln_b, w_conv_out):
    z = z_val * jax.nn.sigmoid(z_gate)
    z = lax.conv_general_dilated(
        z, conv_w[:, None, :].astype(z.dtype), window_strides=(1,),
        padding=[(CONV_W - 1, 0)], dimension_numbers=("NWC", "WIO", "NWC"),
        feature_group_count=CONV_C) + conv_b
    z = layernorm(z, ln_g, ln_b)
    z = z * jax.nn.sigmoid(z)
    return z @ w_conv_out


def forgetting_attention(q, k, v, c):
    B, H, S, hd = q.shape
    nb = S // Q_BLOCK
    scale = 1.0 / math.sqrt(hd)
    qb = q.reshape(B, H, nb, Q_BLOCK, hd).transpose(2, 0, 1, 3, 4)
    cb = c.reshape(B, H, nb, Q_BLOCK).transpose(2, 0, 1, 3)
    kf = k.astype(jnp.float32)
    vf = v.astype(jnp.float32)
    kpos = jnp.arange(S)

    def one_block(args):
        qi, ci, i = args
        s = jnp.einsum("bhqd,bhkd->bhqk", qi.astype(jnp.float32), kf) * scale
        s = s + ci[..., :, None] - c[:, :, None, :]
        qpos = i * Q_BLOCK + jnp.arange(Q_BLOCK)
        mask = kpos[None, :] <= qpos[:, None]
        p = jax.nn.softmax(jnp.where(mask, s, NEG), axis=-1)
        return jnp.einsum("bhqk,bhkd->bhqd", p, vf)

    out = lax.map(one_block, (qb, cb, jnp.arange(nb)))
    return out.transpose(1, 2, 0, 3, 4).reshape(B, H, S, hd).astype(q.dtype)


def peer_ffn(h, peer_wq, peer_k1, peer_k2, peer_u, peer_v):
    B, S, D = h.shape
    T = B * S
    ht = h.reshape(T, D)
    q = (ht @ peer_wq).reshape(T, PEER_HEADS, PEER_DK).astype(jnp.float32)
    half = PEER_DK // 2
    s1 = jnp.einsum("thd,hnd->thn", q[..., :half], peer_k1.astype(jnp.float32))
    s2 = jnp.einsum("thd,hnd->thn", q[..., half:], peer_k2.astype(jnp.float32))
    v1, i1 = lax.top_k(s1, PEER_TOPK)
    v2, i2 = lax.top_k(s2, PEER_TOPK)
    cand = (v1[..., :, None] + v2[..., None, :]).reshape(T, PEER_HEADS, PEER_TOPK * PEER_TOPK)
    sc, pos = lax.top_k(cand, PEER_TOPK)
    e1 = jnp.take_along_axis(i1, pos // PEER_TOPK, axis=-1)
    e2 = jnp.take_along_axis(i2, pos % PEER_TOPK, axis=-1)
    experts = (e1 * PEER_NKEYS + e2).reshape(T, PEER_HEADS * PEER_TOPK)
    gates = jax.nn.softmax(sc, axis=-1).reshape(T, PEER_HEADS * PEER_TOPK)
    nc = T // PEER_CHUNK

    def chunk(args):
        hc, ec, gc = args
        u = peer_u[ec]
        a = jax.nn.gelu(jnp.einsum("ckd,cd->ck", u, hc).astype(jnp.float32)) * gc
        vv = peer_v[ec]
        return jnp.einsum("ck,ckd->cd", a.astype(vv.dtype), vv)

    out = lax.map(chunk, (ht.reshape(nc, PEER_CHUNK, D),
                          experts.reshape(nc, PEER_CHUNK, -1),
                          gates.reshape(nc, PEER_CHUNK, -1)))
    return out.reshape(B, S, D).astype(h.dtype)


def setup_inputs(seed: int = 0) -> dict:
    key = jax.random.key(seed)
    ks = jax.random.split(key, 20)
    f32 = jnp.float32
    D = D_MODEL
    nrm = lambda k, shape, s: jax.random.normal(k, shape, f32) * s
    return {
        "x": nrm(ks[0], (BATCH, SEQ, D), 1.0),
        "norm1_g": 1.0 + nrm(ks[1], (D,), 0.02),
        "w_in": nrm(ks[2], (D, IN_COLS), D ** -0.5),
        "conv_w": nrm(ks[3], (CONV_W, CONV_C), CONV_W ** -0.5),
        "conv_b": nrm(ks[4], (CONV_C,), 0.02),
        "conv_ln_g": 1.0 + nrm(ks[5], (CONV_C,), 0.02),
        "conv_ln_b": nrm(ks[6], (CONV_C,), 0.02),
        "w_conv_out": nrm(ks[7], (CONV_C, D), CONV_C ** -0.5),
        "fox_bf": 1.0 + 4.0 * jax.random.uniform(ks[8], (FOX_HEADS,), f32),
        "w_fox_out": nrm(ks[9], (FOX_W, D), FOX_W ** -0.5),
        "w_out": nrm(ks[10], (D, D), D ** -0.5),
        "norm2_g": 1.0 + nrm(ks[11], (D,), 0.02),
        "peer_wq": nrm(ks[12], (D, PEER_HEADS * PEER_DK), D ** -0.5),
        "peer_k1": nrm(ks[13], (PEER_HEADS, PEER_NKEYS, PEER_DK // 2), (PEER_DK // 2) ** -0.5),
        "peer_k2": nrm(ks[14], (PEER_HEADS, PEER_NKEYS, PEER_DK // 2), (PEER_DK // 2) ** -0.5),
        "peer_u": nrm(ks[15], (PEER_EXPERTS, D), D ** -0.5),
        "peer_v": nrm(ks[16], (PEER_EXPERTS, D), PEER_HEADS ** -0.5),
        "normf_g": 1.0 + nrm(ks[17], (D,), 0.02),
    }


def reference(x, norm1_g, w_in, conv_w, conv_b, conv_ln_g, conv_ln_b, w_conv_out,
              fox_bf, w_fox_out, w_out, norm2_g, peer_wq, peer_k1, peer_k2,
              peer_u, peer_v, normf_g):
    B, S, D = x.shape
    idx = np.cumsum(IN_SPLITS)[:-1].tolist()
    for _ in range(DEPTH):
        h = rmsnorm(x, norm1_g)
        z = h @ w_in
        a_val, a_gate, q, k, v, f_logit, g_a, g_b = jnp.split(z, idx, axis=-1)
        ya = conformer_conv(a_val, a_gate, conv_w, conv_b, conv_ln_g, conv_ln_b, w_conv_out)
        heads = lambda t: t.reshape(B, S, FOX_HEADS, FOX_HD).transpose(0, 2, 1, 3)
        log_f = jax.nn.log_sigmoid(f_logit.astype(jnp.float32) + fox_bf.astype(jnp.float32))
        c = jnp.cumsum(log_f, axis=1).transpose(0, 2, 1)
        ob = forgetting_attention(heads(q), heads(k), heads(v), c)
        yb = ob.transpose(0, 2, 1, 3).reshape(B, S, FOX_W) @ w_fox_out
        mix = (jax.nn.sigmoid(g_a) * ya + jax.nn.sigmoid(g_b) * yb) @ w_out
        x = x + mix
        x = x + peer_ffn(rmsnorm(x, norm2_g), peer_wq, peer_k1, peer_k2, peer_u, peer_v)
    return rmsnorm(x, normf_g)
```

```cpp
#include <hip/hip_runtime.h>
#include <hip/hip_bf16.h>
#include <cstdio>
#include <cstdint>
#include <cmath>
namespace pg8 {
#define PG8_LAS __attribute__((address_space(3)))
typedef unsigned short bf16_t;
typedef short bf16x8 __attribute__((ext_vector_type(8)));
typedef float f32x4 __attribute__((ext_vector_type(4)));
typedef unsigned u32x4 __attribute__((ext_vector_type(4)));
constexpr int BM = 256, BK = 64, HALF = 128, HTB = HALF * BK * 2  , STAGE_BYTES = 8 * HTB, NXCD = 8, WGM = 8;

__host__ __device__ __forceinline__ int lds_byte(int r, int c) { const int st = (r >> 4) * 2 + (c >> 5), rr = r & 15, cc = c & 31, ob = rr * 64 + cc * 2; return st * 1024 + (ob ^ (((ob >> 9) & 1) << 5)); }
__host__ __device__ __forceinline__ void stage_rc(int b, int& R, int& C) { const int st = b / 1024, sb = b % 1024, swz = sb ^ (((sb >> 9) & 1) << 5); R = (st >> 1) * 16 + swz / 64; C = (st & 1) * 32 + (swz % 64) / 2; }
__host__ __device__ __forceinline__ int perm32(int rho) { const int n = rho >> 4, i = rho & 15; return 8 * (i >> 2) + 4 * n + (i & 3); }

struct Unit { int pm, pn, seg; };
struct Gemm { const bf16_t *A0, *A1, *B0, *B1; int M, N, K; };

struct StaticOrder {
    int nM, nN, nwg, G, c;
    __host__ __device__ __forceinline__ void init(int M, int N, int G_, int c_) { nM = M / BM; nN = N / BM; nwg = nM * nN; G = G_; c = c_; }
    __host__ __device__ __forceinline__ bool next(int i, Unit& u) const {
        const long L = (long)i * G + c; if (L >= nwg) return false;
        int wgid = (int)L; { const int q = nwg / NXCD, r = nwg % NXCD, xcd = wgid % NXCD, off = wgid / NXCD; wgid = (xcd < r ? xcd * (q + 1) : r * (q + 1) + (xcd - r) * q) + off; }
        const int nig = WGM * nN, gid = wgid / nig, fm = gid * WGM, gsz = (nM - fm) < WGM ? (nM - fm) : WGM;
        u.pm = fm + ((wgid % nig) % gsz); u.pn = (wgid % nig) / gsz; u.seg = 0; return true;
    }
    __device__ __forceinline__ void a_ready(const Unit&) const {}
    __device__ __forceinline__ void done(const Unit&) const {}
};

__device__ __forceinline__ unsigned cvt_pk_bf16(float lo, float hi) { unsigned r; asm volatile("v_cvt_pk_bf16_f32 %0, %1, %2" : "=v"(r) : "v"(lo), "v"(hi)); return r; }
typedef float f32x2 __attribute__((ext_vector_type(2)));
__device__ __forceinline__ f32x2 gelu_pk(f32x2 v) {
    const f32x2 av = __builtin_elementwise_abs(v), d = av * 0.2316418882f + 1.0f;
    f32x2 t; t.x = __builtin_amdgcn_rcpf(d.x); t.y = __builtin_amdgcn_rcpf(d.y);
    f32x2 q = t * 0.5307027145f + (-0.7265760135f); q = q * t + 0.7107068705f; q = q * t + (-0.142248368f); q = q * t + 0.127414796f; q = q * t;
    const f32x2 s = (v * v) * (-0.72134752044f);
    f32x2 e; e.x = __builtin_amdgcn_exp2f(s.x); e.y = __builtin_amdgcn_exp2f(s.y);
    const f32x2 m = v * (q * e), r = v - m;
    f32x2 o; o.x = v.x < 0.f ? m.x : r.x; o.y = v.y < 0.f ? m.y : r.y; return o;
}

template <int ACT  > struct EpiBf16 {
    static constexpr bool PERM = true, AFTER_DRAIN = false; static_assert(ACT == 0 || ACT == 1, "EpiBf16: ACT is 0 (none) or 1 (gelu_pk)");
    bf16_t* O; int ldc; const float* bias; int split_cols; size_t split_stride; float scale0;
    __device__ __forceinline__ void operator()(const f32x4 (&acc)[2][2][4][2], const Unit& u, int wr, int wc, int fr, int fq) const {
        const int row0 = u.pm * BM + wr * 64 + fr; int colt = u.pn * BM; bf16_t* base = O;
        float sc = 1.f; if (split_cols) { const int t = colt / split_cols; base += (size_t)t * split_stride; colt -= t * split_cols; if (t == 0) sc = scale0; }
        const int col0 = colt + wc * 32 + 8 * fq, bcol0 = u.pn * BM + wc * 32 + 8 * fq;
        f32x4 bv[2][2];
#pragma unroll
        for (int bj = 0; bj < 2; ++bj)
#pragma unroll
            for (int n = 0; n < 2; ++n) bv[bj][n] = bias ? *(const f32x4*)(bias + bcol0 + bj * HALF + 4 * n) : (f32x4){0.f, 0.f, 0.f, 0.f};
#pragma unroll
        for (int ai = 0; ai < 2; ++ai)
#pragma unroll
            for (int m = 0; m < 4; ++m) { bf16_t* rowp = base + (size_t)(row0 + ai * HALF + m * 16) * ldc + col0;
#pragma unroll
                for (int bj = 0; bj < 2; ++bj) { f32x4 v0 = acc[ai][bj][m][0] + bv[bj][0], v1 = acc[ai][bj][m][1] + bv[bj][1];
                    if (ACT == 1) { f32x2 a = gelu_pk((f32x2){v0[0], v0[1]}), b = gelu_pk((f32x2){v0[2], v0[3]}), c = gelu_pk((f32x2){v1[0], v1[1]}), d = gelu_pk((f32x2){v1[2], v1[3]});
                        v0 = (f32x4){a.x, a.y, b.x, b.y}; v1 = (f32x4){c.x, c.y, d.x, d.y}; }
                    v0 = v0 * sc; v1 = v1 * sc; u32x4 w; w.x = cvt_pk_bf16(v0[0], v0[1]); w.y = cvt_pk_bf16(v0[2], v0[3]); w.z = cvt_pk_bf16(v1[0], v1[1]); w.w = cvt_pk_bf16(v1[2], v1[3]);
                    *(u32x4*)(rowp + bj * HALF) = w; } }
    }
};

struct PanelStats {
    unsigned* xbuf;
    unsigned* cnt;
    unsigned* tmo;
    int ntn; float eps;
    unsigned code;
    __device__ __forceinline__ bool run(const f32x4 (&v)[2][2][4][2], const Unit& u, int wr, int wc, int fr, int fq, PG8_LAS unsigned char* lds, int wid, int lane) const {
        typedef float f32x2v __attribute__((ext_vector_type(2)));
        PG8_LAS f32x2v* P = (PG8_LAS f32x2v*)lds;
        PG8_LAS f32x2v* S = (PG8_LAS f32x2v*)(lds + 8192);
        PG8_LAS unsigned* flag = (PG8_LAS unsigned*)(lds + 8192 + 2048);
#pragma unroll
        for (int ai = 0; ai < 2; ++ai)
#pragma unroll
            for (int m = 0; m < 4; ++m) {
                float s = 0.f;
#pragma unroll
                for (int bj = 0; bj < 2; ++bj)
#pragma unroll
                    for (int n = 0; n < 2; ++n) { const f32x4 x = v[ai][bj][m][n]; s += (x[0] + x[1]) + (x[2] + x[3]); }
                s += __shfl_xor(s, 16); s += __shfl_xor(s, 32);
                const float mw = s * (1.0f / 64.0f); float q = 0.f;
#pragma unroll
                for (int bj = 0; bj < 2; ++bj)
#pragma unroll
                    for (int n = 0; n < 2; ++n) { const f32x4 d = v[ai][bj][m][n] - mw; q += (d[0] * d[0] + d[1] * d[1]) + (d[2] * d[2] + d[3] * d[3]); }
                q += __shfl_xor(q, 16); q += __shfl_xor(q, 32);
                if (fq == 0) P[(ai * HALF + wr * 64 + m * 16 + fr) * 4 + wc] = (f32x2v){mw, q};
            }
        asm volatile("s_waitcnt lgkmcnt(0)" ::: "memory"); __builtin_amdgcn_s_barrier(); asm volatile("" ::: "memory");
#if defined(BROKEN_EXCHANGE_NO_WAIT)
#warning BROKEN CONTROL BUILD: the row-statistics exchange does not wait; results are wrong by design
        if (blockIdx.x >= 64) { const long long t0_ = clock64(); while (clock64() - t0_ < 60000) __builtin_amdgcn_s_sleep(8); }
#endif
        const int row = wid * 32 + (lane & 31);
        if (lane < 32) {
            const f32x2v a = P[row * 4 + 0], b = P[row * 4 + 1], c = P[row * 4 + 2], d = P[row * 4 + 3];
            const float mt = (a.x + b.x + c.x + d.x) * 0.25f;
            const float da = a.x - mt, db = b.x - mt, dc = c.x - mt, dd = d.x - mt;
            const float m2 = (a.y + b.y) + (c.y + d.y) + 64.0f * ((da * da + db * db) + (dc * dc + dd * dd));
            unsigned long long* slot = (unsigned long long*)xbuf + ((size_t)(u.pm * BM + row) * 4 + u.pn);
            __hip_atomic_store(slot, ((unsigned long long)__float_as_uint(m2) << 32) | __float_as_uint(mt), __ATOMIC_RELAXED, __HIP_MEMORY_SCOPE_AGENT);
        }
        asm volatile("s_waitcnt vmcnt(0)" ::: "memory");
        if (lane == 0) __hip_atomic_fetch_add(cnt + 64 * u.pm, 1u, __ATOMIC_RELAXED, __HIP_MEMORY_SCOPE_AGENT);
        if (wid == 0) {
            bool dead = false; const unsigned long long t0 = __builtin_amdgcn_s_memrealtime(); const unsigned want = 8u * (unsigned)ntn;
            for (;;) {
#if defined(BROKEN_EXCHANGE_NO_WAIT)
                break;
#endif
                if ((unsigned)__builtin_amdgcn_readfirstlane(__hip_atomic_load(cnt + 64 * u.pm, __ATOMIC_RELAXED, __HIP_MEMORY_SCOPE_AGENT)) >= want) break;
                if (__builtin_amdgcn_s_memrealtime() - t0 > 2000000ull) {
                    if (lane == 0) { unsigned expect = 0u; __hip_atomic_compare_exchange_strong(tmo + 1, &expect, code | (unsigned)(u.pm & 0xff), __ATOMIC_RELAXED, __ATOMIC_RELAXED, __HIP_MEMORY_SCOPE_AGENT);
                                     __hip_atomic_store(tmo, 1u, __ATOMIC_RELAXED, __HIP_MEMORY_SCOPE_AGENT); }
                    dead = true; break; }
                __builtin_amdgcn_s_sleep(2);
            }
            __builtin_amdgcn_fence(__ATOMIC_ACQUIRE, "agent");
            if (lane == 0) flag[0] = dead ? 1u : 0u;
        }
        asm volatile("s_waitcnt vmcnt(0) lgkmcnt(0)" ::: "memory"); __builtin_amdgcn_s_barrier(); asm volatile("" ::: "memory");
        const bool bad = flag[0] != 0u;
        if (lane < 32) {
            const unsigned long long* slot = (const unsigned long long*)xbuf + (size_t)(u.pm * BM + row) * 4; float mt[4], m2[4]; float ms = 0.f;
#pragma unroll
            for (int t = 0; t < 4; ++t) { if (t < ntn) { const unsigned long long w = __hip_atomic_load(slot + t, __ATOMIC_RELAXED, __HIP_MEMORY_SCOPE_AGENT); mt[t] = __uint_as_float((unsigned)w); m2[t] = __uint_as_float((unsigned)(w >> 32)); } else { mt[t] = 0.f; m2[t] = 0.f; } ms += mt[t]; }
            const float mean = ms / (float)ntn; float q = 0.f;
#pragma unroll
            for (int t = 0; t < 4; ++t) if (t < ntn) { const float dm = mt[t] - mean; q += m2[t] + 256.0f * dm * dm; }
            S[row] = (f32x2v){mean, 1.0f / sqrtf(q / (256.0f * (float)ntn) + eps)};
        }
        asm volatile("s_waitcnt lgkmcnt(0)" ::: "memory"); __builtin_amdgcn_s_barrier(); asm volatile("" ::: "memory");
        return bad;
    }
};
struct EpiLnRes {
    static constexpr bool PERM = false, AFTER_DRAIN = true;
    const float* base; float* out; int ldc; const float* bias; PanelStats st; unsigned poison;
    __device__ __forceinline__ void fused(f32x4 (&acc)[2][2][4][2], const Unit& u, int wr, int wc, int fr, int fq, PG8_LAS unsigned char* lds, int wid, int lane) const {
        typedef float f32x2v __attribute__((ext_vector_type(2)));
        const PG8_LAS f32x2v* S = (const PG8_LAS f32x2v*)(lds + 8192);
        const int col0 = u.pn * BM + wc * 32 + 4 * fq;
#pragma unroll
        for (int bj = 0; bj < 2; ++bj)
#pragma unroll
            for (int n = 0; n < 2; ++n) { const f32x4 bv = bias ? *(const f32x4*)(bias + col0 + bj * HALF + n * 16) : (f32x4){0.f, 0.f, 0.f, 0.f};
#pragma unroll
                for (int ai = 0; ai < 2; ++ai)
#pragma unroll
                    for (int m = 0; m < 4; ++m) acc[ai][bj][m][n] += bv; }
        f32x4 pre[4][2][2];
#pragma unroll
        for (int m = 0; m < 4; ++m) { const size_t off = (size_t)(u.pm * BM + wr * 64 + m * 16 + fr) * ldc + col0;
#pragma unroll
            for (int bj = 0; bj < 2; ++bj)
#pragma unroll
                for (int n = 0; n < 2; ++n) pre[m][bj][n] = *(const f32x4*)(base + off + bj * HALF + n * 16); }
        const bool bad = st.run(acc, u, wr, wc, fr, fq, lds, wid, lane) || poison != 0u;
        const float qnan = __builtin_nanf("");
#pragma unroll
        for (int ai = 0; ai < 2; ++ai)
#pragma unroll
            for (int m = 0; m < 4; ++m) { const int r = ai * HALF + wr * 64 + m * 16 + fr; const f32x2v sr = S[r]; const size_t off = (size_t)(u.pm * BM + r) * ldc + col0;
#pragma unroll
                for (int bj = 0; bj < 2; ++bj)
#pragma unroll
                    for (int n = 0; n < 2; ++n) { const f32x4 bs = ai == 0 ? pre[m][bj][n] : *(const f32x4*)(base + off + bj * HALF + n * 16); f32x4 o = bs + (acc[ai][bj][m][n] - sr.x) * sr.y;
                        if (bad) o = (f32x4){qnan, qnan, qnan, qnan}; *(f32x4*)(out + off + bj * HALF + n * 16) = o; }
                if (m & 1) asm volatile("" ::: "memory"); }
    }
};
struct EpiLnResLn {
    static constexpr bool PERM = false, AFTER_DRAIN = true;
    const float* base; float* out; bf16_t* xn; int ldc; const float* bias; PanelStats st1, st2; unsigned poison;
    __device__ __forceinline__ void fused(f32x4 (&acc)[2][2][4][2], const Unit& u, int wr, int wc, int fr, int fq, PG8_LAS unsigned char* lds, int wid, int lane) const {
        typedef float f32x2v __attribute__((ext_vector_type(2))); typedef unsigned u32x2v __attribute__((ext_vector_type(2)));
        const PG8_LAS f32x2v* S = (const PG8_LAS f32x2v*)(lds + 8192);
        const int col0 = u.pn * BM + wc * 32 + 4 * fq;
#pragma unroll
        for (int bj = 0; bj < 2; ++bj)
#pragma unroll
            for (int n = 0; n < 2; ++n) { const f32x4 bv = bias ? *(const f32x4*)(bias + col0 + bj * HALF + n * 16) : (f32x4){0.f, 0.f, 0.f, 0.f};
#pragma unroll
                for (int ai = 0; ai < 2; ++ai)
#pragma unroll
                    for (int m = 0; m < 4; ++m) acc[ai][bj][m][n] += bv; }
        bool bad = st1.run(acc, u, wr, wc, fr, fq, lds, wid, lane) || poison != 0u;
        const float qnan = __builtin_nanf("");
#pragma unroll
        for (int ai = 0; ai < 2; ++ai)
#pragma unroll
            for (int m = 0; m < 4; ++m) { const int r = ai * HALF + wr * 64 + m * 16 + fr; const f32x2v sr = S[r]; const size_t off = (size_t)(u.pm * BM + r) * ldc + col0;
#pragma unroll
                for (int bj = 0; bj < 2; ++bj)
#pragma unroll
                    for (int n = 0; n < 2; ++n) { const f32x4 bs = *(const f32x4*)(base + off + bj * HALF + n * 16); acc[ai][bj][m][n] = bs + (acc[ai][bj][m][n] - sr.x) * sr.y; }
                asm volatile("" : "+v"(acc[ai][0][m][0]), "+v"(acc[ai][0][m][1]), "+v"(acc[ai][1][m][0]), "+v"(acc[ai][1][m][1]));
                if (m & 1) asm volatile("" ::: "memory"); }
        const bool bad1 = bad;
        bad = st2.run(acc, u, wr, wc, fr, fq, lds, wid, lane) || bad;
#pragma unroll
        for (int ai = 0; ai < 2; ++ai)
#pragma unroll
            for (int m = 0; m < 4; ++m) { const int r = ai * HALF + wr * 64 + m * 16 + fr; const f32x2v sr = S[r]; const size_t off = (size_t)(u.pm * BM + r) * ldc + col0;
#pragma unroll
                for (int bj = 0; bj < 2; ++bj)
#pragma unroll
                    for (int n = 0; n < 2; ++n) { const f32x4 x1 = acc[ai][bj][m][n]; *(f32x4*)(out + off + bj * HALF + n * 16) = bad1 ? (f32x4){qnan, qnan, qnan, qnan} : x1;
                        const f32x4 o = (x1 - sr.x) * sr.y; u32x2v w; w.x = cvt_pk_bf16(o[0], o[1]); w.y = cvt_pk_bf16(o[2], o[3]);
                        if (bad) { w.x = 0x7fc07fc0u; w.y = 0x7fc07fc0u; } *(u32x2v*)(xn + off + bj * HALF + n * 16) = w; }
                asm volatile("" ::: "memory"); }
    }
};

template <class Epi, class Sched, bool ALIGN_EPI = false, bool SP2 = false>
__device__ __forceinline__ void gemm_phase(PG8_LAS unsigned char* lds, const Gemm g, const Sched& S, const Epi& E) {
    const int tid = threadIdx.x, wid = __builtin_amdgcn_readfirstlane(tid >> 6), lane = tid & 63, wr = wid >> 2, wc = wid & 3, fr = lane & 15, fq = lane >> 4;
    const int K = g.K, nt = K / BK;
    unsigned voffA[2], voffB[2];
#pragma unroll
    for (int i = 0; i < 2; ++i) { int R, C; stage_rc(tid * 16 + i * 8192, R, C); const int Rb = Epi::PERM ? ((R & ~31) + perm32(R & 31)) : R;
        voffA[i] = (unsigned)(R * K + C) * 2u; voffB[i] = (unsigned)(Rb * K + C) * 2u; }
    const size_t kstep = (size_t)(BK * 2);
    const size_t hstep = (size_t)HALF * K * 2;
    const size_t tstep = 2 * hstep;
    const unsigned ldsw = (unsigned)wid * 1024u;
    const int aoff = lds_byte(wr * 64 + fr, fq * 8), boff = lds_byte(wc * 32 + fr, fq * 8);
#define PG8_SA(b, h) (((b) * 2 + (h)) * HTB)
#define PG8_SB(b, h) ((4 + (b) * 2 + (h)) * HTB)
#define PG8_STAGE(bufoff, gbase, voff) do { _Pragma("unroll") for (int _i = 0; _i < 2; ++_i) \
        __builtin_amdgcn_global_load_lds((const unsigned*)((const char*)(gbase) + (voff)[_i]), (PG8_LAS unsigned*)(lds + (bufoff) + ldsw + _i * 8192), 16, 0, 0); } while (0)
#define PG8_LDA(dst, b, h) do { _Pragma("unroll") for (int m = 0; m < 4; ++m) _Pragma("unroll") for (int k = 0; k < 2; ++k) dst[m][k] = *(const PG8_LAS bf16x8*)(lds + PG8_SA(b, h) + aoff + m * 2048 + k * 1024); } while (0)
#define PG8_LDB(dst, b, h) do { _Pragma("unroll") for (int n = 0; n < 2; ++n) _Pragma("unroll") for (int k = 0; k < 2; ++k) dst[n][k] = *(const PG8_LAS bf16x8*)(lds + PG8_SB(b, h) + boff + n * 2048 + k * 1024); } while (0)
#define PG8_MMA(ai, bj, At, Bt) do { __builtin_amdgcn_s_setprio(1); _Pragma("unroll") for (int m = 0; m < 4; ++m) _Pragma("unroll") for (int n = 0; n < 2; ++n) _Pragma("unroll") for (int k = 0; k < 2; ++k) \
        acc[ai][bj][m][n] = __builtin_amdgcn_mfma_f32_16x16x32_bf16(Bt[n][k], At[m][k], acc[ai][bj][m][n], 0, 0, 0); __builtin_amdgcn_s_setprio(0); } while (0)
#define PG8_WAIT_V(n) asm volatile("s_waitcnt vmcnt(" #n ")" ::: "memory")
#define PG8_WAIT_L(n) asm volatile("s_waitcnt lgkmcnt(" #n ")" ::: "memory")
#define PG8_BAR __builtin_amdgcn_s_barrier()
#define PG8_SCHED __builtin_amdgcn_sched_barrier(0)
    Unit cur, nxt; int ui = 0;
    if (!S.next(0, cur)) return;
    f32x4 acc[2][2][4][2];
#pragma unroll
    for (int a = 0; a < 2; ++a)
#pragma unroll
        for (int b = 0; b < 2; ++b)
#pragma unroll
            for (int m = 0; m < 4; ++m)
#pragma unroll
                for (int n = 0; n < 2; ++n) acc[a][b][m][n] = (f32x4){0.f, 0.f, 0.f, 0.f};
    bf16x8 At[4][2], B0[2][2], B1[2][2];
    const char* cA = (const char*)(cur.seg ? g.A1 : g.A0) + (size_t)cur.pm * tstep; const char* cB = (const char*)(cur.seg ? g.B1 : g.B0) + (size_t)cur.pn * tstep;
    S.a_ready(cur);
    if constexpr (SP2) {
        PG8_STAGE(PG8_SB(0, 0), cB, voffB); PG8_STAGE(PG8_SB(0, 1), cB + hstep, voffB); PG8_STAGE(PG8_SA(0, 0), cA, voffA); PG8_STAGE(PG8_SA(0, 1), cA + hstep, voffA);
        if (wr == 1) PG8_BAR;
        PG8_WAIT_V(2); PG8_BAR;
        PG8_STAGE(PG8_SB(1, 0), cB + kstep, voffB); PG8_STAGE(PG8_SA(1, 0), cA + kstep, voffA); PG8_STAGE(PG8_SB(1, 1), cB + hstep + kstep, voffB);
        PG8_WAIT_V(6); PG8_BAR;
    } else {
        PG8_STAGE(PG8_SB(0, 0), cB, voffB); PG8_STAGE(PG8_SA(0, 0), cA, voffA); PG8_STAGE(PG8_SB(0, 1), cB + hstep, voffB); PG8_STAGE(PG8_SA(0, 1), cA + hstep, voffA);
        if (wr == 1) PG8_BAR;
        PG8_WAIT_V(4); PG8_BAR;
        PG8_STAGE(PG8_SB(1, 0), cB + kstep, voffB); PG8_STAGE(PG8_SA(1, 0), cA + kstep, voffA); PG8_STAGE(PG8_SB(1, 1), cB + hstep + kstep, voffB);
        PG8_WAIT_V(6); PG8_BAR;
    }
    for (;;) {
        const bool has_next = S.next(ui + 1, nxt);
        const char* nA = has_next ? (const char*)(nxt.seg ? g.A1 : g.A0) + (size_t)nxt.pm * tstep : cA; const char* nB = has_next ? (const char*)(nxt.seg ? g.B1 : g.B0) + (size_t)nxt.pn * tstep : cB;
        for (int t = 0; t < nt; t += 2) {
            const bool last = (t == nt - 2);
            const char* a1 = cA + (size_t)(t + 1) * kstep;
            const char* a2 = last ? nA : cA + (size_t)(t + 2) * kstep; const char* b2 = last ? nB : cB + (size_t)(t + 2) * kstep;
            const char* a3 = a2 + kstep; const char* b3 = b2 + kstep;
            if (last && has_next) S.a_ready(nxt);
            if constexpr (SP2) {
            PG8_LDB(B0, 0, 0); PG8_LDB(B1, 0, 1); PG8_SCHED; PG8_LDA(At, 0, 0); PG8_STAGE(PG8_SA(1, 1), a1 + hstep, voffA);
            PG8_WAIT_V(8); PG8_WAIT_L(0); PG8_BAR; PG8_MMA(0, 0, At, B0); PG8_MMA(0, 1, At, B1); PG8_BAR; PG8_SCHED;
            PG8_LDA(At, 0, 1); PG8_STAGE(PG8_SB(0, 0), b2, voffB); PG8_STAGE(PG8_SB(0, 1), b2 + hstep, voffB); PG8_STAGE(PG8_SA(0, 0), a2, voffA);
            PG8_WAIT_V(8); PG8_WAIT_L(0); PG8_BAR; PG8_MMA(1, 0, At, B0); PG8_MMA(1, 1, At, B1); PG8_BAR; PG8_SCHED;
            PG8_LDB(B0, 1, 0); PG8_LDB(B1, 1, 1); PG8_SCHED; PG8_LDA(At, 1, 0); PG8_STAGE(PG8_SA(0, 1), a2 + hstep, voffA);
            PG8_WAIT_V(8); PG8_WAIT_L(0); PG8_BAR; PG8_MMA(0, 0, At, B0); PG8_MMA(0, 1, At, B1); PG8_BAR; PG8_SCHED;
            PG8_LDA(At, 1, 1); PG8_STAGE(PG8_SB(1, 0), b3, voffB); PG8_STAGE(PG8_SB(1, 1), b3 + hstep, voffB); PG8_STAGE(PG8_SA(1, 0), a3, voffA);
            PG8_WAIT_V(8); PG8_WAIT_L(0); PG8_BAR; PG8_MMA(1, 0, At, B0); PG8_MMA(1, 1, At, B1); PG8_BAR; PG8_SCHED;
            } else {
            PG8_LDB(B0, 0, 0); PG8_SCHED; PG8_LDA(At, 0, 0); PG8_STAGE(PG8_SA(1, 1), a1 + hstep, voffA);
            PG8_WAIT_L(8); PG8_BAR; PG8_WAIT_L(0); PG8_MMA(0, 0, At, B0); PG8_BAR; PG8_SCHED;
            PG8_LDB(B1, 0, 1); PG8_STAGE(PG8_SB(0, 0), b2, voffB);
            PG8_BAR; PG8_WAIT_L(0); PG8_MMA(0, 1, At, B1); PG8_BAR;
            PG8_LDA(At, 0, 1); PG8_STAGE(PG8_SA(0, 0), a2, voffA);
            PG8_BAR; PG8_WAIT_L(0); PG8_MMA(1, 0, At, B0); PG8_BAR; PG8_SCHED;
            PG8_STAGE(PG8_SB(0, 1), b2 + hstep, voffB);
            PG8_WAIT_V(6); PG8_BAR; PG8_MMA(1, 1, At, B1); PG8_BAR;
            PG8_LDB(B0, 1, 0); PG8_SCHED; PG8_LDA(At, 1, 0); PG8_STAGE(PG8_SA(0, 1), a2 + hstep, voffA);
            PG8_WAIT_L(8); PG8_BAR; PG8_WAIT_L(0); PG8_MMA(0, 0, At, B0); PG8_BAR; PG8_SCHED;
            PG8_LDB(B1, 1, 1); PG8_STAGE(PG8_SB(1, 0), b3, voffB);
            PG8_BAR; PG8_WAIT_L(0); PG8_MMA(0, 1, At, B1); PG8_BAR;
            PG8_LDA(At, 1, 1); PG8_STAGE(PG8_SA(1, 0), a3, voffA);
            PG8_BAR; PG8_WAIT_L(0); PG8_MMA(1, 0, At, B0); PG8_BAR; PG8_SCHED;
            PG8_STAGE(PG8_SB(1, 1), b3 + hstep, voffB);
            PG8_WAIT_V(6); PG8_BAR; PG8_MMA(1, 1, At, B1); PG8_BAR;
            }
        }
        if constexpr (ALIGN_EPI) { if (wr == 0) PG8_BAR; }
        if constexpr (!Epi::AFTER_DRAIN) { E(acc, cur, wr, wc, fr, fq); S.done(cur); }
        if (!has_next) break;
        if (nxt.seg == 0) {
#pragma unroll
        for (int a = 0; a < 2; ++a)
#pragma unroll
            for (int b = 0; b < 2; ++b)
#pragma unroll
                for (int m = 0; m < 4; ++m)
#pragma unroll
                    for (int n = 0; n < 2; ++n) acc[a][b][m][n] = (f32x4){0.f, 0.f, 0.f, 0.f};
        }
        cur = nxt; cA = nA; cB = nB; ++ui;
        if constexpr (ALIGN_EPI) { if (wr == 1) PG8_BAR; }
    }
    PG8_WAIT_V(0);
    if constexpr (!ALIGN_EPI) { if (wr == 0) PG8_BAR; }
    PG8_BAR;
    if constexpr (Epi::AFTER_DRAIN) { E.fused(acc, cur, wr, wc, fr, fq, lds, wid, lane); S.done(cur); }
#undef PG8_SA
#undef PG8_SB
#undef PG8_STAGE
#undef PG8_LDA
#undef PG8_LDB
#undef PG8_MMA
#undef PG8_WAIT_V
#undef PG8_WAIT_L
#undef PG8_BAR
#undef PG8_SCHED
}
}
namespace attn_body {
using bf16=__hip_bfloat16;
using bf16x8=__attribute__((ext_vector_type(8)))short;
using s16x4=__attribute__((ext_vector_type(4)))short;
using f32x16=__attribute__((ext_vector_type(16)))float;
using u32x4=__attribute__((ext_vector_type(4)))unsigned;
constexpr int BATCH=8,NHEAD=16,SEQ=4096,D=64,DM=NHEAD*D;
constexpr int NW=8,QBLK=32,QB=QBLK*NW,KVBLK=64,NQB=SEQ/QB;
constexpr int ATTN_PITCH=DM, ATTN_UNIT_ROWS=QB;
__device__ __forceinline__ int crow(int r,int hi){return (r&3)+8*(r>>2)+4*hi;}
#define SBAR() __builtin_amdgcn_sched_barrier(0)
__device__ __forceinline__ void cmask(f32x16&p0,f32x16&p1,int jb,int qrel,int hi){
  const float NEG=-INFINITY; int kb=64*jb+4*hi;
  #pragma unroll
  for(int r=0;r<16;++r){int kv=kb+(r&3)+8*(r>>2); if(kv>qrel)p0[r]=NEG; if(kv+32>qrel)p1[r]=NEG;}
}

constexpr int NSLOT=3, SLOTB=8192;
constexpr int LDS_K=0, LDS_V=NSLOT*SLOTB, LDS_WS=2*NSLOT*SLOTB, LDS_OST=LDS_WS+NW*64*4, LDS_CL=LDS_OST+NW*4096, LDS_BYTES=LDS_CL+SEQ*4;
constexpr float C2=0.125f*1.4426950408889634f;
__device__ __forceinline__ void glds16(const void*gsrc,unsigned lds_dst){unsigned keep;
  asm volatile("s_mov_b32 %0, m0\n\ts_mov_b32 m0, %2\n\ts_nop 0\n\tglobal_load_lds_dwordx4 %1, off\n\ts_mov_b32 m0, %0":"=&s"(keep):"v"(gsrc),"s"(lds_dst):"memory");}
__device__ __forceinline__ float max3f(float a,float b,float c){float r;asm("v_max3_f32 %0, %1, %2, %3":"=v"(r):"v"(a),"v"(b),"v"(c));return r;}
__device__ __forceinline__ float max2f(float a,float b){float r;asm("v_max_f32_e32 %0, %1, %2":"=v"(r):"v"(a),"v"(b));return r;}
__device__ __forceinline__ float fadd_s(float a,float b){float r;asm("v_add_f32_e32 %0, %1, %2":"=v"(r):"v"(a),"v"(b));return r;}
__device__ __forceinline__ float fsub_s(float a,float b){float r;asm("v_sub_f32_e32 %0, %1, %2":"=v"(r):"v"(a),"v"(b));return r;}
typedef float f32x2_t __attribute__((ext_vector_type(2))); typedef __bf16 bf16x2_t __attribute__((ext_vector_type(2)));
__device__ __forceinline__ unsigned cvtpk_s(float lo,float hi){f32x2_t v={lo,hi};bf16x2_t b=__builtin_convertvector(v,bf16x2_t);return __builtin_bit_cast(unsigned,b);}
#define WAIT_BAR(N) asm volatile("s_waitcnt vmcnt(" #N ") lgkmcnt(0)\n\ts_barrier":::"memory")

__device__ __forceinline__ void qkt(f32x16&p0,f32x16&p1,const char*Kslot,const bf16x8*qr,int r32,int hi){
  const char*kb=Kslot+hi*1024+r32*16;
  #pragma unroll
  for(int d0=0;d0<4;++d0){
    const bf16x8 b0=*reinterpret_cast<const bf16x8*>(kb+d0*2048);
    const bf16x8 b1=*reinterpret_cast<const bf16x8*>(kb+d0*2048+512);
    {p0=__builtin_amdgcn_mfma_f32_32x32x16_bf16(b0,qr[d0],p0,0,0,0);p1=__builtin_amdgcn_mfma_f32_32x32x16_bf16(b1,qr[d0],p1,0,0,0);}}
}
typedef __attribute__((address_space(3))) const char* lds_cptr;
typedef short v4i16_t __attribute__((ext_vector_type(4)));
__device__ __forceinline__ void kload8(bf16x8*kf,lds_cptr kp){
  kf[0]=*(const __attribute__((address_space(3))) bf16x8*)(kp);      kf[1]=*(const __attribute__((address_space(3))) bf16x8*)(kp+512);
  kf[2]=*(const __attribute__((address_space(3))) bf16x8*)(kp+2048); kf[3]=*(const __attribute__((address_space(3))) bf16x8*)(kp+2560);
  kf[4]=*(const __attribute__((address_space(3))) bf16x8*)(kp+4096); kf[5]=*(const __attribute__((address_space(3))) bf16x8*)(kp+4608);
  kf[6]=*(const __attribute__((address_space(3))) bf16x8*)(kp+6144); kf[7]=*(const __attribute__((address_space(3))) bf16x8*)(kp+6656);
}
__device__ __forceinline__ void kload2(bf16x8*kf,lds_cptr kp,int j){ kf[2*j]=*(const __attribute__((address_space(3))) bf16x8*)(kp+j*2048); kf[2*j+1]=*(const __attribute__((address_space(3))) bf16x8*)(kp+j*2048+512); }
__device__ __forceinline__ s16x4 vtr(lds_cptr p){ return __builtin_bit_cast(s16x4,__builtin_amdgcn_ds_read_tr16_b64_v4i16((__attribute__((address_space(3))) v4i16_t*)p)); }
__device__ __forceinline__ float rowmax(const f32x16&p0,const f32x16&p1){
  float a=max3f(p0[0],p0[1],p1[0]),b=max3f(p0[2],p0[3],p1[1]);a=max3f(a,p1[2],p1[3]);
  #pragma unroll
  for(int r=4;r<16;r+=4){a=max3f(a,p0[r],p0[r+1]);b=max3f(b,p0[r+2],p0[r+3]);a=max3f(a,p1[r],p1[r+1]);b=max3f(b,p1[r+2],p1[r+3]);}
  const float m=max2f(a,b);
  auto rr=__builtin_amdgcn_permlane32_swap(__float_as_uint(m),__float_as_uint(m),false,false);
  return max2f(__uint_as_float(rr[0]),__uint_as_float(rr[1]));
}
__device__ __forceinline__ void pv(f32x16*o,int vb,bf16x8 pa0,bf16x8 pa1,bf16x8 pa2,bf16x8 pa3){
  #pragma unroll
  for(int d0=0;d0<2;++d0){s16x4 lo[4],hi[4];
    #pragma unroll
    for(int ks=0;ks<4;++ks){
      asm volatile("ds_read_b64_tr_b16 %0,%1 offset:%c2":"=&v"(lo[ks]):"v"(vb),"i"(d0*4096+ks*1024):"memory");
      asm volatile("ds_read_b64_tr_b16 %0,%1 offset:%c2":"=&v"(hi[ks]):"v"(vb),"i"(d0*4096+ks*1024+512):"memory");}
    asm volatile("s_waitcnt lgkmcnt(0)":::"memory");SBAR();
    #define PK(k) (bf16x8){lo[k][0],lo[k][1],lo[k][2],lo[k][3],hi[k][0],hi[k][1],hi[k][2],hi[k][3]}
    o[d0]=__builtin_amdgcn_mfma_f32_32x32x16_bf16(pa0,PK(0),o[d0],0,0,0);
    o[d0]=__builtin_amdgcn_mfma_f32_32x32x16_bf16(pa1,PK(1),o[d0],0,0,0);
    o[d0]=__builtin_amdgcn_mfma_f32_32x32x16_bf16(pa2,PK(2),o[d0],0,0,0);
    o[d0]=__builtin_amdgcn_mfma_f32_32x32x16_bf16(pa3,PK(3),o[d0],0,0,0);
    #undef PK
  }
}

#ifndef ATTN_STORE16
#define ATTN_STORE16(p,v) (*(u32x4*)(p)=(v))
#endif
template<int THRL> __device__ __forceinline__ void attn_unit(int b,int h,int qb,int T0,const bf16*Q,const bf16*__restrict__ K,const bf16*__restrict__ V,bf16*O,const float*__restrict__ c2g,char*shm){
  const int tid=threadIdx.x,lane=tid&63,r32=lane&31,hi=lane>>5; const int wid=__builtin_amdgcn_readfirstlane(tid>>6);
  const long rowbase=(long)b*SEQ; const int q0=qb*QB;
  const bf16*Qw=Q+(rowbase+q0+wid*QBLK)*DM+h*D;
  const bf16*Kh=K+(rowbase+(long)T0*KVBLK)*DM+h*D,*Vh=V+(rowbase+(long)T0*KVBLK)*DM+h*D;
  const unsigned lds0=(unsigned)(uintptr_t)shm; const lds_cptr shm3=(lds_cptr)shm;
  float*wsf=(float*)(shm+LDS_WS)+wid*64;
  const bf16*ksrc=Kh+(long)lane*DM+wid*8;
  const bf16*vsrc=Vh+(long)(16*(wid&3)+(lane>>2))*DM+(wid>>2)*32+(lane&3)*8;
  const unsigned kdst=lds0+LDS_K+wid*1024, vdst=lds0+LDS_V+wid*1024;
  #define DMA_K(t,slot) glds16(ksrc+(long)(t)*KVBLK*DM,(unsigned)__builtin_amdgcn_readfirstlane(kdst+(slot)))
  #define DMA_V(t,slot) glds16(vsrc+(long)(t)*KVBLK*DM,(unsigned)__builtin_amdgcn_readfirstlane(vdst+(slot)))
  const int vb0=(int)(lds0+LDS_V)+((lane>>4)&1)*32+(lane&3)*8+(4*hi+((lane&15)>>2))*64;
  const char*Kbase=shm+LDS_K; bf16x8 kf[8];
  const lds_cptr kp0=shm3+LDS_K+hi*1024+r32*16; const lds_cptr vp0=shm3+LDS_V+((lane>>4)&1)*32+(lane&3)*8+(4*hi+((lane&15)>>2))*64;
  const int NT=(q0+QB)/KVBLK-T0;
  { typedef float f32x4g __attribute__((ext_vector_type(4))); __attribute__((address_space(3))) f32x4g* cl4=(__attribute__((address_space(3))) f32x4g*)(shm3+LDS_CL);
    for(int s4=tid; s4<(q0+QB)/4; s4+=NW*64) cl4[s4]=*reinterpret_cast<const f32x4g*>(c2g+4*s4); }
  float nm=c2g[q0+wid*QBLK+r32];
  DMA_K(0,0);DMA_V(0,0);DMA_K(1,SLOTB);
  bf16x8 qr[4];
  #pragma unroll
  for(int d0=0;d0<4;++d0)qr[d0]=*reinterpret_cast<const bf16x8*>(&Qw[(long)r32*DM+d0*16+hi*8]);
  float l_reg=0.f;f32x16 o[2];o[0]=f32x16{};o[1]=f32x16{};
  typedef float f32x4l __attribute__((ext_vector_type(4)));
  #define CINIT(C0,C1,t) do{ const __attribute__((address_space(3))) f32x4l* cp_=(const __attribute__((address_space(3))) f32x4l*)(shm3+LDS_CL+(((t)+T0)*64+4*hi)*4); \
    _Pragma("unroll") for(int g_=0;g_<4;++g_){ const f32x4l a_=cp_[2*g_], b_=cp_[8+2*g_]; \
      C0[4*g_]=nm-a_[0];C0[4*g_+1]=nm-a_[1];C0[4*g_+2]=nm-a_[2];C0[4*g_+3]=nm-a_[3]; \
      C1[4*g_]=nm-b_[0];C1[4*g_+1]=nm-b_[1];C1[4*g_+2]=nm-b_[2];C1[4*g_+3]=nm-b_[3]; } }while(0)
  const int qrel=wid*QBLK+r32;
  #define CMASK(P0,P1,t) do{int jb_=(t)-(NT-4); if(jb_>=0)cmask(P0,P1,jb_,qrel,hi);}while(0)
  bool resc=false;
  #define START(P0,P1) do{ const float rm=rowmax(P0,P1); resc=false; \
    { const float dl=rm; nm=fsub_s(nm,dl); \
      _Pragma("unroll") for(int r=0;r<16;++r){P0[r]=fsub_s(P0[r],dl);P1[r]=fsub_s(P1[r],dl);} } \
    _Pragma("unroll") for(int r=0;r<16;++r)P0[r]=__builtin_amdgcn_exp2f(P0[r]); }while(0)
  #define RESC() do{ if(resc){ asm volatile("s_waitcnt lgkmcnt(0)":::"memory"); \
      _Pragma("unroll") for(int d_=0;d_<2;++d_) _Pragma("unroll") for(int r=0;r<16;++r)o[d_][r]*=wsf[crow(r,hi)]; } }while(0)
  f32x16 pA0,pA1,pB0,pB1;
  int sl_prev=0,sl_cur=0,sl_next=SLOTB;
  #define ROT() do{sl_prev=sl_cur;sl_cur=sl_next;sl_next=(sl_next==(NSLOT-1)*SLOTB)?0:sl_next+SLOTB;}while(0)
  DMA_K(2,2*SLOTB);
  WAIT_BAR(3);
  CINIT(pA0,pA1,0); qkt(pA0,pA1,Kbase,qr,r32,hi);asm volatile("s_nop 15\n\ts_nop 7":"+v"(pA0),"+v"(pA1));CMASK(pA0,pA1,0);
  START(pA0,pA1);
  _Pragma("unroll") for(int r=0;r<16;++r)pA1[r]=__builtin_amdgcn_exp2f(pA1[r]);
  WAIT_BAR(0);
  DMA_K(3,0);DMA_V(1,SLOTB);
  ROT();
  kload8(kf,kp0+sl_cur);
  WAIT_BAR(2);
  s16x4 vlo[8],vhi[8]; u32x4 pw0,pw1,pw2,pw3;
  #define PKW(P,B) cvtpk_s(P[B],P[B+1])
  #define PAF(k) __builtin_bit_cast(bf16x8,pw##k)
  #define VFR(i) (bf16x8){vlo[i][0],vlo[i][1],vlo[i][2],vlo[i][3],vhi[i][0],vhi[i][1],vhi[i][2],vhi[i][3]}
  #define PIN(x) asm volatile("":"+v"(x))
  #define MX3(a,b,c) __builtin_fmaxf(__builtin_fmaxf((a),(b)),(c))
  #define GAPA(MF,A0,A1,A2,A3,W0,W1,PW) do{ MF; sacc+=A0; sacc+=A1; sacc+=A2; sacc+=A3; PIN(sacc); W0; W1; PIN(PW); SBAR(); }while(0)
  #define EX(v) __builtin_amdgcn_exp2f(v)
  #define GAPB(MF,X,B) do{ MF; X[B]=EX(X[B]); X[B+1]=EX(X[B+1]); X[B+2]=EX(X[B+2]); X[B+3]=EX(X[B+3]); PIN(X); SBAR(); }while(0)
  #define VRD(i) do{ vlo[i]=vtr(vp_+(((i)>>2)*4096+((i)&3)*1024)); vhi[i]=vtr(vp_+(((i)>>2)*4096+((i)&3)*1024+512)); }while(0)
  #define KRD(G,j) do{ if(G){ kload2(kf,kp0+sl_next,j); SBAR(); } }while(0)
  #define STEP(C0,C1,P0,P1,t,GK,GV,GL) do{ SBAR(); CINIT(C0,C1,t); SBAR(); \
    const lds_cptr vp_=vp0+sl_prev; \
    VRD(0); SBAR(); float sacc=(P0[0]+P0[1]); \
    GAPA(C0=__builtin_amdgcn_mfma_f32_32x32x16_bf16(kf[0],qr[0],C0,0,0,0), P0[2],P0[3],P0[4],P0[5],     pw0[0]=PKW(P0,0), pw0[1]=PKW(P0,2), pw0); \
    VRD(4); SBAR(); GAPA(C1=__builtin_amdgcn_mfma_f32_32x32x16_bf16(kf[1],qr[0],C1,0,0,0), P0[6],P0[7],P0[8],P0[9],     pw0[2]=PKW(P0,4), pw0[3]=PKW(P0,6), pw0); \
    VRD(1); SBAR(); GAPA(C0=__builtin_amdgcn_mfma_f32_32x32x16_bf16(kf[2],qr[1],C0,0,0,0),   P0[10],P0[11],P0[12],P0[13], pw1[0]=PKW(P0,8), pw1[1]=PKW(P0,10), pw1); \
    VRD(5); SBAR(); GAPA(C1=__builtin_amdgcn_mfma_f32_32x32x16_bf16(kf[3],qr[1],C1,0,0,0),   P0[14],P0[15],P1[0],P1[1],   pw1[2]=PKW(P0,12),pw1[3]=PKW(P0,14), pw1); \
    VRD(2); SBAR(); GAPA(C0=__builtin_amdgcn_mfma_f32_32x32x16_bf16(kf[4],qr[2],C0,0,0,0),   P1[2],P1[3],P1[4],P1[5],     pw2[0]=PKW(P1,0), pw2[1]=PKW(P1,2), pw2); \
    VRD(6); SBAR(); GAPA(C1=__builtin_amdgcn_mfma_f32_32x32x16_bf16(kf[5],qr[2],C1,0,0,0),   P1[6],P1[7],P1[8],P1[9],     pw2[2]=PKW(P1,4), pw2[3]=PKW(P1,6), pw2); \
    VRD(3); SBAR(); GAPA(C0=__builtin_amdgcn_mfma_f32_32x32x16_bf16(kf[6],qr[3],C0,0,0,0),   P1[10],P1[11],P1[12],P1[13], pw3[0]=PKW(P1,8), pw3[1]=PKW(P1,10), pw3); \
    VRD(7); SBAR(); GAPA(C1=__builtin_amdgcn_mfma_f32_32x32x16_bf16(kf[7],qr[3],C1,0,0,0),   P1[14],P1[15],0.f,0.f,       pw3[2]=PKW(P1,12),pw3[3]=PKW(P1,14), pw3); \
    l_reg+=sacc; \
    if(GK){DMA_K((t)+3,sl_cur);} if(GV){DMA_V((t)+1,sl_next);} \
    CMASK(C0,C1,t); \
    { float a=MX3(C0[0],C0[1],C1[0]),b=MX3(C0[2],C0[3],C1[1]); a=MX3(a,C1[2],C1[3]); \
      _Pragma("unroll") for(int r=4;r<16;r+=4){a=MX3(a,C0[r],C0[r+1]);b=MX3(b,C0[r+2],C0[r+3]);a=MX3(a,C1[r],C1[r+1]);b=MX3(b,C1[r+2],C1[r+3]);} \
      float rm=__builtin_fmaxf(a,b); { auto rr=__builtin_amdgcn_permlane32_swap(__float_as_uint(rm),__float_as_uint(rm),false,false); rm=__builtin_fmaxf(__uint_as_float(rr[0]),__uint_as_float(rr[1])); } \
      resc=false; \
      if(__builtin_expect(__any(rm>(float)THRL),0)){ const float dl=__builtin_fmaxf(rm,0.f); nm-=dl; \
        _Pragma("unroll") for(int r=0;r<16;++r){C0[r]-=dl;C1[r]-=dl;} \
        const float f=__builtin_amdgcn_exp2f(-dl); l_reg*=f; if(hi==0)wsf[r32]=f; resc=true; } } \
    SBAR(); \
    GAPB(o[0]=__builtin_amdgcn_mfma_f32_32x32x16_bf16(PAF(0),VFR(0),o[0],0,0,0), C0,0); \
    GAPB(o[1]=__builtin_amdgcn_mfma_f32_32x32x16_bf16(PAF(0),VFR(4),o[1],0,0,0), C0,4); \
    KRD(GL,0); GAPB(o[0]=__builtin_amdgcn_mfma_f32_32x32x16_bf16(PAF(1),VFR(1),o[0],0,0,0), C0,8); \
    KRD(GL,1); GAPB(o[1]=__builtin_amdgcn_mfma_f32_32x32x16_bf16(PAF(1),VFR(5),o[1],0,0,0), C0,12); \
    KRD(GL,2); GAPB(o[0]=__builtin_amdgcn_mfma_f32_32x32x16_bf16(PAF(2),VFR(2),o[0],0,0,0), C1,0); \
    KRD(GL,3); GAPB(o[1]=__builtin_amdgcn_mfma_f32_32x32x16_bf16(PAF(2),VFR(6),o[1],0,0,0), C1,4); \
    GAPB(o[0]=__builtin_amdgcn_mfma_f32_32x32x16_bf16(PAF(3),VFR(3),o[0],0,0,0), C1,8); \
    GAPB(o[1]=__builtin_amdgcn_mfma_f32_32x32x16_bf16(PAF(3),VFR(7),o[1],0,0,0), C1,12); \
    }while(0)
  int t=1;
  #undef CMASK
  #define CMASK(P0,P1,t) do{}while(0)
  for(;t+5<NT;t+=2){
    STEP(pB0,pB1,pA0,pA1,t,true,true,true);     WAIT_BAR(2); RESC(); ROT();
    STEP(pA0,pA1,pB0,pB1,t+1,true,true,true);   WAIT_BAR(2); RESC(); ROT();
  }
  #undef CMASK
  #define CMASK(P0,P1,t) do{int jb_=(t)-(NT-4); if(jb_>=0)cmask(P0,P1,jb_,qrel,hi);}while(0)
  #define ENDW(tt) do{ if((tt)+3<NT){WAIT_BAR(2);} else if((tt)+2<NT){WAIT_BAR(1);} else {WAIT_BAR(0);} }while(0)
  for(;t+1<NT;t+=2){
    STEP(pB0,pB1,pA0,pA1,t,(t+3<NT),(t+1<NT),(t+1<NT));       ENDW(t);   RESC(); ROT();
    STEP(pA0,pA1,pB0,pB1,t+1,(t+4<NT),(t+2<NT),(t+2<NT));     ENDW(t+1); RESC(); ROT();
  }
  STEP(pB0,pB1,pA0,pA1,NT-1,false,false,false); RESC();
  { float sacc=pB0[0]+pB0[1]; _Pragma("unroll") for(int r=2;r<16;++r)sacc+=pB0[r]; _Pragma("unroll") for(int r=0;r<16;++r)sacc+=pB1[r]; l_reg+=sacc;
    pw0=(u32x4){PKW(pB0,0),PKW(pB0,2),PKW(pB0,4),PKW(pB0,6)};pw1=(u32x4){PKW(pB0,8),PKW(pB0,10),PKW(pB0,12),PKW(pB0,14)};pw2=(u32x4){PKW(pB1,0),PKW(pB1,2),PKW(pB1,4),PKW(pB1,6)};pw3=(u32x4){PKW(pB1,8),PKW(pB1,10),PKW(pB1,12),PKW(pB1,14)};
    SBAR(); pv(o,vb0+sl_cur,PAF(0),PAF(1),PAF(2),PAF(3)); }
  #undef PKW
  #undef PAF
  #undef VFR
  #undef PIN
  #undef MX3
  #undef GAPA
  #undef GAPB
  #undef EX
  #undef VRD
  #undef KRD
  #undef STEP
  #undef ENDW
  {auto rr=__builtin_amdgcn_permlane32_swap(__float_as_uint(l_reg),__float_as_uint(l_reg),false,false);l_reg=__uint_as_float(rr[0])+__uint_as_float(rr[1]);}
  if(hi==0)wsf[32+r32]=l_reg;asm volatile("s_waitcnt lgkmcnt(0)":::"memory");
  float rli[16];
  #pragma unroll
  for(int r=0;r<16;++r)rli[r]=__builtin_amdgcn_rcpf(wsf[32+crow(r,hi)]);
  bf16*Ow=O+(rowbase+q0+wid*QBLK)*DM+h*D;
  { bf16*stg=(bf16*)(shm+LDS_OST)+wid*2048;
    #pragma unroll
    for(int r=0;r<16;++r){const int orow=crow(r,hi);
      #pragma unroll
      for(int d0=0;d0<2;++d0)stg[orow*64+d0*32+r32]=__float2bfloat16(o[d0][r]*rli[r]);}
    asm volatile("s_waitcnt lgkmcnt(0)":::"memory");
    #pragma unroll
    for(int i=0;i<4;++i){const int row=i*8+(lane>>3),ch=lane&7; const u32x4 v=*(const u32x4*)(stg+row*64+ch*8); ATTN_STORE16(Ow+(long)row*DM+ch*8,v);} }
  asm volatile("s_waitcnt lgkmcnt(0)\n\ts_barrier":::"memory");
  #undef DMA_K
  #undef DMA_V
  #undef CMASK
  #undef CINIT
  #undef START
  #undef RESC
  #undef ROT
}
constexpr int ATTN_LDS_BYTES=LDS_BYTES;
struct AttnTensors { const bf16* Q; const bf16* K; const bf16* V; bf16* O; const float* C2; };
struct AttnUnit { int bh; int qb; int t0; };
struct StaticOrder {
  int vcu, G;
  __device__ __forceinline__ explicit StaticOrder(int grid,int block):vcu((grid%8==0)?(block%8)*(grid/8)+block/8:block),G(grid){}
  __device__ __forceinline__ bool next(int i,AttnUnit&u)const{
    if(G==256){ if(i>=8)return false; const int s=vcu&1, base=4*(i>>1); u.bh=vcu>>1; u.qb=(i&1)?base+3-s:base+s; u.t0=0; return true; }
    const int L=i*G+vcu; if(L>=BATCH*NHEAD*NQB)return false; u.bh=L/NQB; u.qb=L%NQB; u.t0=0; return true; }
  __device__ __forceinline__ void a_ready(const AttnUnit&)const{}
  __device__ __forceinline__ void done(const AttnUnit&)const{}
};
template<class Sched,int THRL=8> __device__ __forceinline__ void attn_phase(char*lds,const AttnTensors&T,const Sched&S){
  AttnUnit u;
  for(int i=0;S.next(i,u);++i){ S.a_ready(u); attn_unit<THRL>(u.bh/NHEAD,u.bh%NHEAD,u.qb,u.t0,T.Q,T.K,T.V,T.O,T.C2+(size_t)u.bh*SEQ,lds); S.done(u); }
}
#undef SBAR
#undef WAIT_BAR
}
#define GAS __attribute__((address_space(1)))
#define LAS __attribute__((address_space(3)))
typedef unsigned short bf16;
typedef unsigned v4u __attribute__((ext_vector_type(4)));
typedef float f32x4 __attribute__((ext_vector_type(4)));
typedef short bf16x8 __attribute__((ext_vector_type(8)));
typedef GAS unsigned gu32;
typedef GAS unsigned long long gu64;
#define RLX_AGENT __ATOMIC_RELAXED, __HIP_MEMORY_SCOPE_AGENT
#define LDS_WAIT() asm volatile("s_waitcnt lgkmcnt(0)" ::: "memory")
#define VM_WAIT() asm volatile("s_waitcnt vmcnt(0)" ::: "memory")
__device__ __forceinline__ unsigned long long rt() { return __builtin_amdgcn_s_memrealtime(); }
__device__ __forceinline__ unsigned f2bf(float f) { unsigned u = __builtin_bit_cast(unsigned, f); return (u + 0x7fffu + ((u >> 16) & 1u)) >> 16; }
__device__ __forceinline__ unsigned pk2(float lo, float hi) { return f2bf(lo) | (f2bf(hi) << 16); }

#define XB_TMO      128
#define XB_XCNT(j)  (256  + 64 * (j))
#define XB_XSUB(j)  (1280 + 64 * (j))
#define XB_XGEN(j)  (2304 + 64 * (j))
#define XB_TOP      3328
#define XB_TOPGEN   3392
#define XCD_BAR_WORDS 3456
#define XB_SPIN_CAP (1u << 18)

__device__ __forceinline__ unsigned xb_ld(unsigned* p)              { return __hip_atomic_load(p, __ATOMIC_RELAXED, __HIP_MEMORY_SCOPE_AGENT); }
__device__ __forceinline__ unsigned xb_add(unsigned* p, unsigned v) { return __hip_atomic_fetch_add(p, v, __ATOMIC_RELAXED, __HIP_MEMORY_SCOPE_AGENT); }
__device__ __forceinline__ unsigned xb_xcc_id() { return (unsigned)__builtin_amdgcn_s_getreg((3 << 11) | 20) & 0xFu; }
#define XB_SPIN(cond, bar) do { unsigned _sp = 0; while (cond) { __builtin_amdgcn_s_sleep(1); \
    if ((++_sp & 255u) == 0u) { if (xb_ld(&(bar)[XB_TMO])) break; if (_sp > XB_SPIN_CAP) { atomicAdd(&(bar)[XB_TMO], 1u); break; } } } } while (0)

struct XcdBarrier {
    unsigned* bar; unsigned x;
    volatile LAS unsigned* st;
};

__device__ __forceinline__ XcdBarrier xcd_barrier_post(unsigned* bar, volatile LAS unsigned* st) {
    XcdBarrier b; b.bar = bar; b.x = xb_xcc_id(); b.st = st;
    if (threadIdx.x == 0) (void)xb_add(&bar[XB_XCNT(b.x)], 1u);
    return b;
}
__device__ __forceinline__ void xcd_barrier_complete(unsigned* bar, unsigned x, unsigned& nloc, unsigned& nx) {
    const unsigned G = gridDim.x * gridDim.y * gridDim.z;
    unsigned sum, cnt, mine, sp = 0u;
    for (;;) {
        sum = 0u; cnt = 0u; mine = 0u;
#pragma unroll
        for (unsigned j = 0; j < 16; ++j) { const unsigned c = xb_ld(&bar[XB_XCNT(j)]); sum += c; cnt += (c > 0u) ? 1u : 0u; mine = (j == x) ? c : mine; }
        if (sum == G) break;
        __builtin_amdgcn_s_sleep(1);
        if ((++sp & 255u) == 0u) { if (xb_ld(&bar[XB_TMO])) break; if (sp > XB_SPIN_CAP) { atomicAdd(&bar[XB_TMO], 1u); break; } }
    }
    nloc = mine > 0u ? mine : 1u; nx = cnt > 0u ? cnt : 1u;
}

__device__ __forceinline__ void xcd_barrier(const XcdBarrier& b) {
    asm volatile("s_waitcnt vmcnt(0)" ::: "memory");
    __syncthreads();
    if (threadIdx.x == 0) {
        unsigned* bar = b.bar;
        __builtin_amdgcn_s_waitcnt(0);
        unsigned nloc = b.st[0], nx = b.st[1];
        if (nloc == 0u) { xcd_barrier_complete(bar, b.x, nloc, nx); b.st[0] = nloc; b.st[1] = nx; }
        const unsigned old = xb_add(&bar[XB_XSUB(b.x)], 1u);
        const unsigned gen = old / nloc;
        if (old + 1u == (gen + 1u) * nloc) {
            __builtin_amdgcn_fence(__ATOMIC_RELEASE, "agent");
            asm volatile("s_waitcnt vmcnt(0)" ::: "memory");
            const unsigned og = xb_add(&bar[XB_TOP], 1u);
            const unsigned tg = og / nx;
            if (og + 1u == (tg + 1u) * nx) xb_add(&bar[XB_TOPGEN], 1u);
            else XB_SPIN(xb_ld(&bar[XB_TOPGEN]) == tg, bar);
            __builtin_amdgcn_fence(__ATOMIC_ACQUIRE, "agent");
            xb_add(&bar[XB_XGEN(b.x)], 1u);
            asm volatile("s_waitcnt vmcnt(0)" ::: "memory");
        } else {
            XB_SPIN(xb_ld(&bar[XB_XGEN(b.x)]) == gen, bar);
            __builtin_amdgcn_fence(__ATOMIC_ACQUIRE, "agent");
            asm volatile("s_waitcnt vmcnt(0)" ::: "memory");
        }
    }
    __syncthreads();
}

constexpr int BATCH = 8, SEQ = 4096, D = 1024, M = BATCH * SEQ, NHEADS = 16, HDIM = 64;
constexpr int INC = 7184, N1 = 7168;
constexpr int PHEADS = 8, PNK = 128, PDK = 256, PTOPK = 16, NQP = PHEADS * PDK, NEXP = PNK * PNK, NSEL = PHEADS * PTOPK;
constexpr float EPS = 1e-6f, LOG2E = 1.4426950408889634f;
constexpr int NWAVES = 8;

constexpr size_t MiB = 1u << 20;
constexpr size_t WS_CTL = 0, CTL_ZERO_BYTES = 1 * MiB;
constexpr size_t WS_LOGF = 1 * MiB;
constexpr size_t WS_C2 = 3 * MiB;
constexpr size_t WS_K1 = 5 * MiB, WS_K2 = 5 * MiB + 256 * 1024;
constexpr size_t WS_WIN = 8 * MiB;
constexpr size_t WS_WC = 22 * MiB, WS_WF = 24 * MiB, WS_WO = 26 * MiB, WS_WQ = 28 * MiB;
constexpr size_t WS_U = 32 * MiB, WS_VT = 64 * MiB;
constexpr size_t WS_XN = 96 * MiB;
constexpr size_t WS_GLU = 160 * MiB;
constexpr size_t WS_QO = 224 * MiB, WS_K = 288 * MiB, WS_V = 352 * MiB;
constexpr size_t WS_QP = 96 * MiB;
constexpr size_t WS_IDX = 352 * MiB;
constexpr size_t WS_GATE = 360 * MiB;
constexpr size_t WS_END = 416 * MiB;
constexpr int CW_BAR = 4096;

constexpr int RING_OFF = 0, RING_BYTES = 131072;
constexpr int LDS_BYTES = 155648, LDSCTL_OFF = 154624, MISC_OFF = LDSCTL_OFF + 320;
static_assert(MISC_OFF + 128 <= LDS_BYTES, "LDS map");

__device__ __forceinline__ float wave_sum(float v) {
#pragma unroll
    for (int o = 1; o < 64; o <<= 1) v += __shfl_xor(v, o);
    return v;
}
__device__ __forceinline__ float sigmoidf_(float x) { return __builtin_amdgcn_rcpf(1.f + __builtin_amdgcn_exp2f(-x * LOG2E)); }
__device__ __forceinline__ float bf_lo(unsigned v) { return __uint_as_float(v << 16); }
__device__ __forceinline__ float bf_hi(unsigned v) { return __uint_as_float(v & 0xffff0000u); }
typedef unsigned u32x2 __attribute__((ext_vector_type(2)));

__device__ __forceinline__ void p0_transpose_item(const float* W, int ldw, int col0, bf16* WT, int K, int drow0, LAS float* scr, int kb, int lane) {
    const int k0 = 64 * kb;
#pragma unroll 8
    for (int i = 0; i < 32; ++i) { const int kk = 2 * i + (lane >> 5); scr[kk * 33 + (lane & 31)] = W[(size_t)(k0 + kk) * ldw + col0 + (lane & 31)]; }
    LDS_WAIT(); asm volatile("" ::: "memory");
    const int c = lane & 7;
#pragma unroll
    for (int j = 0; j < 4; ++j) { const int n = (lane >> 3) + 8 * j; const LAS float* s = scr + (8 * c) * 33 + n;
        v4u o; o.x = pk2(s[0 * 33], s[1 * 33]); o.y = pk2(s[2 * 33], s[3 * 33]); o.z = pk2(s[4 * 33], s[5 * 33]); o.w = pk2(s[6 * 33], s[7 * 33]);
        *(GAS v4u*)(WT + (size_t)(drow0 + n) * K + k0 + 8 * c) = o; }
    LDS_WAIT(); asm volatile("" ::: "memory");
}
__device__ __forceinline__ float log_sigmoid_(float z) { return fminf(z, 0.f) - log1pf(expf(-fabsf(z))); }

struct P0Args { const float *x, *g1, *w_in, *w_conv_out, *w_fox_out, *w_out, *peer_wq, *k1, *k2, *u, *v, *fox_bf;
                bf16 *WIN, *WC, *WF, *WO, *WQ, *K1b, *K2b, *Ub, *Vb, *XN; float* LOGF; };
__device__ __forceinline__ void p0_prologue(LAS unsigned char* lds, const P0Args& a, int vcu, int G, int tid) {
    const int lane = tid & 63, wave = __builtin_amdgcn_readfirstlane(tid >> 6);
    LAS float* scr = (LAS float*)(lds + wave * 8704);
    LAS float* wfT = (LAS float*)(lds + 69632);
    const int gw = vcu * NWAVES + wave, NGW = G * NWAVES;
    for (int e = tid; e < 16 * 1024; e += NWAVES * 64) { const int d = e >> 4, j = e & 15; wfT[j * 1024 + d] = a.w_in[(size_t)d * INC + 5120 + j]; }
    __syncthreads();
    {
        const GAS f32x4* gp = (const GAS f32x4*)a.g1 + lane; f32x4 gv[4];
#pragma unroll
        for (int j = 0; j < 4; ++j) gv[j] = gp[64 * j];
        const float fb = a.fox_bf[lane & 15];
        for (int m = gw; m < M; m += NGW) {
            const GAS f32x4* xr = (const GAS f32x4*)(a.x + (size_t)m * D) + lane;
            f32x4 v[4]; float s = 0.f;
#pragma unroll
            for (int j = 0; j < 4; ++j) { v[j] = xr[64 * j]; s += (v[j].x * v[j].x + v[j].y * v[j].y) + (v[j].z * v[j].z + v[j].w * v[j].w); }
            const float rstd = 1.0f / sqrtf(wave_sum(s) * (1.f / D) + EPS);
#pragma unroll
            for (int j = 0; j < 4; ++j) v[j] = v[j] * rstd * gv[j];
            GAS unsigned long long* o8 = (GAS unsigned long long*)(a.XN + (size_t)m * D) + lane;
#pragma unroll
            for (int j = 0; j < 4; ++j) o8[64 * j] = (unsigned long long)pk2(v[j].x, v[j].y) | ((unsigned long long)pk2(v[j].z, v[j].w) << 32);
            float mine = 0.f;
#pragma unroll 2
            for (int jj = 0; jj < 16; ++jj) {
                float f = 0.f;
#pragma unroll
                for (int j = 0; j < 4; ++j) { const f32x4 w = *(const LAS f32x4*)(wfT + jj * 1024 + 256 * j + 4 * lane); f += (v[j].x * w.x + v[j].y * w.y) + (v[j].z * w.z + v[j].w * w.w); }
                f = wave_sum(f);
                mine = ((lane & 15) == jj) ? f : mine;
            }
            if (lane < 16) a.LOGF[(size_t)m * 16 + lane] = log_sigmoid_(mine + fb);
        }
    }
    for (int it = gw; it < 6144; it += NGW) {
        int r = it;
        if (r < 512)  { const int nb = r & 31, kb = r >> 5; p0_transpose_item(a.w_in, INC, 32 * nb, a.WIN, D, (nb >> 2) * 256 + (nb & 3) * 32, scr, kb, lane); continue; } r -= 512;
        if (r < 512)  { const int nb = r & 31, kb = r >> 5; p0_transpose_item(a.w_in, INC, 1024 + 32 * nb, a.WIN, D, (nb >> 2) * 256 + 128 + (nb & 3) * 32, scr, kb, lane); continue; } r -= 512;
        if (r < 1536) { const int nb = r % 96, kb = r / 96; p0_transpose_item(a.w_in, INC, 2048 + 32 * nb, a.WIN, D, 2048 + 32 * nb, scr, kb, lane); continue; } r -= 1536;
        if (r < 1024) { const int nb = r & 63, kb = r >> 6; p0_transpose_item(a.w_in, INC, 5136 + 32 * nb, a.WIN, D, 5120 + 32 * nb, scr, kb, lane); continue; } r -= 1024;
        if (r < 512)  { const int nb = r & 31, kb = r >> 5; p0_transpose_item(a.w_conv_out, D, 32 * nb, a.WC, D, 32 * nb, scr, kb, lane); continue; } r -= 512;
        if (r < 512)  { const int nb = r & 31, kb = r >> 5; p0_transpose_item(a.w_fox_out, D, 32 * nb, a.WF, D, 32 * nb, scr, kb, lane); continue; } r -= 512;
        if (r < 512)  { const int nb = r & 31, kb = r >> 5; p0_transpose_item(a.w_out, D, 32 * nb, a.WO, D, 32 * nb, scr, kb, lane); continue; } r -= 512;
        { const int nb = r & 63, kb = r >> 6; p0_transpose_item(a.peer_wq, NQP, 32 * nb, a.WQ, D, 32 * nb, scr, kb, lane); }
    }
    constexpr int I_K = PHEADS * PNK * 128 / 512, I_U = NEXP * D / 512;
    for (int it = gw; it < 2 * I_K + 2 * I_U; it += NGW) {
        int r = it; const float* src; bf16* dst;
        if (r < I_K) { src = a.k1; dst = a.K1b; } else if ((r -= I_K) < I_K) { src = a.k2; dst = a.K2b; } else if ((r -= I_K) < I_U) { src = a.u; dst = a.Ub; } else { r -= I_U; src = a.v; dst = a.Vb; }
        const size_t e0 = (size_t)r * 512 + 8 * lane;
        const f32x4 p = *(const GAS f32x4*)(src + e0), q = *(const GAS f32x4*)(src + e0 + 4);
        v4u o; o.x = pk2(p.x, p.y); o.y = pk2(p.z, p.w); o.z = pk2(q.x, q.y); o.w = pk2(q.z, q.w);
        *(GAS v4u*)(dst + e0) = o;
    }
}

namespace pg8 {
struct EpiP1 {
    static constexpr bool PERM = true, AFTER_DRAIN = false;
    bf16_t *GLU, *Q, *K, *V, *GA, *GB; float qscale;
    __device__ __forceinline__ void operator()(const f32x4 (&acc)[2][2][4][2], const Unit& u, int wr, int wc, int fr, int fq) const {
        const int row0 = u.pm * BM + wr * 64 + fr;
        if (u.pn < 8) {
            const int col = 128 * u.pn + wc * 32 + 8 * fq;
#pragma unroll
            for (int ai = 0; ai < 2; ++ai)
#pragma unroll
                for (int m = 0; m < 4; ++m) {
                    const f32x4 v0 = acc[ai][0][m][0], v1 = acc[ai][0][m][1], g0 = acc[ai][1][m][0], g1 = acc[ai][1][m][1];
                    u32x4 w;
                    w.x = cvt_pk_bf16(v0[0] * sigmoidf_(g0[0]), v0[1] * sigmoidf_(g0[1])); w.y = cvt_pk_bf16(v0[2] * sigmoidf_(g0[2]), v0[3] * sigmoidf_(g0[3]));
                    w.z = cvt_pk_bf16(v1[0] * sigmoidf_(g1[0]), v1[1] * sigmoidf_(g1[1])); w.w = cvt_pk_bf16(v1[2] * sigmoidf_(g1[2]), v1[3] * sigmoidf_(g1[3]));
                    *(u32x4*)(GLU + (size_t)(row0 + ai * HALF + m * 16) * 1024 + col) = w;
                }
        } else {
            const int t = (u.pn - 8) >> 2, colt = ((u.pn - 8) & 3) * 256 + wc * 32 + 8 * fq;
            bf16_t* base = t == 0 ? Q : t == 1 ? K : t == 2 ? V : t == 3 ? GA : GB;
            const float sc = t == 0 ? qscale : 1.f;
#pragma unroll
            for (int ai = 0; ai < 2; ++ai)
#pragma unroll
                for (int m = 0; m < 4; ++m) { bf16_t* rowp = base + (size_t)(row0 + ai * HALF + m * 16) * 1024 + colt;
#pragma unroll
                    for (int bj = 0; bj < 2; ++bj) { f32x4 v0 = acc[ai][bj][m][0], v1 = acc[ai][bj][m][1];
                        if (t >= 3) {
#pragma unroll
                            for (int i = 0; i < 4; ++i) { v0[i] = sigmoidf_(v0[i]); v1[i] = sigmoidf_(v1[i]); }
                        } else { v0 = v0 * sc; v1 = v1 * sc; }
                        u32x4 w; w.x = cvt_pk_bf16(v0[0], v0[1]); w.y = cvt_pk_bf16(v0[2], v0[3]); w.z = cvt_pk_bf16(v1[0], v1[1]); w.w = cvt_pk_bf16(v1[2], v1[3]);
                        *(u32x4*)(rowp + bj * HALF) = w; } }
        }
    }
};
struct EpiDual {
    static constexpr bool PERM = true, AFTER_DRAIN = false;
    const bf16_t *GA, *GB; bf16_t* O;
    __device__ __forceinline__ void operator()(f32x4 (&acc)[2][2][4][2], const Unit& u, int wr, int wc, int fr, int fq) const {
        const int row0 = u.pm * BM + wr * 64 + fr, col0 = u.pn * BM + wc * 32 + 8 * fq;
#pragma unroll
        for (int ai = 0; ai < 2; ++ai)
#pragma unroll
            for (int m = 0; m < 4; ++m)
#pragma unroll
                for (int bj = 0; bj < 2; ++bj) {
                    const size_t off = (size_t)(row0 + ai * HALF + m * 16) * 1024 + col0 + bj * HALF;
                    const u32x4 gb = *(const u32x4*)(GB + off);
                    if (u.seg == 0) {
                        const u32x4 ga = *(const u32x4*)(GA + off);
#pragma unroll
                        for (int i = 0; i < 4; ++i) { const unsigned a_ = ga[i], b_ = gb[i]; const int n = i >> 1, e = (i & 1) * 2;
                            acc[ai][bj][m][n][e]     *= bf_lo(a_) * __builtin_amdgcn_rcpf(fmaxf(bf_lo(b_), 1e-30f));
                            acc[ai][bj][m][n][e + 1] *= bf_hi(a_) * __builtin_amdgcn_rcpf(fmaxf(bf_hi(b_), 1e-30f)); }
                    } else {
                        u32x4 w;
#pragma unroll
                        for (int i = 0; i < 4; ++i) { const unsigned b_ = gb[i]; const int n = i >> 1, e = (i & 1) * 2;
                            w[i] = cvt_pk_bf16(acc[ai][bj][m][n][e] * bf_lo(b_), acc[ai][bj][m][n][e + 1] * bf_hi(b_)); }
                        *(u32x4*)(O + off) = w;
                    }
                }
    }
};
struct DualOrder {
    StaticOrder S; int ntile, G, c;
    __device__ __forceinline__ void init(int M_, int N_, int G_, int c_) { S.init(M_, N_, G_, c_); ntile = S.nwg; G = G_; c = c_; }
    __device__ __forceinline__ bool next(int i, Unit& u) const { if (!S.next(i >> 1, u)) return false; u.seg = i & 1; return true; }
    __device__ __forceinline__ void a_ready(const Unit&) const {}
    __device__ __forceinline__ void done(const Unit&) const {}
};
struct EpiRes {
    static constexpr bool PERM = true, AFTER_DRAIN = false;
    const float* base; float* out;
    __device__ __forceinline__ void operator()(const f32x4 (&acc)[2][2][4][2], const Unit& u, int wr, int wc, int fr, int fq) const {
        const int row0 = u.pm * BM + wr * 64 + fr, col0 = u.pn * BM + wc * 32 + 8 * fq;
#pragma unroll
        for (int ai = 0; ai < 2; ++ai)
#pragma unroll
            for (int m = 0; m < 4; ++m)
#pragma unroll
                for (int bj = 0; bj < 2; ++bj) {
                    const size_t off = (size_t)(row0 + ai * HALF + m * 16) * 1024 + col0 + bj * HALF;
                    const f32x4 b0 = *(const f32x4*)(base + off), b1 = *(const f32x4*)(base + off + 4);
                    *(f32x4*)(out + off) = b0 + acc[ai][bj][m][0]; *(f32x4*)(out + off + 4) = b1 + acc[ai][bj][m][1];
                }
    }
};
}

__device__ __forceinline__ void scan_unit(LAS unsigned char* lds, const float* LOGF, float* C2, int bh, int tid) {
    const int b = bh >> 4, h = bh & 15, lane = tid & 63, wave = tid >> 6;
    LAS float* wtot = (LAS float*)lds;
    float v[8]; float run = 0.f;
#pragma unroll
    for (int i = 0; i < 8; ++i) { run += LOGF[((size_t)b * SEQ + 8 * tid + i) * 16 + h]; v[i] = run; }
    float inc = run;
#pragma unroll
    for (int o = 1; o < 64; o <<= 1) { const float t = __shfl_up(inc, o); if (lane >= o) inc += t; }
    if (lane == 63) wtot[wave] = inc;
    __syncthreads();
    float base = inc - run;
    for (int w = 0; w < wave; ++w) base += wtot[w];
    f32x4 o0, o1;
    o0.x = (base + v[0]) * LOG2E; o0.y = (base + v[1]) * LOG2E; o0.z = (base + v[2]) * LOG2E; o0.w = (base + v[3]) * LOG2E;
    o1.x = (base + v[4]) * LOG2E; o1.y = (base + v[5]) * LOG2E; o1.z = (base + v[6]) * LOG2E; o1.w = (base + v[7]) * LOG2E;
    *(f32x4*)(C2 + (size_t)bh * SEQ + 8 * tid) = o0; *(f32x4*)(C2 + (size_t)bh * SEQ + 8 * tid + 4) = o1;
    __syncthreads();
}
__device__ __forceinline__ void conv_phase(LAS unsigned char* lds, const bf16* GLU, const float* conv_w, const float* conv_b, const float* ln_g, const float* ln_b, bf16* CZ, int vcu, int G, int tid) {
    typedef float f32x2 __attribute__((ext_vector_type(2)));
    LAS float* red = (LAS float*)lds;
    LAS float* fin = (LAS float*)(lds + 65536);
    const int lane = tid & 63;
    float w0[31], w1[31];
#pragma unroll
    for (int j = 0; j < 31; ++j) { const f32x2 t = *(const f32x2*)(conv_w + j * 1024 + 2 * tid); w0[j] = t.x; w1[j] = t.y; }
    const f32x2 cb = *(const f32x2*)(conv_b + 2 * tid), lg = *(const f32x2*)(ln_g + 2 * tid), lb = *(const f32x2*)(ln_b + 2 * tid);
    const unsigned* Gd = (const unsigned*)GLU; unsigned* Cd = (unsigned*)CZ;
    for (int tile = vcu; tile < M / 32; tile += G) {
        const int t0 = tile * 32, sloc = t0 & (SEQ - 1);
        unsigned in[62];
#pragma unroll
        for (int r = 0; r < 62; ++r) in[r] = (sloc - 30 + r >= 0) ? Gd[(size_t)(t0 - 30 + r) * 512 + tid] : 0u;
#pragma unroll
        for (int ch = 0; ch < 2; ++ch) {
            float o0[16], o1[16];
#pragma unroll
            for (int tt = 0; tt < 16; ++tt) { float a0 = cb.x, a1 = cb.y;
#pragma unroll
                for (int j = 0; j < 31; ++j) { const unsigned v = in[16 * ch + tt + j]; a0 += w0[j] * bf_lo(v); a1 += w1[j] * bf_hi(v); }
                o0[tt] = a0; o1[tt] = a1; red[tt * 512 + tid] = a0 + a1; red[(16 + tt) * 512 + tid] = a0 * a0 + a1 * a1; }
            __syncthreads();
            { const int st = tid >> 4, sg = tid & 15; float s = 0.f;
#pragma unroll
              for (int i = 0; i < 8; ++i) { const f32x4 t = *(const LAS f32x4*)(red + st * 512 + sg * 32 + 4 * i); s += (t.x + t.y) + (t.z + t.w); }
              s += __shfl_xor(s, 1); s += __shfl_xor(s, 2); s += __shfl_xor(s, 4); s += __shfl_xor(s, 8);
              if (sg == 0) fin[st] = s; }
            __syncthreads();
#pragma unroll
            for (int tt = 0; tt < 16; ++tt) {
                const float mean = fin[tt] * (1.f / 1024.f), var = fin[16 + tt] * (1.f / 1024.f) - mean * mean, rstd = 1.0f / sqrtf(fmaxf(var, 0.f) + EPS);
                const float y0 = (o0[tt] - mean) * rstd * lg.x + lb.x, y1 = (o1[tt] - mean) * rstd * lg.y + lb.y;
                Cd[(size_t)(t0 + 16 * ch + tt) * 512 + tid] = pk2(y0 * sigmoidf_(y0), y1 * sigmoidf_(y1));
            }
        }
    }
    (void)lane;
}

__device__ __forceinline__ void norm2_phase(const float* X1, const float* g2, bf16* H2, int gw, int NGW, int lane) {
    const GAS f32x4* gp = (const GAS f32x4*)g2 + lane; f32x4 gv[4];
#pragma unroll
    for (int j = 0; j < 4; ++j) gv[j] = gp[64 * j];
    for (int m = gw; m < M; m += NGW) {
        const GAS f32x4* xr = (const GAS f32x4*)(X1 + (size_t)m * D) + lane;
        f32x4 v[4]; float s = 0.f;
#pragma unroll
        for (int j = 0; j < 4; ++j) { v[j] = xr[64 * j]; s += (v[j].x * v[j].x + v[j].y * v[j].y) + (v[j].z * v[j].z + v[j].w * v[j].w); }
        const float rstd = 1.0f / sqrtf(wave_sum(s) * (1.f / D) + EPS);
        GAS unsigned long long* o8 = (GAS unsigned long long*)(H2 + (size_t)m * D) + lane;
#pragma unroll
        for (int j = 0; j < 4; ++j) { const f32x4 t = v[j] * rstd * gv[j]; o8[64 * j] = (unsigned long long)pk2(t.x, t.y) | ((unsigned long long)pk2(t.z, t.w) << 32); }
    }
}

typedef float f32x16 __attribute__((ext_vector_type(16)));
__device__ __forceinline__ unsigned f_ord(float f) { const unsigned b = __float_as_uint(f); return b ^ ((unsigned)((int)b >> 31) | 0x80000000u); }
__device__ __forceinline__ float f_unord(unsigned k) { return __uint_as_float((k & 0x80000000u) ? (k ^ 0x80000000u) : ~k); }
#define CE_DESC(a, b) do { const unsigned hi_ = (a) > (b) ? (a) : (b), lo_ = (a) > (b) ? (b) : (a); (a) = hi_; (b) = lo_; } while (0)
#define CE_ASC(a, b)  do { const unsigned hi_ = (a) > (b) ? (a) : (b), lo_ = (a) > (b) ? (b) : (a); (a) = lo_; (b) = hi_; } while (0)
__device__ __forceinline__ void sort16_desc(unsigned (&v)[16]) {
#pragma unroll
    for (int k = 2; k <= 16; k <<= 1)
#pragma unroll
        for (int j = k >> 1; j > 0; j >>= 1)
#pragma unroll
            for (int i = 0; i < 16; ++i) { const int l = i ^ j; if (l > i) { if ((i & k) == 0) CE_DESC(v[i], v[l]); else CE_ASC(v[i], v[l]); } }
}
__device__ __forceinline__ void merge16_desc(unsigned (&a)[16], const unsigned (&b)[16]) {
#pragma unroll
    for (int i = 0; i < 16; ++i) a[i] = a[i] > b[15 - i] ? a[i] : b[15 - i];
#pragma unroll
    for (int j = 8; j > 0; j >>= 1)
#pragma unroll
        for (int i = 0; i < 16; ++i) { const int l = i ^ j; if (l > i) CE_DESC(a[i], a[l]); }
}
__device__ __forceinline__ void xchg_merge16(unsigned (&a)[16]) {
    unsigned b[16];
#pragma unroll
    for (int i = 0; i < 16; ++i) { auto rr = __builtin_amdgcn_permlane32_swap(a[i], a[i], false, false); b[i] = (threadIdx.x & 32) ? rr[0] : rr[1]; }
    merge16_desc(a, b);
}
__device__ __forceinline__ void route_unit(LAS unsigned char* tabw, const bf16* QP, const bf16* K1b, const bf16* K2b, unsigned short* IDX, float* GATE, int tok0, int head, int lane) {
    const int r = lane & 31, hi = lane >> 5;
    unsigned L[2][16];
#pragma unroll
    for (int half = 0; half < 2; ++half) {
        const bf16* qrow = QP + (size_t)(tok0 + r) * NQP + head * PDK + half * 128 + 8 * hi;
        const bf16* kb = (half ? K2b : K1b) + (size_t)(head * PNK + r) * 128 + 8 * hi;
        bf16x8 bq[8];
#pragma unroll
        for (int s = 0; s < 8; ++s) bq[s] = *(const bf16x8*)(qrow + 16 * s);
        unsigned R[16];
#pragma unroll
        for (int i = 0; i < 16; ++i) R[i] = 0u;
#pragma unroll 1
        for (int nb = 0; nb < 4; ++nb) {
            f32x16 acc = f32x16{};
#pragma unroll
            for (int s = 0; s < 8; ++s) { const bf16x8 ak = *(const bf16x8*)(kb + (size_t)nb * 32 * 128 + 16 * s); acc = __builtin_amdgcn_mfma_f32_32x32x16_bf16(ak, bq[s], acc, 0, 0, 0); }
            unsigned g[16];
#pragma unroll
            for (int q = 0; q < 16; ++q) { const int n = 32 * nb + (q & 3) + 8 * (q >> 2) + 4 * hi; g[q] = (f_ord(acc[q]) & ~127u) | (unsigned)(127 - n); }
            sort16_desc(g);
            merge16_desc(R, g);
        }
        xchg_merge16(R);
#pragma unroll
        for (int i = 0; i < 16; ++i) L[half][i] = R[i];
    }
    {
        LAS unsigned* tp = (LAS unsigned*)(tabw + r * 32 + hi * 16);
#pragma unroll
        for (int d = 0; d < 4; ++d) { unsigned w = 0;
#pragma unroll
            for (int b = 0; b < 4; ++b) { const unsigned k1 = L[0][4 * d + b], k2 = L[1][4 * d + b]; const unsigned n = 127u - ((hi ? k2 : k1) & 127u); w |= n << (8 * b); }
            tp[d] = w; }
    }
    float F1[16], F2[16];
#pragma unroll
    for (int i = 0; i < 16; ++i) { F1[i] = f_unord(L[0][i] & ~127u); F2[i] = f_unord(L[1][i] & ~127u); }
    unsigned c0[16], c1[16];
#define CAND(dst, ai, aj, bi, bj) do { const float f1_ = hi ? F1[bi] : F1[ai], f2_ = hi ? F2[bj] : F2[aj]; \
        dst = (f_ord(f1_ + f2_) & ~255u) | (hi ? (unsigned)(255 - ((bi) * 16 + (bj))) : (unsigned)(255 - ((ai) * 16 + (aj)))); } while (0)
    CAND(c0[0], 0, 0, 1, 0);  CAND(c0[1], 0, 1, 1, 1);  CAND(c0[2], 0, 2, 1, 2);  CAND(c0[3], 0, 3, 1, 3);
    CAND(c0[4], 0, 4, 1, 4);  CAND(c0[5], 0, 5, 1, 5);  CAND(c0[6], 0, 6, 1, 6);  CAND(c0[7], 0, 7, 1, 7);
    CAND(c0[8], 0, 8, 2, 0);  CAND(c0[9], 0, 9, 2, 1);  CAND(c0[10], 0, 10, 2, 2); CAND(c0[11], 0, 11, 2, 3);
    CAND(c0[12], 0, 12, 2, 4); CAND(c0[13], 0, 13, 3, 0); CAND(c0[14], 0, 14, 3, 1); CAND(c0[15], 0, 15, 3, 2);
    CAND(c1[0], 8, 0, 3, 3);  CAND(c1[1], 9, 0, 4, 1);  CAND(c1[2], 10, 0, 4, 2); CAND(c1[3], 11, 0, 5, 0);
    CAND(c1[4], 12, 0, 5, 1); CAND(c1[5], 13, 0, 6, 0); CAND(c1[6], 14, 0, 6, 1); CAND(c1[7], 15, 0, 7, 0);
    CAND(c1[8], 4, 0, 7, 1);
#undef CAND
#pragma unroll
    for (int s = 9; s < 16; ++s) c1[s] = 0u;
    sort16_desc(c0); sort16_desc(c1); merge16_desc(c0, c1); xchg_merge16(c0);
    float sc[16]; float ssum = 0.f;
#pragma unroll
    for (int k = 0; k < 16; ++k) { sc[k] = __builtin_amdgcn_exp2f((f_unord(c0[k] & ~255u) - f_unord(c0[0] & ~255u)) * LOG2E); ssum += sc[k]; }
    const float rs = 1.0f / ssum;
    const LAS unsigned char* tb = (const LAS unsigned char*)(tabw + r * 32);
    unsigned ew[4]; f32x4 g0, g1;
#pragma unroll
    for (int kk = 0; kk < 8; ++kk) {
        unsigned ka_ = c0[kk], kb_ = c0[8 + kk]; float sa_ = sc[kk], sb_ = sc[8 + kk];
        asm volatile("" : "+v"(ka_), "+v"(kb_), "+v"(sa_), "+v"(sb_));
        const unsigned key = hi ? kb_ : ka_; const float gt = (hi ? sb_ : sa_) * rs;
        const unsigned code = 255u - (key & 255u); const unsigned e1 = tb[code >> 4], e2 = tb[16 + (code & 15u)];
        const unsigned e = e1 * 128u + e2;
        if (kk & 1) ew[kk >> 1] |= e << 16; else ew[kk >> 1] = e;
        if (kk < 4) g0[kk] = gt; else g1[kk - 4] = gt;
    }
    const size_t o = (size_t)(tok0 + r) * NSEL + head * PTOPK + 8 * hi;
    *(v4u*)(IDX + o) = (v4u){ew[0], ew[1], ew[2], ew[3]};
    *(f32x4*)(GATE + o) = g0; *(f32x4*)(GATE + o + 4) = g1;
}

__device__ __forceinline__ float gelu_tanh(float x) {
    const float y = 0.7978845608028654f * (x + 0.044715f * x * x * x);
    const float t = 1.f - 2.f * __builtin_amdgcn_rcpf(1.f + __builtin_amdgcn_exp2f(2.f * LOG2E * y));
    return 0.5f * x * (1.f + t);
}
__device__ __forceinline__ float dot8(v4u a, v4u b, float acc) {
#pragma unroll
    for (int i = 0; i < 4; ++i) { acc += bf_lo(a[i]) * bf_lo(b[i]); acc += bf_hi(a[i]) * bf_hi(b[i]); }
    return acc;
}
__device__ __forceinline__ void peer_phase(LAS unsigned char* wl, const bf16* H2, const bf16* Ub, const bf16* Vb, const unsigned short* IDX, const float* GATE, float* XO, const float* gf, int gw, int NGW, int lane) {
    const f32x4 gf0 = *(const f32x4*)(gf + 8 * lane), gf1 = *(const f32x4*)(gf + 8 * lane + 4), gf2 = *(const f32x4*)(gf + 512 + 8 * lane), gf3 = *(const f32x4*)(gf + 512 + 8 * lane + 4);
    LAS unsigned* lid = (LAS unsigned*)wl; LAS float* la = (LAS float*)(wl + 512);
    for (int tok = gw; tok < M; tok += NGW) {
        const v4u hA = *(const v4u*)(H2 + (size_t)tok * D + 8 * lane), hB = *(const v4u*)(H2 + (size_t)tok * D + 512 + 8 * lane);
        lid[lane] = IDX[(size_t)tok * NSEL + lane]; lid[64 + lane] = IDX[(size_t)tok * NSEL + 64 + lane];
#pragma unroll 1
        for (int b = 0; b < 8; ++b) {
            const float gate = GATE[(size_t)tok * NSEL + 16 * b + ((lane >> 2) & 15)];
            float p[16];
#pragma unroll
            for (int e = 0; e < 16; ++e) {
                const unsigned eid = (unsigned)__builtin_amdgcn_readfirstlane((int)lid[16 * b + e]);
                const bf16* row = Ub + (size_t)eid * D;
                const v4u uA = *(const v4u*)(row + 8 * lane), uB = *(const v4u*)(row + 512 + 8 * lane);
                p[e] = dot8(uB, hB, dot8(uA, hA, 0.f));
            }
#pragma unroll
            for (int st = 0; st < 4; ++st) { const int msk = 32 >> st, n = 8 >> st; const bool up = (lane & msk) != 0;
#pragma unroll
                for (int i = 0; i < n; ++i) { const float mine = up ? p[i + n] : p[i], theirs = up ? p[i] : p[i + n]; p[i] = mine + __shfl_xor(theirs, msk); } }
            float d = p[0]; d += __shfl_xor(d, 1); d += __shfl_xor(d, 2);
            if ((lane & 3) == 0) la[16 * b + ((lane >> 2) & 15)] = gelu_tanh(d) * gate;
        }
        float o[16];
#pragma unroll
        for (int i = 0; i < 16; ++i) o[i] = 0.f;
#pragma unroll 1
        for (int b = 0; b < 16; ++b) {
#pragma unroll
            for (int e = 0; e < 8; ++e) {
                const unsigned eid = (unsigned)__builtin_amdgcn_readfirstlane((int)lid[8 * b + e]);
                const float a = la[8 * b + e];
                const bf16* row = Vb + (size_t)eid * D;
                const v4u vA = *(const v4u*)(row + 8 * lane), vB = *(const v4u*)(row + 512 + 8 * lane);
#pragma unroll
                for (int i = 0; i < 4; ++i) { o[2 * i] += a * bf_lo(vA[i]); o[2 * i + 1] += a * bf_hi(vA[i]); o[8 + 2 * i] += a * bf_lo(vB[i]); o[8 + 2 * i + 1] += a * bf_hi(vB[i]); }
            }
        }
        float* xr = XO + (size_t)tok * D;
        f32x4 x0 = *(const f32x4*)(xr + 8 * lane), x1 = *(const f32x4*)(xr + 8 * lane + 4), x2 = *(const f32x4*)(xr + 512 + 8 * lane), x3 = *(const f32x4*)(xr + 512 + 8 * lane + 4);
        x0 += (f32x4){o[0], o[1], o[2], o[3]}; x1 += (f32x4){o[4], o[5], o[6], o[7]}; x2 += (f32x4){o[8], o[9], o[10], o[11]}; x3 += (f32x4){o[12], o[13], o[14], o[15]};
        float s = 0.f;
#pragma unroll
        for (int i = 0; i < 4; ++i) s += x0[i] * x0[i] + x1[i] * x1[i] + x2[i] * x2[i] + x3[i] * x3[i];
        const float rstd = 1.0f / sqrtf(wave_sum(s) * (1.f / D) + EPS);
        *(f32x4*)(xr + 8 * lane) = x0 * rstd * gf0; *(f32x4*)(xr + 8 * lane + 4) = x1 * rstd * gf1;
        *(f32x4*)(xr + 512 + 8 * lane) = x2 * rstd * gf2; *(f32x4*)(xr + 512 + 8 * lane + 4) = x3 * rstd * gf3;
    }
}

constexpr int N_PHASES = 10;
#ifndef MK_FUSED
#define MK_FUSED 0
#endif
struct Args { const float* in[18]; float* out; unsigned char* ws; int ph_lo, ph_hi; };
__global__ void __launch_bounds__(NWAVES * 64, 2) hyb_fwd(Args args) {
    extern __shared__ __attribute__((aligned(16))) unsigned char lds[];
    LAS unsigned char* L = (LAS unsigned char*)lds;
    volatile LAS unsigned* MISC = (volatile LAS unsigned*)(L + MISC_OFF);
    const int tid = threadIdx.x, lane = tid & 63, wave = __builtin_amdgcn_readfirstlane(tid >> 6);
    const int G = gridDim.x; const int bx = blockIdx.x; const int vcu = (G % 8 == 0) ? (bx % 8) * (G / 8) + bx / 8 : bx;
    const int gw = vcu * NWAVES + wave, NGW = G * NWAVES;
    unsigned char* ws = args.ws;
    gu32* ctl = (gu32*)(ws + WS_CTL);
    const float* x = args.in[0]; float* out = args.out;
    bf16 *WIN = (bf16*)(ws + WS_WIN), *WC = (bf16*)(ws + WS_WC), *WF = (bf16*)(ws + WS_WF), *WO = (bf16*)(ws + WS_WO), *WQ = (bf16*)(ws + WS_WQ);
    bf16 *K1b = (bf16*)(ws + WS_K1), *K2b = (bf16*)(ws + WS_K2), *Ub = (bf16*)(ws + WS_U), *Vb = (bf16*)(ws + WS_VT);
    bf16 *XN = (bf16*)(ws + WS_XN), *CZ = XN, *GLU = (bf16*)(ws + WS_GLU), *MM = GLU, *QO = (bf16*)(ws + WS_QO), *KB = (bf16*)(ws + WS_K), *H2 = KB, *VB = (bf16*)(ws + WS_V);
    bf16 *QP = (bf16*)(ws + WS_QP), *GA = (bf16*)out, *GB = (bf16*)out + (size_t)M * D;
    float *LOGF = (float*)(ws + WS_LOGF), *C2 = (float*)(ws + WS_C2), *GATE = (float*)(ws + WS_GATE);
    unsigned short* IDX = (unsigned short*)(ws + WS_IDX);
    for (int u = tid; u < (LDS_BYTES - LDSCTL_OFF) / 4; u += NWAVES * 64) ((LAS unsigned*)(L + LDSCTL_OFF))[u] = 0u;
    __syncthreads();
#if MK_FUSED
    XcdBarrier bar = xcd_barrier_post((unsigned*)(ctl + CW_BAR), MISC + 8);
#define GRID_BAR() xcd_barrier(bar)
#else
#define GRID_BAR() do {} while (0)
    (void)MISC; (void)ctl;
#endif
    const int lo = args.ph_lo, hi = args.ph_hi;
#ifdef ONLY_PHASE
#define IN(k) ((k) == ONLY_PHASE)
#else
#define IN(k) (lo <= (k) && (k) < hi)
#endif
#define BOTH(k) (IN(k) && IN((k) + 1))

    if (IN(0)) {
        P0Args a{x, args.in[1], args.in[2], args.in[7], args.in[9], args.in[10], args.in[12], args.in[13], args.in[14], args.in[15], args.in[16], args.in[8],
                 WIN, WC, WF, WO, WQ, K1b, K2b, Ub, Vb, XN, LOGF};
        p0_prologue(L, a, vcu, G, tid);
        if (BOTH(0)) GRID_BAR();
    }
    if (IN(1)) {
        pg8::Gemm g{XN, XN, WIN, WIN, M, N1, D}; pg8::StaticOrder S; S.init(M, N1, G, bx);
        pg8::EpiP1 E{GLU, QO, KB, VB, GA, GB, attn_body::C2};
        pg8::gemm_phase<pg8::EpiP1, pg8::StaticOrder, true, true>(L + RING_OFF, g, S, E);
        if (BOTH(1)) GRID_BAR();
    }
    if (IN(2)) {
        for (int bh = vcu; bh < BATCH * NHEADS; bh += G) scan_unit(L, LOGF, C2, bh, tid);
        conv_phase(L, GLU, args.in[3], args.in[4], args.in[5], args.in[6], CZ, vcu, G, tid);
        if (BOTH(2)) GRID_BAR();
    }
    if (IN(3)) {
        const attn_body::AttnTensors AT{(const attn_body::bf16*)QO, (const attn_body::bf16*)KB, (const attn_body::bf16*)VB, (attn_body::bf16*)QO, C2};
        const attn_body::StaticOrder S(G, bx);
        attn_body::attn_phase<attn_body::StaticOrder>((char*)lds + RING_OFF, AT, S);
        if (BOTH(3)) GRID_BAR();
    }
    if (IN(4)) {
        pg8::Gemm g{CZ, QO, WC, WF, M, D, D}; pg8::DualOrder S; S.init(M, D, G, bx);
        pg8::EpiDual E{GA, GB, MM};
        pg8::gemm_phase<pg8::EpiDual, pg8::DualOrder, true, true>(L + RING_OFF, g, S, E);
        if (BOTH(4)) GRID_BAR();
    }
    if (IN(5)) {
        pg8::Gemm g{MM, MM, WO, WO, M, D, D}; pg8::StaticOrder S; S.init(M, D, G, bx);
        pg8::EpiRes E{x, out};
        pg8::gemm_phase<pg8::EpiRes, pg8::StaticOrder, true, true>(L + RING_OFF, g, S, E);
        if (BOTH(5)) GRID_BAR();
    }
    if (IN(6)) { norm2_phase(out, args.in[11], H2, gw, NGW, lane); if (BOTH(6)) GRID_BAR(); }
    if (IN(7)) {
        pg8::Gemm g{H2, H2, WQ, WQ, M, NQP, D}; pg8::StaticOrder S; S.init(M, NQP, G, bx);
        pg8::EpiBf16<0> E{QP, NQP, nullptr, 0, 0, 1.f};
        pg8::gemm_phase<pg8::EpiBf16<0>, pg8::StaticOrder, true, true>(L + RING_OFF, g, S, E);
        if (BOTH(7)) GRID_BAR();
    }
    if (IN(8)) {
        for (int uidx = gw; uidx < (M / 32) * PHEADS; uidx += NGW) route_unit(L + wave * 1024, QP, K1b, K2b, IDX, GATE, (uidx >> 3) * 32, uidx & 7, lane);
        if (BOTH(8)) GRID_BAR();
    }
    if (IN(9)) peer_phase(L + wave * 1024, H2, Ub, Vb, IDX, GATE, out, args.in[17], gw, NGW, lane);
#undef IN
#undef BOTH
}

extern "C" void kernel_launch(void* const* d_in, const int* in_sizes, int n_in, void* d_out, int out_size, void* d_ws, size_t ws_size, hipStream_t stream) {
    static int grid = 0;
    if (grid == 0) {
        if (n_in != 18 || in_sizes[0] != M * D || out_size != M * D || ws_size < WS_END) { fprintf(stderr, "kernel_launch: unexpected shapes (n_in %d, ws %zu)\n", n_in, ws_size); grid = -1; return; }
        int dev = 0, cus = 0, per_cu = 0;
        if (hipGetDevice(&dev) != hipSuccess || hipDeviceGetAttribute(&cus, hipDeviceAttributeMultiprocessorCount, dev) != hipSuccess) { grid = -1; return; }
        if (hipFuncSetAttribute((const void*)hyb_fwd, hipFuncAttributeMaxDynamicSharedMemorySize, LDS_BYTES) != hipSuccess) { fprintf(stderr, "kernel_launch: hipFuncSetAttribute failed\n"); grid = -1; return; }
        if (hipOccupancyMaxActiveBlocksPerMultiprocessor(&per_cu, (const void*)hyb_fwd, NWAVES * 64, LDS_BYTES) != hipSuccess || per_cu < 1) { fprintf(stderr, "kernel_launch: occupancy query says %d\n", per_cu); per_cu = 1; }
        (void)hipGetLastError();
        grid = cus;
    }
    if (grid < 0) return;
    Args a{};
    for (int i = 0; i < 18; ++i) a.in[i] = (const float*)d_in[i];
    a.out = (float*)d_out; a.ws = (unsigned char*)d_ws;
#if MK_FUSED
    (void)hipMemsetAsync((char*)d_ws + WS_CTL, 0, CTL_ZERO_BYTES, stream);
    a.ph_lo = 0; a.ph_hi = N_PHASES;
    void* kargs[] = {&a};
    hipError_t e = hipLaunchCooperativeKernel((const void*)hyb_fwd, dim3(grid), dim3(NWAVES * 64), kargs, LDS_BYTES, stream);
    if (e != hipSuccess) fprintf(stderr, "kernel_launch: cooperative launch failed: %s\n", hipGetErrorString(e));
#else
    for (int p = 0; p < N_PHASES; ++p) { a.ph_lo = p; a.ph_hi = p + 1; hipLaunchKernelGGL(hyb_fwd, dim3(grid), dim3(NWAVES * 64), LDS_BYTES, stream, a); }
#endif
}
```

```cpp
#include <hip/hip_runtime.h>
#include <hip/hip_bf16.h>
#include <cstdio>
#include <cstdint>
#include <cmath>
namespace pg8 {
#define PG8_LAS __attribute__((address_space(3)))
typedef unsigned short bf16_t;
typedef short bf16x8 __attribute__((ext_vector_type(8)));
typedef float f32x4 __attribute__((ext_vector_type(4)));
typedef unsigned u32x4 __attribute__((ext_vector_type(4)));
constexpr int BM = 256, BK = 64, HALF = 128, HTB = HALF * BK * 2  , STAGE_BYTES = 8 * HTB, NXCD = 8, WGM = 8;

__host__ __device__ __forceinline__ int lds_byte(int r, int c) { const int st = (r >> 4) * 2 + (c >> 5), rr = r & 15, cc = c & 31, ob = rr * 64 + cc * 2; return st * 1024 + (ob ^ (((ob >> 9) & 1) << 5)); }
__host__ __device__ __forceinline__ void stage_rc(int b, int& R, int& C) { const int st = b / 1024, sb = b % 1024, swz = sb ^ (((sb >> 9) & 1) << 5); R = (st >> 1) * 16 + swz / 64; C = (st & 1) * 32 + (swz % 64) / 2; }
__host__ __device__ __forceinline__ int perm32(int rho) { const int n = rho >> 4, i = rho & 15; return 8 * (i >> 2) + 4 * n + (i & 3); }

struct Unit { int pm, pn, seg; };
struct Gemm { const bf16_t *A0, *A1, *B0, *B1; int M, N, K; };

struct StaticOrder {
    int nM, nN, nwg, G, c;
    __host__ __device__ __forceinline__ void init(int M, int N, int G_, int c_) { nM = M / BM; nN = N / BM; nwg = nM * nN; G = G_; c = c_; }
    __host__ __device__ __forceinline__ bool next(int i, Unit& u) const {
        const long L = (long)i * G + c; if (L >= nwg) return false;
        int wgid = (int)L; { const int q = nwg / NXCD, r = nwg % NXCD, xcd = wgid % NXCD, off = wgid / NXCD; wgid = (xcd < r ? xcd * (q + 1) : r * (q + 1) + (xcd - r) * q) + off; }
        const int nig = WGM * nN, gid = wgid / nig, fm = gid * WGM, gsz = (nM - fm) < WGM ? (nM - fm) : WGM;
        u.pm = fm + ((wgid % nig) % gsz); u.pn = (wgid % nig) / gsz; u.seg = 0; return true;
    }
    __device__ __forceinline__ void a_ready(const Unit&) const {}
    __device__ __forceinline__ void done(const Unit&) const {}
};

__device__ __forceinline__ unsigned cvt_pk_bf16(float lo, float hi) { unsigned r; asm volatile("v_cvt_pk_bf16_f32 %0, %1, %2" : "=v"(r) : "v"(lo), "v"(hi)); return r; }
typedef float f32x2 __attribute__((ext_vector_type(2)));
__device__ __forceinline__ f32x2 gelu_pk(f32x2 v) {
    const f32x2 av = __builtin_elementwise_abs(v), d = av * 0.2316418882f + 1.0f;
    f32x2 t; t.x = __builtin_amdgcn_rcpf(d.x); t.y = __builtin_amdgcn_rcpf(d.y);
    f32x2 q = t * 0.5307027145f + (-0.7265760135f); q = q * t + 0.7107068705f; q = q * t + (-0.142248368f); q = q * t + 0.127414796f; q = q * t;
    const f32x2 s = (v * v) * (-0.72134752044f);
    f32x2 e; e.x = __builtin_amdgcn_exp2f(s.x); e.y = __builtin_amdgcn_exp2f(s.y);
    const f32x2 m = v * (q * e), r = v - m;
    f32x2 o; o.x = v.x < 0.f ? m.x : r.x; o.y = v.y < 0.f ? m.y : r.y; return o;
}

template <int ACT  > struct EpiBf16 {
    static constexpr bool PERM = true, AFTER_DRAIN = false; static_assert(ACT == 0 || ACT == 1, "EpiBf16: ACT is 0 (none) or 1 (gelu_pk)");
    bf16_t* O; int ldc; const float* bias; int split_cols; size_t split_stride; float scale0;
    __device__ __forceinline__ void operator()(const f32x4 (&acc)[2][2][4][2], const Unit& u, int wr, int wc, int fr, int fq) const {
        const int row0 = u.pm * BM + wr * 64 + fr; int colt = u.pn * BM; bf16_t* base = O;
        float sc = 1.f; if (split_cols) { const int t = colt / split_cols; base += (size_t)t * split_stride; colt -= t * split_cols; if (t == 0) sc = scale0; }
        const int col0 = colt + wc * 32 + 8 * fq, bcol0 = u.pn * BM + wc * 32 + 8 * fq;
        f32x4 bv[2][2];
#pragma unroll
        for (int bj = 0; bj < 2; ++bj)
#pragma unroll
            for (int n = 0; n < 2; ++n) bv[bj][n] = bias ? *(const f32x4*)(bias + bcol0 + bj * HALF + 4 * n) : (f32x4){0.f, 0.f, 0.f, 0.f};
#pragma unroll
        for (int ai = 0; ai < 2; ++ai)
#pragma unroll
            for (int m = 0; m < 4; ++m) { bf16_t* rowp = base + (size_t)(row0 + ai * HALF + m * 16) * ldc + col0;
#pragma unroll
                for (int bj = 0; bj < 2; ++bj) { f32x4 v0 = acc[ai][bj][m][0] + bv[bj][0], v1 = acc[ai][bj][m][1] + bv[bj][1];
                    if (ACT == 1) { f32x2 a = gelu_pk((f32x2){v0[0], v0[1]}), b = gelu_pk((f32x2){v0[2], v0[3]}), c = gelu_pk((f32x2){v1[0], v1[1]}), d = gelu_pk((f32x2){v1[2], v1[3]});
                        v0 = (f32x4){a.x, a.y, b.x, b.y}; v1 = (f32x4){c.x, c.y, d.x, d.y}; }
                    v0 = v0 * sc; v1 = v1 * sc; u32x4 w; w.x = cvt_pk_bf16(v0[0], v0[1]); w.y = cvt_pk_bf16(v0[2], v0[3]); w.z = cvt_pk_bf16(v1[0], v1[1]); w.w = cvt_pk_bf16(v1[2], v1[3]);
                    *(u32x4*)(rowp + bj * HALF) = w; } }
    }
};

struct PanelStats {
    unsigned* xbuf;
    unsigned* cnt;
    unsigned* tmo;
    int ntn; float eps;
    unsigned code;
    __device__ __forceinline__ bool run(const f32x4 (&v)[2][2][4][2], const Unit& u, int wr, int wc, int fr, int fq, PG8_LAS unsigned char* lds, int wid, int lane) const {
        typedef float f32x2v __attribute__((ext_vector_type(2)));
        PG8_LAS f32x2v* P = (PG8_LAS f32x2v*)lds;
        PG8_LAS f32x2v* S = (PG8_LAS f32x2v*)(lds + 8192);
        PG8_LAS unsigned* flag = (PG8_LAS unsigned*)(lds + 8192 + 2048);
#pragma unroll
        for (int ai = 0; ai < 2; ++ai)
#pragma unroll
            for (int m = 0; m < 4; ++m) {
                float s = 0.f;
#pragma unroll
                for (int bj = 0; bj < 2; ++bj)
#pragma unroll
                    for (int n = 0; n < 2; ++n) { const f32x4 x = v[ai][bj][m][n]; s += (x[0] + x[1]) + (x[2] + x[3]); }
                s += __shfl_xor(s, 16); s += __shfl_xor(s, 32);
                const float mw = s * (1.0f / 64.0f); float q = 0.f;
#pragma unroll
                for (int bj = 0; bj < 2; ++bj)
#pragma unroll
                    for (int n = 0; n < 2; ++n) { const f32x4 d = v[ai][bj][m][n] - mw; q += (d[0] * d[0] + d[1] * d[1]) + (d[2] * d[2] + d[3] * d[3]); }
                q += __shfl_xor(q, 16); q += __shfl_xor(q, 32);
                if (fq == 0) P[(ai * HALF + wr * 64 + m * 16 + fr) * 4 + wc] = (f32x2v){mw, q};
            }
        asm volatile("s_waitcnt lgkmcnt(0)" ::: "memory"); __builtin_amdgcn_s_barrier(); asm volatile("" ::: "memory");
#if defined(BROKEN_EXCHANGE_NO_WAIT)
#warning BROKEN CONTROL BUILD: the row-statistics exchange does not wait; results are wrong by design
        if (blockIdx.x >= 64) { const long long t0_ = clock64(); while (clock64() - t0_ < 60000) __builtin_amdgcn_s_sleep(8); }
#endif
        const int row = wid * 32 + (lane & 31);
        if (lane < 32) {
            const f32x2v a = P[row * 4 + 0], b = P[row * 4 + 1], c = P[row * 4 + 2], d = P[row * 4 + 3];
            const float mt = (a.x + b.x + c.x + d.x) * 0.25f;
            const float da = a.x - mt, db = b.x - mt, dc = c.x - mt, dd = d.x - mt;
            const float m2 = (a.y + b.y) + (c.y + d.y) + 64.0f * ((da * da + db * db) + (dc * dc + dd * dd));
            unsigned long long* slot = (unsigned long long*)xbuf + ((size_t)(u.pm * BM + row) * 4 + u.pn);
            __hip_atomic_store(slot, ((unsigned long long)__float_as_uint(m2) << 32) | __float_as_uint(mt), __ATOMIC_RELAXED, __HIP_MEMORY_SCOPE_AGENT);
        }
        asm volatile("s_waitcnt vmcnt(0)" ::: "memory");
        if (lane == 0) __hip_atomic_fetch_add(cnt + 64 * u.pm, 1u, __ATOMIC_RELAXED, __HIP_MEMORY_SCOPE_AGENT);
        if (wid == 0) {
            bool dead = false; const unsigned long long t0 = __builtin_amdgcn_s_memrealtime(); const unsigned want = 8u * (unsigned)ntn;
            for (;;) {
#if defined(BROKEN_EXCHANGE_NO_WAIT)
                break;
#endif
                if ((unsigned)__builtin_amdgcn_readfirstlane(__hip_atomic_load(cnt + 64 * u.pm, __ATOMIC_RELAXED, __HIP_MEMORY_SCOPE_AGENT)) >= want) break;
                if (__builtin_amdgcn_s_memrealtime() - t0 > 2000000ull) {
                    if (lane == 0) { unsigned expect = 0u; __hip_atomic_compare_exchange_strong(tmo + 1, &expect, code | (unsigned)(u.pm & 0xff), __ATOMIC_RELAXED, __ATOMIC_RELAXED, __HIP_MEMORY_SCOPE_AGENT);
                                     __hip_atomic_store(tmo, 1u, __ATOMIC_RELAXED, __HIP_MEMORY_SCOPE_AGENT); }
                    dead = true; break; }
                __builtin_amdgcn_s_sleep(2);
            }
            __builtin_amdgcn_fence(__ATOMIC_ACQUIRE, "agent");
            if (lane == 0) flag[0] = dead ? 1u : 0u;
        }
        asm volatile("s_waitcnt vmcnt(0) lgkmcnt(0)" ::: "memory"); __builtin_amdgcn_s_barrier(); asm volatile("" ::: "memory");
        const bool bad = flag[0] != 0u;
        if (lane < 32) {
            const unsigned long long* slot = (const unsigned long long*)xbuf + (size_t)(u.pm * BM + row) * 4; float mt[4], m2[4]; float ms = 0.f;
#pragma unroll
            for (int t = 0; t < 4; ++t) { if (t < ntn) { const unsigned long long w = __hip_atomic_load(slot + t, __ATOMIC_RELAXED, __HIP_MEMORY_SCOPE_AGENT); mt[t] = __uint_as_float((unsigned)w); m2[t] = __uint_as_float((unsigned)(w >> 32)); } else { mt[t] = 0.f; m2[t] = 0.f; } ms += mt[t]; }
            const float mean = ms / (float)ntn; float q = 0.f;
#pragma unroll
            for (int t = 0; t < 4; ++t) if (t < ntn) { const float dm = mt[t] - mean; q += m2[t] + 256.0f * dm * dm; }
            S[row] = (f32x2v){mean, 1.0f / sqrtf(q / (256.0f * (float)ntn) + eps)};
        }
        asm volatile("s_waitcnt lgkmcnt(0)" ::: "memory"); __builtin_amdgcn_s_barrier(); asm volatile("" ::: "memory");
        return bad;
    }
};
struct EpiLnRes {
    static constexpr bool PERM = false, AFTER_DRAIN = true;
    const float* base; float* out; int ldc; const float* bias; PanelStats st; unsigned poison;
    __device__ __forceinline__ void fused(f32x4 (&acc)[2][2][4][2], const Unit& u, int wr, int wc, int fr, int fq, PG8_LAS unsigned char* lds, int wid, int lane) const {
        typedef float f32x2v __attribute__((ext_vector_type(2)));
        const PG8_LAS f32x2v* S = (const PG8_LAS f32x2v*)(lds + 8192);
        const int col0 = u.pn * BM + wc * 32 + 4 * fq;
#pragma unroll
        for (int bj = 0; bj < 2; ++bj)
#pragma unroll
            for (int n = 0; n < 2; ++n) { const f32x4 bv = bias ? *(const f32x4*)(bias + col0 + bj * HALF + n * 16) : (f32x4){0.f, 0.f, 0.f, 0.f};
#pragma unroll
                for (int ai = 0; ai < 2; ++ai)
#pragma unroll
                    for (int m = 0; m < 4; ++m) acc[ai][bj][m][n] += bv; }
        f32x4 pre[4][2][2];
#pragma unroll
        for (int m = 0; m < 4; ++m) { const size_t off = (size_t)(u.pm * BM + wr * 64 + m * 16 + fr) * ldc + col0;
#pragma unroll
            for (int bj = 0; bj < 2; ++bj)
#pragma unroll
                for (int n = 0; n < 2; ++n) pre[m][bj][n] = *(const f32x4*)(base + off + bj * HALF + n * 16); }
        const bool bad = st.run(acc, u, wr, wc, fr, fq, lds, wid, lane) || poison != 0u;
        const float qnan = __builtin_nanf("");
#pragma unroll
        for (int ai = 0; ai < 2; ++ai)
#pragma unroll
            for (int m = 0; m < 4; ++m) { const int r = ai * HALF + wr * 64 + m * 16 + fr; const f32x2v sr = S[r]; const size_t off = (size_t)(u.pm * BM + r) * ldc + col0;
#pragma unroll
                for (int bj = 0; bj < 2; ++bj)
#pragma unroll
                    for (int n = 0; n < 2; ++n) { const f32x4 bs = ai == 0 ? pre[m][bj][n] : *(const f32x4*)(base + off + bj * HALF + n * 16); f32x4 o = bs + (acc[ai][bj][m][n] - sr.x) * sr.y;
                        if (bad) o = (f32x4){qnan, qnan, qnan, qnan}; *(f32x4*)(out + off + bj * HALF + n * 16) = o; }
                if (m & 1) asm volatile("" ::: "memory"); }
    }
};
struct EpiLnResLn {
    static constexpr bool PERM = false, AFTER_DRAIN = true;
    const float* base; float* out; bf16_t* xn; int ldc; const float* bias; PanelStats st1, st2; unsigned poison;
    __device__ __forceinline__ void fused(f32x4 (&acc)[2][2][4][2], const Unit& u, int wr, int wc, int fr, int fq, PG8_LAS unsigned char* lds, int wid, int lane) const {
        typedef float f32x2v __attribute__((ext_vector_type(2))); typedef unsigned u32x2v __attribute__((ext_vector_type(2)));
        const PG8_LAS f32x2v* S = (const PG8_LAS f32x2v*)(lds + 8192);
        const int col0 = u.pn * BM + wc * 32 + 4 * fq;
#pragma unroll
        for (int bj = 0; bj < 2; ++bj)
#pragma unroll
            for (int n = 0; n < 2; ++n) { const f32x4 bv = bias ? *(const f32x4*)(bias + col0 + bj * HALF + n * 16) : (f32x4){0.f, 0.f, 0.f, 0.f};
#pragma unroll
                for (int ai = 0; ai < 2; ++ai)
#pragma unroll
                    for (int m = 0; m < 4; ++m) acc[ai][bj][m][n] += bv; }
        bool bad = st1.run(acc, u, wr, wc, fr, fq, lds, wid, lane) || poison != 0u;
        const float qnan = __builtin_nanf("");
#pragma unroll
        for (int ai = 0; ai < 2; ++ai)
#pragma unroll
            for (int m = 0; m < 4; ++m) { const int r = ai * HALF + wr * 64 + m * 16 + fr; const f32x2v sr = S[r]; const size_t off = (size_t)(u.pm * BM + r) * ldc + col0;
#pragma unroll
                for (int bj = 0; bj < 2; ++bj)
#pragma unroll
                    for (int n = 0; n < 2; ++n) { const f32x4 bs = *(const f32x4*)(base + off + bj * HALF + n * 16); acc[ai][bj][m][n] = bs + (acc[ai][bj][m][n] - sr.x) * sr.y; }
                asm volatile("" : "+v"(acc[ai][0][m][0]), "+v"(acc[ai][0][m][1]), "+v"(acc[ai][1][m][0]), "+v"(acc[ai][1][m][1]));
                if (m & 1) asm volatile("" ::: "memory"); }
        const bool bad1 = bad;
        bad = st2.run(acc, u, wr, wc, fr, fq, lds, wid, lane) || bad;
#pragma unroll
        for (int ai = 0; ai < 2; ++ai)
#pragma unroll
            for (int m = 0; m < 4; ++m) { const int r = ai * HALF + wr * 64 + m * 16 + fr; const f32x2v sr = S[r]; const size_t off = (size_t)(u.pm * BM + r) * ldc + col0;
#pragma unroll
                for (int bj = 0; bj < 2; ++bj)
#pragma unroll
                    for (int n = 0; n < 2; ++n) { const f32x4 x1 = acc[ai][bj][m][n]; *(f32x4*)(out + off + bj * HALF + n * 16) = bad1 ? (f32x4){qnan, qnan, qnan, qnan} : x1;
                        const f32x4 o = (x1 - sr.x) * sr.y; u32x2v w; w.x = cvt_pk_bf16(o[0], o[1]); w.y = cvt_pk_bf16(o[2], o[3]);
                        if (bad) { w.x = 0x7fc07fc0u; w.y = 0x7fc07fc0u; } *(u32x2v*)(xn + off + bj * HALF + n * 16) = w; }
                asm volatile("" ::: "memory"); }
    }
};

template <class Epi, class Sched, bool ALIGN_EPI = false, bool SP2 = false>
__device__ __forceinline__ void gemm_phase(PG8_LAS unsigned char* lds, const Gemm g, const Sched& S, const Epi& E) {
    const int tid = threadIdx.x, wid = __builtin_amdgcn_readfirstlane(tid >> 6), lane = tid & 63, wr = wid >> 2, wc = wid & 3, fr = lane & 15, fq = lane >> 4;
    const int K = g.K, nt = K / BK;
    unsigned voffA[2], voffB[2];
#pragma unroll
    for (int i = 0; i < 2; ++i) { int R, C; stage_rc(tid * 16 + i * 8192, R, C); const int Rb = Epi::PERM ? ((R & ~31) + perm32(R & 31)) : R;
        voffA[i] = (unsigned)(R * K + C) * 2u; voffB[i] = (unsigned)(Rb * K + C) * 2u; }
    const size_t kstep = (size_t)(BK * 2);
    const size_t hstep = (size_t)HALF * K * 2;
    const size_t tstep = 2 * hstep;
    const unsigned ldsw = (unsigned)wid * 1024u;
    const int aoff = lds_byte(wr * 64 + fr, fq * 8), boff = lds_byte(wc * 32 + fr, fq * 8);
#define PG8_SA(b, h) (((b) * 2 + (h)) * HTB)
#define PG8_SB(b, h) ((4 + (b) * 2 + (h)) * HTB)
#define PG8_STAGE(bufoff, gbase, voff) do { _Pragma("unroll") for (int _i = 0; _i < 2; ++_i) \
        __builtin_amdgcn_global_load_lds((const unsigned*)((const char*)(gbase) + (voff)[_i]), (PG8_LAS unsigned*)(lds + (bufoff) + ldsw + _i * 8192), 16, 0, 0); } while (0)
#define PG8_LDA(dst, b, h) do { _Pragma("unroll") for (int m = 0; m < 4; ++m) _Pragma("unroll") for (int k = 0; k < 2; ++k) dst[m][k] = *(const PG8_LAS bf16x8*)(lds + PG8_SA(b, h) + aoff + m * 2048 + k * 1024); } while (0)
#define PG8_LDB(dst, b, h) do { _Pragma("unroll") for (int n = 0; n < 2; ++n) _Pragma("unroll") for (int k = 0; k < 2; ++k) dst[n][k] = *(const PG8_LAS bf16x8*)(lds + PG8_SB(b, h) + boff + n * 2048 + k * 1024); } while (0)
#define PG8_MMA(ai, bj, At, Bt) do { __builtin_amdgcn_s_setprio(1); _Pragma("unroll") for (int m = 0; m < 4; ++m) _Pragma("unroll") for (int n = 0; n < 2; ++n) _Pragma("unroll") for (int k = 0; k < 2; ++k) \
        acc[ai][bj][m][n] = __builtin_amdgcn_mfma_f32_16x16x32_bf16(Bt[n][k], At[m][k], acc[ai][bj][m][n], 0, 0, 0); __builtin_amdgcn_s_setprio(0); } while (0)
#define PG8_WAIT_V(n) asm volatile("s_waitcnt vmcnt(" #n ")" ::: "memory")
#define PG8_WAIT_L(n) asm volatile("s_waitcnt lgkmcnt(" #n ")" ::: "memory")
#define PG8_BAR __builtin_amdgcn_s_barrier()
#define PG8_SCHED __builtin_amdgcn_sched_barrier(0)
    Unit cur, nxt; int ui = 0;
    if (!S.next(0, cur)) return;
    f32x4 acc[2][2][4][2];
#pragma unroll
    for (int a = 0; a < 2; ++a)
#pragma unroll
        for (int b = 0; b < 2; ++b)
#pragma unroll
            for (int m = 0; m < 4; ++m)
#pragma unroll
                for (int n = 0; n < 2; ++n) acc[a][b][m][n] = (f32x4){0.f, 0.f, 0.f, 0.f};
    bf16x8 At[4][2], B0[2][2], B1[2][2];
    const char* cA = (const char*)(cur.seg ? g.A1 : g.A0) + (size_t)cur.pm * tstep; const char* cB = (const char*)(cur.seg ? g.B1 : g.B0) + (size_t)cur.pn * tstep;
    S.a_ready(cur);
    if constexpr (SP2) {
        PG8_STAGE(PG8_SB(0, 0), cB, voffB); PG8_STAGE(PG8_SB(0, 1), cB + hstep, voffB); PG8_STAGE(PG8_SA(0, 0), cA, voffA); PG8_STAGE(PG8_SA(0, 1), cA + hstep, voffA);
        if (wr == 1) PG8_BAR;
        PG8_WAIT_V(2); PG8_BAR;
        PG8_STAGE(PG8_SB(1, 0), cB + kstep, voffB); PG8_STAGE(PG8_SA(1, 0), cA + kstep, voffA); PG8_STAGE(PG8_SB(1, 1), cB + hstep + kstep, voffB);
        PG8_WAIT_V(6); PG8_BAR;
    } else {
        PG8_STAGE(PG8_SB(0, 0), cB, voffB); PG8_STAGE(PG8_SA(0, 0), cA, voffA); PG8_STAGE(PG8_SB(0, 1), cB + hstep, voffB); PG8_STAGE(PG8_SA(0, 1), cA + hstep, voffA);
        if (wr == 1) PG8_BAR;
        PG8_WAIT_V(4); PG8_BAR;
        PG8_STAGE(PG8_SB(1, 0), cB + kstep, voffB); PG8_STAGE(PG8_SA(1, 0), cA + kstep, voffA); PG8_STAGE(PG8_SB(1, 1), cB + hstep + kstep, voffB);
        PG8_WAIT_V(6); PG8_BAR;
    }
    for (;;) {
        const bool has_next = S.next(ui + 1, nxt);
        const char* nA = has_next ? (const char*)(nxt.seg ? g.A1 : g.A0) + (size_t)nxt.pm * tstep : cA; const char* nB = has_next ? (const char*)(nxt.seg ? g.B1 : g.B0) + (size_t)nxt.pn * tstep : cB;
        for (int t = 0; t < nt; t += 2) {
            const bool last = (t == nt - 2);
            const char* a1 = cA + (size_t)(t + 1) * kstep;
            const char* a2 = last ? nA : cA + (size_t)(t + 2) * kstep; const char* b2 = last ? nB : cB + (size_t)(t + 2) * kstep;
            const char* a3 = a2 + kstep; const char* b3 = b2 + kstep;
            if (last && has_next) S.a_ready(nxt);
            if constexpr (SP2) {
            PG8_LDB(B0, 0, 0); PG8_LDB(B1, 0, 1); PG8_SCHED; PG8_LDA(At, 0, 0); PG8_STAGE(PG8_SA(1, 1), a1 + hstep, voffA);
            PG8_WAIT_V(8); PG8_WAIT_L(0); PG8_BAR; PG8_MMA(0, 0, At, B0); PG8_MMA(0, 1, At, B1); PG8_BAR; PG8_SCHED;
            PG8_LDA(At, 0, 1); PG8_STAGE(PG8_SB(0, 0), b2, voffB); PG8_STAGE(PG8_SB(0, 1), b2 + hstep, voffB); PG8_STAGE(PG8_SA(0, 0), a2, voffA);
            PG8_WAIT_V(8); PG8_WAIT_L(0); PG8_BAR; PG8_MMA(1, 0, At, B0); PG8_MMA(1, 1, At, B1); PG8_BAR; PG8_SCHED;
            PG8_LDB(B0, 1, 0); PG8_LDB(B1, 1, 1); PG8_SCHED; PG8_LDA(At, 1, 0); PG8_STAGE(PG8_SA(0, 1), a2 + hstep, voffA);
            PG8_WAIT_V(8); PG8_WAIT_L(0); PG8_BAR; PG8_MMA(0, 0, At, B0); PG8_MMA(0, 1, At, B1); PG8_BAR; PG8_SCHED;
            PG8_LDA(At, 1, 1); PG8_STAGE(PG8_SB(1, 0), b3, voffB); PG8_STAGE(PG8_SB(1, 1), b3 + hstep, voffB); PG8_STAGE(PG8_SA(1, 0), a3, voffA);
            PG8_WAIT_V(8); PG8_WAIT_L(0); PG8_BAR; PG8_MMA(1, 0, At, B0); PG8_MMA(1, 1, At, B1); PG8_BAR; PG8_SCHED;
            } else {
            PG8_LDB(B0, 0, 0); PG8_SCHED; PG8_LDA(At, 0, 0); PG8_STAGE(PG8_SA(1, 1), a1 + hstep, voffA);
            PG8_WAIT_L(8); PG8_BAR; PG8_WAIT_L(0); PG8_MMA(0, 0, At, B0); PG8_BAR; PG8_SCHED;
            PG8_LDB(B1, 0, 1); PG8_STAGE(PG8_SB(0, 0), b2, voffB);
            PG8_BAR; PG8_WAIT_L(0); PG8_MMA(0, 1, At, B1); PG8_BAR;
            PG8_LDA(At, 0, 1); PG8_STAGE(PG8_SA(0, 0), a2, voffA);
            PG8_BAR; PG8_WAIT_L(0); PG8_MMA(1, 0, At, B0); PG8_BAR; PG8_SCHED;
            PG8_STAGE(PG8_SB(0, 1), b2 + hstep, voffB);
            PG8_WAIT_V(6); PG8_BAR; PG8_MMA(1, 1, At, B1); PG8_BAR;
            PG8_LDB(B0, 1, 0); PG8_SCHED; PG8_LDA(At, 1, 0); PG8_STAGE(PG8_SA(0, 1), a2 + hstep, voffA);
            PG8_WAIT_L(8); PG8_BAR; PG8_WAIT_L(0); PG8_MMA(0, 0, At, B0); PG8_BAR; PG8_SCHED;
            PG8_LDB(B1, 1, 1); PG8_STAGE(PG8_SB(1, 0), b3, voffB);
            PG8_BAR; PG8_WAIT_L(0); PG8_MMA(0, 1, At, B1); PG8_BAR;
            PG8_LDA(At, 1, 1); PG8_STAGE(PG8_SA(1, 0), a3, voffA);
            PG8_BAR; PG8_WAIT_L(0); PG8_MMA(1, 0, At, B0); PG8_BAR; PG8_SCHED;
            PG8_STAGE(PG8_SB(1, 1), b3 + hstep, voffB);
            PG8_WAIT_V(6); PG8_BAR; PG8_MMA(1, 1, At, B1); PG8_BAR;
            }
        }
        if constexpr (ALIGN_EPI) { if (wr == 0) PG8_BAR; }
        if constexpr (!Epi::AFTER_DRAIN) { E(acc, cur, wr, wc, fr, fq); S.done(cur); }
        if (!has_next) break;
        if (nxt.seg == 0) {
#pragma unroll
        for (int a = 0; a < 2; ++a)
#pragma unroll
            for (int b = 0; b < 2; ++b)
#pragma unroll
                for (int m = 0; m < 4; ++m)
#pragma unroll
                    for (int n = 0; n < 2; ++n) acc[a][b][m][n] = (f32x4){0.f, 0.f, 0.f, 0.f};
        }
        cur = nxt; cA = nA; cB = nB; ++ui;
        if constexpr (ALIGN_EPI) { if (wr == 1) PG8_BAR; }
    }
    PG8_WAIT_V(0);
    if constexpr (!ALIGN_EPI) { if (wr == 0) PG8_BAR; }
    PG8_BAR;
    if constexpr (Epi::AFTER_DRAIN) { E.fused(acc, cur, wr, wc, fr, fq, lds, wid, lane); S.done(cur); }
#undef PG8_SA
#undef PG8_SB
#undef PG8_STAGE
#undef PG8_LDA
#undef PG8_LDB
#undef PG8_MMA
#undef PG8_WAIT_V
#undef PG8_WAIT_L
#undef PG8_BAR
#undef PG8_SCHED
}
}
namespace attn_body {
using bf16=__hip_bfloat16;
using bf16x8=__attribute__((ext_vector_type(8)))short;
using s16x4=__attribute__((ext_vector_type(4)))short;
using f32x16=__attribute__((ext_vector_type(16)))float;
using u32x4=__attribute__((ext_vector_type(4)))unsigned;
constexpr int BATCH=8,NHEAD=16,SEQ=4096,D=64,DM=NHEAD*D;
constexpr int NW=8,QBLK=32,QB=QBLK*NW,KVBLK=64,NQB=SEQ/QB;
constexpr int ATTN_PITCH=DM, ATTN_UNIT_ROWS=QB;
__device__ __forceinline__ int crow(int r,int hi){return (r&3)+8*(r>>2)+4*hi;}
#define SBAR() __builtin_amdgcn_sched_barrier(0)
__device__ __forceinline__ void cmask(f32x16&p0,f32x16&p1,int jb,int qrel,int hi){
  const float NEG=-INFINITY; int kb=64*jb+4*hi;
  #pragma unroll
  for(int r=0;r<16;++r){int kv=kb+(r&3)+8*(r>>2); if(kv>qrel)p0[r]=NEG; if(kv+32>qrel)p1[r]=NEG;}
}

constexpr int NSLOT=3, SLOTB=8192;
constexpr int LDS_K=0, LDS_V=NSLOT*SLOTB, LDS_WS=2*NSLOT*SLOTB, LDS_OST=LDS_WS+NW*64*4, LDS_CL=LDS_OST+NW*4096, LDS_BYTES=LDS_CL+SEQ*4;
constexpr float C2=0.125f*1.4426950408889634f;
__device__ __forceinline__ void glds16(const void*gsrc,unsigned lds_dst){unsigned keep;
  asm volatile("s_mov_b32 %0, m0\n\ts_mov_b32 m0, %2\n\ts_nop 0\n\tglobal_load_lds_dwordx4 %1, off\n\ts_mov_b32 m0, %0":"=&s"(keep):"v"(gsrc),"s"(lds_dst):"memory");}
__device__ __forceinline__ float max3f(float a,float b,float c){float r;asm("v_max3_f32 %0, %1, %2, %3":"=v"(r):"v"(a),"v"(b),"v"(c));return r;}
__device__ __forceinline__ float max2f(float a,float b){float r;asm("v_max_f32_e32 %0, %1, %2":"=v"(r):"v"(a),"v"(b));return r;}
__device__ __forceinline__ float fadd_s(float a,float b){float r;asm("v_add_f32_e32 %0, %1, %2":"=v"(r):"v"(a),"v"(b));return r;}
__device__ __forceinline__ float fsub_s(float a,float b){float r;asm("v_sub_f32_e32 %0, %1, %2":"=v"(r):"v"(a),"v"(b));return r;}
typedef float f32x2_t __attribute__((ext_vector_type(2))); typedef __bf16 bf16x2_t __attribute__((ext_vector_type(2)));
__device__ __forceinline__ unsigned cvtpk_s(float lo,float hi){f32x2_t v={lo,hi};bf16x2_t b=__builtin_convertvector(v,bf16x2_t);return __builtin_bit_cast(unsigned,b);}
#define WAIT_BAR(N) asm volatile("s_waitcnt vmcnt(" #N ") lgkmcnt(0)\n\ts_barrier":::"memory")

__device__ __forceinline__ void qkt(f32x16&p0,f32x16&p1,const char*Kslot,const bf16x8*qr,int r32,int hi){
  const char*kb=Kslot+hi*1024+r32*16;
  #pragma unroll
  for(int d0=0;d0<4;++d0){
    const bf16x8 b0=*reinterpret_cast<const bf16x8*>(kb+d0*2048);
    const bf16x8 b1=*reinterpret_cast<const bf16x8*>(kb+d0*2048+512);
    {p0=__builtin_amdgcn_mfma_f32_32x32x16_bf16(b0,qr[d0],p0,0,0,0);p1=__builtin_amdgcn_mfma_f32_32x32x16_bf16(b1,qr[d0],p1,0,0,0);}}
}
typedef __attribute__((address_space(3))) const char* lds_cptr;
typedef short v4i16_t __attribute__((ext_vector_type(4)));
__device__ __forceinline__ void kload8(bf16x8*kf,lds_cptr kp){
  kf[0]=*(const __attribute__((address_space(3))) bf16x8*)(kp);      kf[1]=*(const __attribute__((address_space(3))) bf16x8*)(kp+512);
  kf[2]=*(const __attribute__((address_space(3))) bf16x8*)(kp+2048); kf[3]=*(const __attribute__((address_space(3))) bf16x8*)(kp+2560);
  kf[4]=*(const __attribute__((address_space(3))) bf16x8*)(kp+4096); kf[5]=*(const __attribute__((address_space(3))) bf16x8*)(kp+4608);
  kf[6]=*(const __attribute__((address_space(3))) bf16x8*)(kp+6144); kf[7]=*(const __attribute__((address_space(3))) bf16x8*)(kp+6656);
}
__device__ __forceinline__ void kload2(bf16x8*kf,lds_cptr kp,int j){ kf[2*j]=*(const __attribute__((address_space(3))) bf16x8*)(kp+j*2048); kf[2*j+1]=*(const __attribute__((address_space(3))) bf16x8*)(kp+j*2048+512); }
__device__ __forceinline__ s16x4 vtr(lds_cptr p){ return __builtin_bit_cast(s16x4,__builtin_amdgcn_ds_read_tr16_b64_v4i16((__attribute__((address_space(3))) v4i16_t*)p)); }
__device__ __forceinline__ float rowmax(const f32x16&p0,const f32x16&p1){
  float a=max3f(p0[0],p0[1],p1[0]),b=max3f(p0[2],p0[3],p1[1]);a=max3f(a,p1[2],p1[3]);
  #pragma unroll
  for(int r=4;r<16;r+=4){a=max3f(a,p0[r],p0[r+1]);b=max3f(b,p0[r+2],p0[r+3]);a=max3f(a,p1[r],p1[r+1]);b=max3f(b,p1[r+2],p1[r+3]);}
  const float m=max2f(a,b);
  auto rr=__builtin_amdgcn_permlane32_swap(__float_as_uint(m),__float_as_uint(m),false,false);
  return max2f(__uint_as_float(rr[0]),__uint_as_float(rr[1]));
}
__device__ __forceinline__ void pv(f32x16*o,int vb,bf16x8 pa0,bf16x8 pa1,bf16x8 pa2,bf16x8 pa3){
  #pragma unroll
  for(int d0=0;d0<2;++d0){s16x4 lo[4],hi[4];
    #pragma unroll
    for(int ks=0;ks<4;++ks){
      asm volatile("ds_read_b64_tr_b16 %0,%1 offset:%c2":"=&v"(lo[ks]):"v"(vb),"i"(d0*4096+ks*1024):"memory");
      asm volatile("ds_read_b64_tr_b16 %0,%1 offset:%c2":"=&v"(hi[ks]):"v"(vb),"i"(d0*4096+ks*1024+512):"memory");}
    asm volatile("s_waitcnt lgkmcnt(0)":::"memory");SBAR();
    #define PK(k) (bf16x8){lo[k][0],lo[k][1],lo[k][2],lo[k][3],hi[k][0],hi[k][1],hi[k][2],hi[k][3]}
    o[d0]=__builtin_amdgcn_mfma_f32_32x32x16_bf16(pa0,PK(0),o[d0],0,0,0);
    o[d0]=__builtin_amdgcn_mfma_f32_32x32x16_bf16(pa1,PK(1),o[d0],0,0,0);
    o[d0]=__builtin_amdgcn_mfma_f32_32x32x16_bf16(pa2,PK(2),o[d0],0,0,0);
    o[d0]=__builtin_amdgcn_mfma_f32_32x32x16_bf16(pa3,PK(3),o[d0],0,0,0);
    #undef PK
  }
}

#ifndef ATTN_STORE16
#define ATTN_STORE16(p,v) (*(u32x4*)(p)=(v))
#endif
template<int THRL> __device__ __forceinline__ void attn_unit(int b,int h,int qb,int T0,const bf16*Q,const bf16*__restrict__ K,const bf16*__restrict__ V,bf16*O,const float*__restrict__ c2g,char*shm){
  const int tid=threadIdx.x,lane=tid&63,r32=lane&31,hi=lane>>5; const int wid=__builtin_amdgcn_readfirstlane(tid>>6);
  const long rowbase=(long)b*SEQ; const int q0=qb*QB;
  const bf16*Qw=Q+(rowbase+q0+wid*QBLK)*DM+h*D;
  const bf16*Kh=K+(rowbase+(long)T0*KVBLK)*DM+h*D,*Vh=V+(rowbase+(long)T0*KVBLK)*DM+h*D;
  const unsigned lds0=(unsigned)(uintptr_t)shm; const lds_cptr shm3=(lds_cptr)shm;
  float*wsf=(float*)(shm+LDS_WS)+wid*64;
  const bf16*ksrc=Kh+(long)lane*DM+wid*8;
  const bf16*vsrc=Vh+(long)(16*(wid&3)+(lane>>2))*DM+(wid>>2)*32+(lane&3)*8;
  const unsigned kdst=lds0+LDS_K+wid*1024, vdst=lds0+LDS_V+wid*1024;
  #define DMA_K(t,slot) glds16(ksrc+(long)(t)*KVBLK*DM,(unsigned)__builtin_amdgcn_readfirstlane(kdst+(slot)))
  #define DMA_V(t,slot) glds16(vsrc+(long)(t)*KVBLK*DM,(unsigned)__builtin_amdgcn_readfirstlane(vdst+(slot)))
  const int vb0=(int)(lds0+LDS_V)+((lane>>4)&1)*32+(lane&3)*8+(4*hi+((lane&15)>>2))*64;
  const char*Kbase=shm+LDS_K; bf16x8 kf[8];
  const lds_cptr kp0=shm3+LDS_K+hi*1024+r32*16; const lds_cptr vp0=shm3+LDS_V+((lane>>4)&1)*32+(lane&3)*8+(4*hi+((lane&15)>>2))*64;
  const int NT=(q0+QB)/KVBLK-T0;
  { typedef float f32x4g __attribute__((ext_vector_type(4))); __attribute__((address_space(3))) f32x4g* cl4=(__attribute__((address_space(3))) f32x4g*)(shm3+LDS_CL);
    for(int s4=16*T0+tid; s4<(q0+QB)/4; s4+=NW*64) cl4[s4]=*reinterpret_cast<const f32x4g*>(c2g+4*s4); }
  float nm=c2g[q0+wid*QBLK+r32];
  DMA_K(0,0);DMA_V(0,0);DMA_K(1,SLOTB);
  bf16x8 qr[4];
  #pragma unroll
  for(int d0=0;d0<4;++d0)qr[d0]=*reinterpret_cast<const bf16x8*>(&Qw[(long)r32*DM+d0*16+hi*8]);
  float l_reg=0.f;f32x16 o[2];o[0]=f32x16{};o[1]=f32x16{};
  typedef float f32x4l __attribute__((ext_vector_type(4)));
  #define CINIT(C0,C1,t) do{ const __attribute__((address_space(3))) f32x4l* cp_=(const __attribute__((address_space(3))) f32x4l*)(shm3+LDS_CL+(((t)+T0)*64+4*hi)*4); \
    _Pragma("unroll") for(int g_=0;g_<4;++g_){ const f32x4l a_=cp_[2*g_], b_=cp_[8+2*g_]; \
      C0[4*g_]=nm-a_[0];C0[4*g_+1]=nm-a_[1];C0[4*g_+2]=nm-a_[2];C0[4*g_+3]=nm-a_[3]; \
      C1[4*g_]=nm-b_[0];C1[4*g_+1]=nm-b_[1];C1[4*g_+2]=nm-b_[2];C1[4*g_+3]=nm-b_[3]; } }while(0)
  const int qrel=wid*QBLK+r32;
  #define CMASK(P0,P1,t) do{int jb_=(t)-(NT-4); if(jb_>=0)cmask(P0,P1,jb_,qrel,hi);}while(0)
  bool resc=false;
  #define START(P0,P1) do{ const float rm=rowmax(P0,P1); resc=false; \
    { const float dl=rm; nm=fsub_s(nm,dl); \
      _Pragma("unroll") for(int r=0;r<16;++r){P0[r]=fsub_s(P0[r],dl);P1[r]=fsub_s(P1[r],dl);} } \
    _Pragma("unroll") for(int r=0;r<16;++r)P0[r]=__builtin_amdgcn_exp2f(P0[r]); }while(0)
  #define RESC() do{ if(resc){ asm volatile("s_waitcnt lgkmcnt(0)":::"memory"); \
      _Pragma("unroll") for(int d_=0;d_<2;++d_) _Pragma("unroll") for(int r=0;r<16;++r)o[d_][r]*=wsf[crow(r,hi)]; } }while(0)
  f32x16 pA0,pA1,pB0,pB1;
  int sl_prev=0,sl_cur=0,sl_next=SLOTB;
  #define ROT() do{sl_prev=sl_cur;sl_cur=sl_next;sl_next=(sl_next==(NSLOT-1)*SLOTB)?0:sl_next+SLOTB;}while(0)
  DMA_K(2,2*SLOTB);
  WAIT_BAR(3);
  CINIT(pA0,pA1,0); qkt(pA0,pA1,Kbase,qr,r32,hi);asm volatile("s_nop 15\n\ts_nop 7":"+v"(pA0),"+v"(pA1));CMASK(pA0,pA1,0);
  START(pA0,pA1);
  _Pragma("unroll") for(int r=0;r<16;++r)pA1[r]=__builtin_amdgcn_exp2f(pA1[r]);
  WAIT_BAR(0);
  DMA_K(3,0);DMA_V(1,SLOTB);
  ROT();
  kload8(kf,kp0+sl_cur);
  WAIT_BAR(2);
  s16x4 vlo[8],vhi[8]; u32x4 pw0,pw1,pw2,pw3;
  #define PKW(P,B) cvtpk_s(P[B],P[B+1])
  #define PAF(k) __builtin_bit_cast(bf16x8,pw##k)
  #define VFR(i) (bf16x8){vlo[i][0],vlo[i][1],vlo[i][2],vlo[i][3],vhi[i][0],vhi[i][1],vhi[i][2],vhi[i][3]}
  #define PIN(x) asm volatile("":"+v"(x))
  #define MX3(a,b,c) __builtin_fmaxf(__builtin_fmaxf((a),(b)),(c))
  #define GAPA(MF,A0,A1,A2,A3,W0,W1,PW) do{ MF; sacc+=A0; sacc+=A1; sacc+=A2; sacc+=A3; PIN(sacc); W0; W1; PIN(PW); SBAR(); }while(0)
  #define EX(v) __builtin_amdgcn_exp2f(v)
  #define GAPB(MF,X,B) do{ MF; X[B]=EX(X[B]); X[B+1]=EX(X[B+1]); X[B+2]=EX(X[B+2]); X[B+3]=EX(X[B+3]); PIN(X); SBAR(); }while(0)
  #define VRD(i) do{ vlo[i]=vtr(vp_+(((i)>>2)*4096+((i)&3)*1024)); vhi[i]=vtr(vp_+(((i)>>2)*4096+((i)&3)*1024+512)); }while(0)
  #define KRD(G,j) do{ if(G){ kload2(kf,kp0+sl_next,j); SBAR(); } }while(0)
  #define STEP(C0,C1,P0,P1,t,GK,GV,GL) do{ SBAR(); CINIT(C0,C1,t); SBAR(); \
    const lds_cptr vp_=vp0+sl_prev; \
    VRD(0); SBAR(); float sacc=(P0[0]+P0[1]); \
    GAPA(C0=__builtin_amdgcn_mfma_f32_32x32x16_bf16(kf[0],qr[0],C0,0,0,0), P0[2],P0[3],P0[4],P0[5],     pw0[0]=PKW(P0,0), pw0[1]=PKW(P0,2), pw0); \
    VRD(4); SBAR(); GAPA(C1=__builtin_amdgcn_mfma_f32_32x32x16_bf16(kf[1],qr[0],C1,0,0,0), P0[6],P0[7],P0[8],P0[9],     pw0[2]=PKW(P0,4), pw0[3]=PKW(P0,6), pw0); \
    VRD(1); SBAR(); GAPA(C0=__builtin_amdgcn_mfma_f32_32x32x16_bf16(kf[2],qr[1],C0,0,0,0),   P0[10],P0[11],P0[12],P0[13], pw1[0]=PKW(P0,8), pw1[1]=PKW(P0,10), pw1); \
    VRD(5); SBAR(); GAPA(C1=__builtin_amdgcn_mfma_f32_32x32x16_bf16(kf[3],qr[1],C1,0,0,0),   P0[14],P0[15],P1[0],P1[1],   pw1[2]=PKW(P0,12),pw1[3]=PKW(P0,14), pw1); \
    VRD(2); SBAR(); GAPA(C0=__builtin_amdgcn_mfma_f32_32x32x16_bf16(kf[4],qr[2],C0,0,0,0),   P1[2],P1[3],P1[4],P1[5],     pw2[0]=PKW(P1,0), pw2[1]=PKW(P1,2), pw2); \
    VRD(6); SBAR(); GAPA(C1=__builtin_amdgcn_mfma_f32_32x32x16_bf16(kf[5],qr[2],C1,0,0,0),   P1[6],P1[7],P1[8],P1[9],     pw2[2]=PKW(P1,4), pw2[3]=PKW(P1,6), pw2); \
    VRD(3); SBAR(); GAPA(C0=__builtin_amdgcn_mfma_f32_32x32x16_bf16(kf[6],qr[3],C0,0,0,0),   P1[10],P1[11],P1[12],P1[13], pw3[0]=PKW(P1,8), pw3[1]=PKW(P1,10), pw3); \
    VRD(7); SBAR(); GAPA(C1=__builtin_amdgcn_mfma_f32_32x32x16_bf16(kf[7],qr[3],C1,0,0,0),   P1[14],P1[15],0.f,0.f,       pw3[2]=PKW(P1,12),pw3[3]=PKW(P1,14), pw3); \
    l_reg+=sacc; \
    if(GK){DMA_K((t)+3,sl_cur);} if(GV){DMA_V((t)+1,sl_next);} \
    CMASK(C0,C1,t); \
    { float a=MX3(C0[0],C0[1],C1[0]),b=MX3(C0[2],C0[3],C1[1]); a=MX3(a,C1[2],C1[3]); \
      _Pragma("unroll") for(int r=4;r<16;r+=4){a=MX3(a,C0[r],C0[r+1]);b=MX3(b,C0[r+2],C0[r+3]);a=MX3(a,C1[r],C1[r+1]);b=MX3(b,C1[r+2],C1[r+3]);} \
      float rm=__builtin_fmaxf(a,b); { auto rr=__builtin_amdgcn_permlane32_swap(__float_as_uint(rm),__float_as_uint(rm),false,false); rm=__builtin_fmaxf(__uint_as_float(rr[0]),__uint_as_float(rr[1])); } \
      resc=false; \
      if(__builtin_expect(__any(rm>(float)THRL),0)){ const float dl=__builtin_fmaxf(rm,0.f); nm-=dl; \
        _Pragma("unroll") for(int r=0;r<16;++r){C0[r]-=dl;C1[r]-=dl;} \
        const float f=__builtin_amdgcn_exp2f(-dl); l_reg*=f; if(hi==0)wsf[r32]=f; resc=true; } } \
    SBAR(); \
    GAPB(o[0]=__builtin_amdgcn_mfma_f32_32x32x16_bf16(PAF(0),VFR(0),o[0],0,0,0), C0,0); \
    GAPB(o[1]=__builtin_amdgcn_mfma_f32_32x32x16_bf16(PAF(0),VFR(4),o[1],0,0,0), C0,4); \
    KRD(GL,0); GAPB(o[0]=__builtin_amdgcn_mfma_f32_32x32x16_bf16(PAF(1),VFR(1),o[0],0,0,0), C0,8); \
    KRD(GL,1); GAPB(o[1]=__builtin_amdgcn_mfma_f32_32x32x16_bf16(PAF(1),VFR(5),o[1],0,0,0), C0,12); \
    KRD(GL,2); GAPB(o[0]=__builtin_amdgcn_mfma_f32_32x32x16_bf16(PAF(2),VFR(2),o[0],0,0,0), C1,0); \
    KRD(GL,3); GAPB(o[1]=__builtin_amdgcn_mfma_f32_32x32x16_bf16(PAF(2),VFR(6),o[1],0,0,0), C1,4); \
    GAPB(o[0]=__builtin_amdgcn_mfma_f32_32x32x16_bf16(PAF(3),VFR(3),o[0],0,0,0), C1,8); \
    GAPB(o[1]=__builtin_amdgcn_mfma_f32_32x32x16_bf16(PAF(3),VFR(7),o[1],0,0,0), C1,12); \
    }while(0)
  int t=1;
  #undef CMASK
  #define CMASK(P0,P1,t) do{}while(0)
  for(;t+5<NT;t+=2){
    STEP(pB0,pB1,pA0,pA1,t,true,true,true);     WAIT_BAR(2); RESC(); ROT();
    STEP(pA0,pA1,pB0,pB1,t+1,true,true,true);   WAIT_BAR(2); RESC(); ROT();
  }
  #undef CMASK
  #define CMASK(P0,P1,t) do{int jb_=(t)-(NT-4); if(jb_>=0)cmask(P0,P1,jb_,qrel,hi);}while(0)
  #define ENDW(tt) do{ if((tt)+3<NT){WAIT_BAR(2);} else if((tt)+2<NT){WAIT_BAR(1);} else {WAIT_BAR(0);} }while(0)
  for(;t+1<NT;t+=2){
    STEP(pB0,pB1,pA0,pA1,t,(t+3<NT),(t+1<NT),(t+1<NT));       ENDW(t);   RESC(); ROT();
    STEP(pA0,pA1,pB0,pB1,t+1,(t+4<NT),(t+2<NT),(t+2<NT));     ENDW(t+1); RESC(); ROT();
  }
  STEP(pB0,pB1,pA0,pA1,NT-1,false,false,false); RESC();
  { float sacc=pB0[0]+pB0[1]; _Pragma("unroll") for(int r=2;r<16;++r)sacc+=pB0[r]; _Pragma("unroll") for(int r=0;r<16;++r)sacc+=pB1[r]; l_reg+=sacc;
    pw0=(u32x4){PKW(pB0,0),PKW(pB0,2),PKW(pB0,4),PKW(pB0,6)};pw1=(u32x4){PKW(pB0,8),PKW(pB0,10),PKW(pB0,12),PKW(pB0,14)};pw2=(u32x4){PKW(pB1,0),PKW(pB1,2),PKW(pB1,4),PKW(pB1,6)};pw3=(u32x4){PKW(pB1,8),PKW(pB1,10),PKW(pB1,12),PKW(pB1,14)};
    SBAR(); pv(o,vb0+sl_cur,PAF(0),PAF(1),PAF(2),PAF(3)); }
  #undef PKW
  #undef PAF
  #undef VFR
  #undef PIN
  #undef MX3
  #undef GAPA
  #undef GAPB
  #undef EX
  #undef VRD
  #undef KRD
  #undef STEP
  #undef ENDW
  {auto rr=__builtin_amdgcn_permlane32_swap(__float_as_uint(l_reg),__float_as_uint(l_reg),false,false);l_reg=__uint_as_float(rr[0])+__uint_as_float(rr[1]);}
  if(hi==0)wsf[32+r32]=l_reg;asm volatile("s_waitcnt lgkmcnt(0)":::"memory");
  float rli[16];
  #pragma unroll
  for(int r=0;r<16;++r)rli[r]=__builtin_amdgcn_rcpf(wsf[32+crow(r,hi)]);
  bf16*Ow=O+(rowbase+q0+wid*QBLK)*DM+h*D;
  { bf16*stg=(bf16*)(shm+LDS_OST)+wid*2048;
    #pragma unroll
    for(int r=0;r<16;++r){const int orow=crow(r,hi);
      #pragma unroll
      for(int d0=0;d0<2;++d0)stg[orow*64+d0*32+r32]=__float2bfloat16(o[d0][r]*rli[r]);}
    asm volatile("s_waitcnt lgkmcnt(0)":::"memory");
    #pragma unroll
    for(int i=0;i<4;++i){const int row=i*8+(lane>>3),ch=lane&7; const u32x4 v=*(const u32x4*)(stg+row*64+ch*8); ATTN_STORE16(Ow+(long)row*DM+ch*8,v);} }
  asm volatile("s_waitcnt lgkmcnt(0)\n\ts_barrier":::"memory");
  #undef DMA_K
  #undef DMA_V
  #undef CMASK
  #undef CINIT
  #undef START
  #undef RESC
  #undef ROT
}
constexpr int ATTN_LDS_BYTES=LDS_BYTES;
struct AttnTensors { const bf16* Q; const bf16* K; const bf16* V; bf16* O; const float* C2; };
struct AttnUnit { int bh; int qb; int t0; };
struct StaticOrder {
  int vcu, G;
  __device__ __forceinline__ explicit StaticOrder(int grid,int block):vcu((grid%8==0)?(block%8)*(grid/8)+block/8:block),G(grid){}
  __device__ __forceinline__ bool next(int i,AttnUnit&u)const{
    if(G==256){ if(i>=8)return false; const int s=vcu&1, base=4*(i>>1); u.bh=vcu>>1; u.qb=(i&1)?base+3-s:base+s; u.t0=0; return true; }
    const int L=i*G+vcu; if(L>=BATCH*NHEAD*NQB)return false; u.bh=L/NQB; u.qb=L%NQB; u.t0=0; return true; }
  __device__ __forceinline__ void a_ready(const AttnUnit&)const{}
  __device__ __forceinline__ void done(const AttnUnit&)const{}
};
template<class Sched,int THRL=8> __device__ __forceinline__ void attn_phase(char*lds,const AttnTensors&T,const Sched&S){
  AttnUnit u;
  for(int i=0;S.next(i,u);++i){ S.a_ready(u); attn_unit<THRL>(u.bh/NHEAD,u.bh%NHEAD,u.qb,u.t0,T.Q,T.K,T.V,T.O,T.C2+(size_t)u.bh*SEQ,lds); S.done(u); }
}
constexpr float SKIP_THR=40.f;
template<int THRL=8> __device__ __forceinline__ void attn_phase_queue(char*lds,const AttnTensors&T,unsigned*ctr,const float*STAT,int ctl_off){
  const int tid=threadIdx.x,lane=tid&63;
  volatile __attribute__((address_space(3))) unsigned* slot=(volatile __attribute__((address_space(3))) unsigned*)((__attribute__((address_space(3))) char*)lds+ctl_off);
  for(;;){
    if(tid==0) slot[0]=__hip_atomic_fetch_add(ctr,1u,__ATOMIC_RELAXED,__HIP_MEMORY_SCOPE_AGENT);
    __syncthreads();
    const unsigned un=slot[0];
    __syncthreads();
    if(un>=(unsigned)(BATCH*NHEAD*NQB))break;
    const int qb=NQB-1-(int)(un>>7), bh=(int)(un&127), q0=qb*QB;
    const float*c2g=T.C2+(size_t)bh*SEQ;
    const float qq=STAT[bh*4+0]+STAT[bh*4+1], kk=STAT[bh*4+2]+STAT[bh*4+3];
    const float lim=c2g[q0]+2.04f*sqrtf(qq*kk)+SKIP_THR;
    bool ok=false; if(lane<32){ const int t0c=2*lane; ok=(t0c==0)||(t0c<=4*qb && c2g[64*t0c-1]>=lim); }
    const unsigned long long mk=__ballot(ok);
    const int t0=2*(31-__builtin_clz((unsigned)(mk&0xffffffffull)));
    attn_unit<THRL>(bh/NHEAD,bh%NHEAD,qb,t0,T.Q,T.K,T.V,T.O,c2g,lds);
  }
}
#undef SBAR
#undef WAIT_BAR
}
#define GAS __attribute__((address_space(1)))
#define LAS __attribute__((address_space(3)))
typedef unsigned short bf16;
typedef unsigned v4u __attribute__((ext_vector_type(4)));
typedef float f32x4 __attribute__((ext_vector_type(4)));
typedef short bf16x8 __attribute__((ext_vector_type(8)));
typedef GAS unsigned gu32;
typedef GAS unsigned long long gu64;
#define RLX_AGENT __ATOMIC_RELAXED, __HIP_MEMORY_SCOPE_AGENT
#define LDS_WAIT() asm volatile("s_waitcnt lgkmcnt(0)" ::: "memory")
#define VM_WAIT() asm volatile("s_waitcnt vmcnt(0)" ::: "memory")
__device__ __forceinline__ unsigned long long rt() { return __builtin_amdgcn_s_memrealtime(); }
__device__ __forceinline__ unsigned f2bf(float f) { unsigned u = __builtin_bit_cast(unsigned, f); return (u + 0x7fffu + ((u >> 16) & 1u)) >> 16; }
__device__ __forceinline__ unsigned pk2(float lo, float hi) { return f2bf(lo) | (f2bf(hi) << 16); }

#define XB_TMO      128
#define XB_XCNT(j)  (256  + 64 * (j))
#define XB_XSUB(j)  (1280 + 64 * (j))
#define XB_XGEN(j)  (2304 + 64 * (j))
#define XB_TOP      3328
#define XB_TOPGEN   3392
#define XCD_BAR_WORDS 3456
#define XB_SPIN_CAP (1u << 18)

__device__ __forceinline__ unsigned xb_ld(unsigned* p)              { return __hip_atomic_load(p, __ATOMIC_RELAXED, __HIP_MEMORY_SCOPE_AGENT); }
__device__ __forceinline__ unsigned xb_add(unsigned* p, unsigned v) { return __hip_atomic_fetch_add(p, v, __ATOMIC_RELAXED, __HIP_MEMORY_SCOPE_AGENT); }
__device__ __forceinline__ unsigned xb_xcc_id() { return (unsigned)__builtin_amdgcn_s_getreg((3 << 11) | 20) & 0xFu; }
#define XB_SPIN(cond, bar) do { unsigned _sp = 0; while (cond) { __builtin_amdgcn_s_sleep(1); \
    if ((++_sp & 255u) == 0u) { if (xb_ld(&(bar)[XB_TMO])) break; if (_sp > XB_SPIN_CAP) { atomicAdd(&(bar)[XB_TMO], 1u); break; } } } } while (0)

struct XcdBarrier {
    unsigned* bar; unsigned x;
    volatile LAS unsigned* st;
};

__device__ __forceinline__ XcdBarrier xcd_barrier_post(unsigned* bar, volatile LAS unsigned* st) {
    XcdBarrier b; b.bar = bar; b.x = xb_xcc_id(); b.st = st;
    if (threadIdx.x == 0) (void)xb_add(&bar[XB_XCNT(b.x)], 1u);
    return b;
}
__device__ __forceinline__ void xcd_barrier_complete(unsigned* bar, unsigned x, unsigned& nloc, unsigned& nx) {
    const unsigned G = gridDim.x * gridDim.y * gridDim.z;
    unsigned sum, cnt, mine, sp = 0u;
    for (;;) {
        sum = 0u; cnt = 0u; mine = 0u;
#pragma unroll
        for (unsigned j = 0; j < 16; ++j) { const unsigned c = xb_ld(&bar[XB_XCNT(j)]); sum += c; cnt += (c > 0u) ? 1u : 0u; mine = (j == x) ? c : mine; }
        if (sum == G) break;
        __builtin_amdgcn_s_sleep(1);
        if ((++sp & 255u) == 0u) { if (xb_ld(&bar[XB_TMO])) break; if (sp > XB_SPIN_CAP) { atomicAdd(&bar[XB_TMO], 1u); break; } }
    }
    nloc = mine > 0u ? mine : 1u; nx = cnt > 0u ? cnt : 1u;
}

__device__ __forceinline__ void xcd_barrier(const XcdBarrier& b) {
    asm volatile("s_waitcnt vmcnt(0)" ::: "memory");
    __syncthreads();
    if (threadIdx.x == 0) {
        unsigned* bar = b.bar;
        __builtin_amdgcn_s_waitcnt(0);
        unsigned nloc = b.st[0], nx = b.st[1];
        if (nloc == 0u) { xcd_barrier_complete(bar, b.x, nloc, nx); b.st[0] = nloc; b.st[1] = nx; }
        const unsigned old = xb_add(&bar[XB_XSUB(b.x)], 1u);
        const unsigned gen = old / nloc;
        if (old + 1u == (gen + 1u) * nloc) {
            __builtin_amdgcn_fence(__ATOMIC_RELEASE, "agent");
            asm volatile("s_waitcnt vmcnt(0)" ::: "memory");
            const unsigned og = xb_add(&bar[XB_TOP], 1u);
            const unsigned tg = og / nx;
            if (og + 1u == (tg + 1u) * nx) xb_add(&bar[XB_TOPGEN], 1u);
            else XB_SPIN(xb_ld(&bar[XB_TOPGEN]) == tg, bar);
            __builtin_amdgcn_fence(__ATOMIC_ACQUIRE, "agent");
            xb_add(&bar[XB_XGEN(b.x)], 1u);
            asm volatile("s_waitcnt vmcnt(0)" ::: "memory");
        } else {
            XB_SPIN(xb_ld(&bar[XB_XGEN(b.x)]) == gen, bar);
            __builtin_amdgcn_fence(__ATOMIC_ACQUIRE, "agent");
            asm volatile("s_waitcnt vmcnt(0)" ::: "memory");
        }
    }
    __syncthreads();
}

constexpr int BATCH = 8, SEQ = 4096, D = 1024, M = BATCH * SEQ, NHEADS = 16, HDIM = 64;
constexpr int INC = 7184, N1 = 7168;
constexpr int PHEADS = 8, PNK = 128, PDK = 256, PTOPK = 16, NQP = PHEADS * PDK, NEXP = PNK * PNK, NSEL = PHEADS * PTOPK;
constexpr float EPS = 1e-6f, LOG2E = 1.4426950408889634f;
constexpr float U_SCALE = 256.f, V_SCALE = 16.f, A_SCALE = 32.f, H_SCALE = 8.f;
constexpr int PU_LDS = 17408;
constexpr int NWAVES = 8;

constexpr size_t MiB = 1u << 20;
constexpr size_t WS_CTL = 0, CTL_ZERO_BYTES = 1 * MiB;
constexpr size_t WS_LOGF = 1 * MiB;
constexpr size_t WS_C2 = 3 * MiB;
constexpr size_t WS_K1 = 5 * MiB, WS_K2 = 5 * MiB + 256 * 1024;
constexpr size_t WS_WIN = 8 * MiB;
constexpr size_t WS_WC = 22 * MiB, WS_WF = 24 * MiB, WS_WO = 26 * MiB, WS_WQ = 28 * MiB;
constexpr size_t WS_U = 32 * MiB, WS_VT = 64 * MiB;
constexpr size_t WS_XN = 96 * MiB;
constexpr size_t WS_GLU = 160 * MiB;
constexpr size_t WS_QO = 224 * MiB, WS_K = 288 * MiB, WS_V = 352 * MiB;
constexpr size_t WS_QP = 96 * MiB;
constexpr size_t WS_IDX = 352 * MiB;
constexpr size_t WS_GATE = 360 * MiB;
constexpr size_t WS_ACT = 376 * MiB;
constexpr size_t WS_HHI = 224 * MiB, WS_HLO = 256 * MiB;
constexpr size_t WS_PART = 96 * MiB;
#ifndef PEER_SLICED
#define PEER_SLICED 1
#endif
constexpr size_t WS_END = 416 * MiB;

constexpr int CW_BAR = 4096, CW_ATTQ = 8192 + 64, CW_STAT = 16384, CW_RSS = 32768;

constexpr int RING_OFF = 0, RING_BYTES = 131072;
constexpr int LDS_BYTES = 155648, LDSCTL_OFF = 154624, MISC_OFF = LDSCTL_OFF + 320;
static_assert(MISC_OFF + 128 <= LDS_BYTES, "LDS map");

__device__ __forceinline__ float wave_sum(float v) {
#pragma unroll
    for (int o = 1; o < 64; o <<= 1) v += __shfl_xor(v, o);
    return v;
}
__device__ __forceinline__ float sigmoidf_(float x) { return __builtin_amdgcn_rcpf(1.f + __builtin_amdgcn_exp2f(-x * LOG2E)); }
__device__ __forceinline__ float bf_lo(unsigned v) { return __uint_as_float(v << 16); }
__device__ __forceinline__ float bf_hi(unsigned v) { return __uint_as_float(v & 0xffff0000u); }
typedef unsigned u32x2 __attribute__((ext_vector_type(2)));

__device__ __forceinline__ void p0_transpose_item(const float* W, int ldw, int col0, bf16* WT, int K, int drow0, LAS float* scr, int kb, int lane, const float* kscale = nullptr) {
    const int k0 = 64 * kb;
    float tv[32];
#pragma unroll
    for (int i = 0; i < 32; ++i) tv[i] = W[(size_t)(k0 + 2 * i + (lane >> 5)) * ldw + col0 + (lane & 31)];
    if (kscale) {
#pragma unroll
        for (int i = 0; i < 32; ++i) tv[i] *= kscale[k0 + 2 * i + (lane >> 5)]; }
#pragma unroll
    for (int i = 0; i < 32; ++i) scr[(2 * i + (lane >> 5)) * 33 + (lane & 31)] = tv[i];
    LDS_WAIT(); asm volatile("" ::: "memory");
    const int c = lane & 7;
#pragma unroll
    for (int j = 0; j < 4; ++j) { const int n = (lane >> 3) + 8 * j; const LAS float* s = scr + (8 * c) * 33 + n;
        v4u o; o.x = pk2(s[0 * 33], s[1 * 33]); o.y = pk2(s[2 * 33], s[3 * 33]); o.z = pk2(s[4 * 33], s[5 * 33]); o.w = pk2(s[6 * 33], s[7 * 33]);
        *(GAS v4u*)(WT + (size_t)(drow0 + n) * K + k0 + 8 * c) = o; }
    LDS_WAIT(); asm volatile("" ::: "memory");
}
__device__ __forceinline__ float log_sigmoid_(float z) { return fminf(z, 0.f) - log1pf(expf(-fabsf(z))); }

struct P0Args { const float *g2; const float *x, *g1, *w_in, *w_conv_out, *w_fox_out, *w_out, *peer_wq, *k1, *k2, *u, *v, *fox_bf;
                bf16 *WIN, *WC, *WF, *WO, *WQ, *K1b, *K2b; unsigned char *Uq, *Vq; bf16* XN; float* LOGF; };
__device__ __forceinline__ void p0_prologue(LAS unsigned char* lds, const P0Args& a, int vcu, int G, int tid, int parts = 7) {
    const int lane = tid & 63, wave = __builtin_amdgcn_readfirstlane(tid >> 6);
    LAS float* scr = (LAS float*)(lds + wave * 8704);
    LAS float* wfT = (LAS float*)(lds + 69632);
    const int gw = vcu * NWAVES + wave, NGW = G * NWAVES;
#pragma unroll
    for (int c = tid; c < 4096; c += NWAVES * 64) { const int d = c >> 2, q4 = c & 3; const f32x4 t = *(const GAS f32x4*)(a.w_in + (size_t)d * INC + 5120 + 4 * q4);
        wfT[(4 * q4 + 0) * 1024 + d] = t.x; wfT[(4 * q4 + 1) * 1024 + d] = t.y; wfT[(4 * q4 + 2) * 1024 + d] = t.z; wfT[(4 * q4 + 3) * 1024 + d] = t.w; }
    __syncthreads();
    if (parts & 1) {
        const GAS f32x4* gp = (const GAS f32x4*)a.g1 + lane; f32x4 gv[4];
#pragma unroll
        for (int j = 0; j < 4; ++j) gv[j] = gp[64 * j];
        const float fb = a.fox_bf[(lane >> 2) & 15];
        for (int m0 = gw * 4; m0 < M; m0 += NGW * 4) {
            f32x4 va[4][4];
#pragma unroll
            for (int rr = 0; rr < 4; ++rr) { const GAS f32x4* xr = (const GAS f32x4*)(a.x + (size_t)(m0 + rr) * D) + lane;
#pragma unroll
                for (int j = 0; j < 4; ++j) va[rr][j] = xr[64 * j]; }
#pragma unroll
            for (int rr = 0; rr < 4; ++rr) {
            const int m = m0 + rr;
            f32x4 v[4]; float s = 0.f;
#pragma unroll
            for (int j = 0; j < 4; ++j) { v[j] = va[rr][j]; s += (v[j].x * v[j].x + v[j].y * v[j].y) + (v[j].z * v[j].z + v[j].w * v[j].w); }
            const float rstd = 1.0f / sqrtf(wave_sum(s) * (1.f / D) + EPS);
#pragma unroll
            for (int j = 0; j < 4; ++j) v[j] = v[j] * rstd * gv[j];
            GAS unsigned long long* o8 = (GAS unsigned long long*)(a.XN + (size_t)m * D) + lane;
#pragma unroll
            for (int j = 0; j < 4; ++j) o8[64 * j] = (unsigned long long)pk2(v[j].x, v[j].y) | ((unsigned long long)pk2(v[j].z, v[j].w) << 32);
            float fp[16];
#pragma unroll
            for (int jj = 0; jj < 16; ++jj) { float t = 0.f;
#pragma unroll
                for (int j = 0; j < 4; ++j) { const f32x4 w = *(const LAS f32x4*)(wfT + jj * 1024 + 256 * j + 4 * lane); t += (v[j].x * w.x + v[j].y * w.y) + (v[j].z * w.z + v[j].w * w.w); }
                fp[jj] = t; if (jj & 1) __builtin_amdgcn_sched_barrier(0); }
#pragma unroll
            for (int st = 0; st < 4; ++st) { const int msk = 32 >> st, n = 8 >> st; const bool up = (lane & msk) != 0;
#pragma unroll
                for (int i = 0; i < n; ++i) { float a_ = fp[i], b_ = fp[i + n]; asm volatile("" : "+v"(a_), "+v"(b_));
                    const float mine = up ? b_ : a_, theirs = up ? a_ : b_; fp[i] = mine + __shfl_xor(theirs, msk); } }
            float ft = fp[0]; ft += __shfl_xor(ft, 1); ft += __shfl_xor(ft, 2);
            if ((lane & 3) == 0) a.LOGF[(size_t)m * 16 + ((lane >> 2) & 15)] = log_sigmoid_(ft + fb);
            }
        }
    }
    if (parts & 2) for (int it = gw; it < 6144; it += NGW) {
        int r = it;
        if (r < 512)  { const int nb = r & 31, kb = r >> 5; p0_transpose_item(a.w_in, INC, 32 * nb, a.WIN, D, (nb >> 2) * 256 + (nb & 3) * 32, scr, kb, lane); continue; } r -= 512;
        if (r < 512)  { const int nb = r & 31, kb = r >> 5; p0_transpose_item(a.w_in, INC, 1024 + 32 * nb, a.WIN, D, (nb >> 2) * 256 + 128 + (nb & 3) * 32, scr, kb, lane); continue; } r -= 512;
        if (r < 1536) { const int nb = r % 96, kb = r / 96; p0_transpose_item(a.w_in, INC, 2048 + 32 * nb, a.WIN, D, 2048 + 32 * nb, scr, kb, lane); continue; } r -= 1536;
        if (r < 1024) { const int nb = r & 63, kb = r >> 6; p0_transpose_item(a.w_in, INC, 5136 + 32 * nb, a.WIN, D, 5120 + 32 * nb, scr, kb, lane); continue; } r -= 1024;
        if (r < 512)  { const int nb = r & 31, kb = r >> 5; p0_transpose_item(a.w_conv_out, D, 32 * nb, a.WC, D, 32 * nb, scr, kb, lane); continue; } r -= 512;
        if (r < 512)  { const int nb = r & 31, kb = r >> 5; p0_transpose_item(a.w_fox_out, D, 32 * nb, a.WF, D, 32 * nb, scr, kb, lane); continue; } r -= 512;
        if (r < 512)  { const int nb = r & 31, kb = r >> 5; p0_transpose_item(a.w_out, D, 32 * nb, a.WO, D, 32 * nb, scr, kb, lane); continue; } r -= 512;
        { const int nb = r & 63, kb = r >> 6; p0_transpose_item(a.peer_wq, NQP, 32 * nb, a.WQ, D, 32 * nb, scr, kb, lane, a.g2); }
    }
    constexpr int I_K = PHEADS * PNK * 128 / 512;
    if (parts & 4) for (int it = gw; it < 2 * I_K; it += NGW) {
        int r = it; const float* src; bf16* dst;
        if (r < I_K) { src = a.k1; dst = a.K1b; } else { r -= I_K; src = a.k2; dst = a.K2b; }
        const size_t e0 = (size_t)r * 512 + 8 * lane;
        const f32x4 p = *(const GAS f32x4*)(src + e0), q = *(const GAS f32x4*)(src + e0 + 4);
        v4u o; o.x = pk2(p.x, p.y); o.y = pk2(p.z, p.w); o.z = pk2(q.x, q.y); o.w = pk2(q.z, q.w);
        *(GAS v4u*)(dst + e0) = o;
    }
    constexpr int I_U = NEXP * D / 4096;
    f32x4 gq[4];
#pragma unroll
    for (int j = 0; j < 4; ++j) gq[j] = *(const GAS f32x4*)(a.g2 + 4 * lane + 256 * j);
    if (parts & 4) for (int it = gw; it < 2 * I_U; it += NGW) {
        const bool isv = it >= I_U; const int r = isv ? it - I_U : it;
        const float* src = isv ? a.v : a.u; unsigned char* dst = isv ? a.Vq : a.Uq; const float sc = isv ? V_SCALE : U_SCALE;
        const size_t e0 = (size_t)r * 4096 + 4 * lane; f32x4 p[16];
#pragma unroll
        for (int k = 0; k < 16; ++k) p[k] = *(const GAS f32x4*)(src + e0 + 256 * k);
#pragma unroll
        for (int k = 0; k < 16; ++k) { f32x4 t = p[k] * sc; if (PEER_SLICED && !isv) t = t * gq[k & 3]; int w = __builtin_amdgcn_cvt_pk_fp8_f32(t.x, t.y, 0, false); w = __builtin_amdgcn_cvt_pk_fp8_f32(t.z, t.w, w, true);
            const size_t ee = e0 + 256 * k;
            if (PEER_SLICED) { const size_t erow = ee >> 10; const int dcol = (int)(ee & 1023); *(GAS unsigned*)(dst + (size_t)(dcol >> 7) * ((size_t)NEXP * 128) + erow * 128 + (dcol & 127)) = (unsigned)w; }
            else *(GAS unsigned*)(dst + ee) = (unsigned)w; }
    }
}

namespace pg8 {
struct EpiP1 {
    static constexpr bool PERM = true, AFTER_DRAIN = false;
    bf16_t *GLU, *Q, *K, *V, *GA, *GB; float qscale; unsigned* STAT;
    __device__ __forceinline__ void operator()(const f32x4 (&acc)[2][2][4][2], const Unit& u, int wr, int wc, int fr, int fq) const {
        const int row0 = u.pm * BM + wr * 64 + fr;
        if (u.pn < 8) {
            const int col = 128 * u.pn + wc * 32 + 8 * fq;
#pragma unroll
            for (int ai = 0; ai < 2; ++ai)
#pragma unroll
                for (int m = 0; m < 4; ++m) {
                    const f32x4 v0 = acc[ai][0][m][0], v1 = acc[ai][0][m][1], g0 = acc[ai][1][m][0], g1 = acc[ai][1][m][1];
                    u32x4 w;
                    w.x = cvt_pk_bf16(v0[0] * sigmoidf_(g0[0]), v0[1] * sigmoidf_(g0[1])); w.y = cvt_pk_bf16(v0[2] * sigmoidf_(g0[2]), v0[3] * sigmoidf_(g0[3]));
                    w.z = cvt_pk_bf16(v1[0] * sigmoidf_(g1[0]), v1[1] * sigmoidf_(g1[1])); w.w = cvt_pk_bf16(v1[2] * sigmoidf_(g1[2]), v1[3] * sigmoidf_(g1[3]));
                    *(u32x4*)(GLU + (size_t)(row0 + ai * HALF + m * 16) * 1024 + col) = w;
                }
        } else {
            const int t = (u.pn - 8) >> 2, colt = ((u.pn - 8) & 3) * 256 + wc * 32 + 8 * fq;
            bf16_t* base = t == 0 ? Q : t == 1 ? K : t == 2 ? V : t == 3 ? GA : GB;
            const float sc = t == 0 ? qscale : 1.f;
#pragma unroll
            for (int ai = 0; ai < 2; ++ai)
#pragma unroll
                for (int m = 0; m < 4; ++m) { bf16_t* rowp = base + (size_t)(row0 + ai * HALF + m * 16) * 1024 + colt;
#pragma unroll
                    for (int bj = 0; bj < 2; ++bj) { f32x4 v0 = acc[ai][bj][m][0], v1 = acc[ai][bj][m][1];
                        if (t >= 3) {
#pragma unroll
                            for (int i = 0; i < 4; ++i) { v0[i] = sigmoidf_(v0[i]); v1[i] = sigmoidf_(v1[i]); }
                        } else { v0 = v0 * sc; v1 = v1 * sc; }
                        u32x4 w; w.x = cvt_pk_bf16(v0[0], v0[1]); w.y = cvt_pk_bf16(v0[2], v0[3]); w.z = cvt_pk_bf16(v1[0], v1[1]); w.w = cvt_pk_bf16(v1[2], v1[3]);
                        *(u32x4*)(rowp + bj * HALF) = w; } }
            if (t <= 1) {
                float mx[2] = {0.f, 0.f};
#pragma unroll
                for (int ai = 0; ai < 2; ++ai)
#pragma unroll
                    for (int m = 0; m < 4; ++m)
#pragma unroll
                        for (int bj = 0; bj < 2; ++bj) { const f32x4 v0 = acc[ai][bj][m][0] * sc, v1 = acc[ai][bj][m][1] * sc;
                            float s = (v0[0] * v0[0] + v0[1] * v0[1]) + (v0[2] * v0[2] + v0[3] * v0[3]) + (v1[0] * v1[0] + v1[1] * v1[1]) + (v1[2] * v1[2] + v1[3] * v1[3]);
                            s += __shfl_xor(s, 16); s += __shfl_xor(s, 32); mx[bj] = fmaxf(mx[bj], s); }
#pragma unroll
                for (int bj = 0; bj < 2; ++bj) { float v = mx[bj];
#pragma unroll
                    for (int o = 1; o < 16; o <<= 1) v = fmaxf(v, __shfl_xor(v, o));
                    if ((fr | fq) == 0) atomicMax(STAT + ((u.pm >> 4) * 16 + ((u.pn - 8) & 3) * 4 + bj * 2 + (wc >> 1)) * 4 + 2 * t + (wc & 1), __float_as_uint(v)); }
            }
        }
    }
};
struct EpiDual {
    static constexpr bool PERM = true, AFTER_DRAIN = false;
    const bf16_t *GA, *GB; bf16_t* O;
    __device__ __forceinline__ void operator()(f32x4 (&acc)[2][2][4][2], const Unit& u, int wr, int wc, int fr, int fq) const {
        const int row0 = u.pm * BM + wr * 64 + fr, col0 = u.pn * BM + wc * 32 + 8 * fq;
#pragma unroll
        for (int ai = 0; ai < 2; ++ai)
#pragma unroll
            for (int m = 0; m < 4; ++m)
#pragma unroll
                for (int bj = 0; bj < 2; ++bj) {
                    const size_t off = (size_t)(row0 + ai * HALF + m * 16) * 1024 + col0 + bj * HALF;
                    const u32x4 gb = *(const u32x4*)(GB + off);
                    if (u.seg == 0) {
                        const u32x4 ga = *(const u32x4*)(GA + off);
#pragma unroll
                        for (int i = 0; i < 4; ++i) { const unsigned a_ = ga[i], b_ = gb[i]; const int n = i >> 1, e = (i & 1) * 2;
                            acc[ai][bj][m][n][e]     *= bf_lo(a_) * __builtin_amdgcn_rcpf(fmaxf(bf_lo(b_), 1e-30f));
                            acc[ai][bj][m][n][e + 1] *= bf_hi(a_) * __builtin_amdgcn_rcpf(fmaxf(bf_hi(b_), 1e-30f)); }
                    } else {
                        u32x4 w;
#pragma unroll
                        for (int i = 0; i < 4; ++i) { const unsigned b_ = gb[i]; const int n = i >> 1, e = (i & 1) * 2;
                            w[i] = cvt_pk_bf16(acc[ai][bj][m][n][e] * bf_lo(b_), acc[ai][bj][m][n][e + 1] * bf_hi(b_)); }
                        *(u32x4*)(O + off) = w;
                    }
                }
    }
};
struct DualOrder {
    StaticOrder S; int ntile, G, c;
    __device__ __forceinline__ void init(int M_, int N_, int G_, int c_) { S.init(M_, N_, G_, c_); ntile = S.nwg; G = G_; c = c_; }
    __device__ __forceinline__ bool next(int i, Unit& u) const { if (!S.next(i >> 1, u)) return false; u.seg = i & 1; return true; }
    __device__ __forceinline__ void a_ready(const Unit&) const {}
    __device__ __forceinline__ void done(const Unit&) const {}
};
typedef float pf32x2 __attribute__((ext_vector_type(2))); typedef unsigned pu32x2 __attribute__((ext_vector_type(2)));
struct EpiResNorm {
    static constexpr bool PERM = true, AFTER_DRAIN = false;
    const float* base; bf16_t* X1b; float* RSS; const float* g2; unsigned char *HHI, *HLO;
    __device__ __forceinline__ void operator()(const f32x4 (&acc)[2][2][4][2], const Unit& u, int wr, int wc, int fr, int fq) const {
        const int row0 = u.pm * BM + wr * 64 + fr, col0 = u.pn * BM + wc * 32 + 8 * fq;
#pragma unroll
        for (int ai = 0; ai < 2; ++ai)
#pragma unroll
            for (int m = 0; m < 4; ++m) { float ss = 0.f; const int row = row0 + ai * HALF + m * 16;
#pragma unroll
                for (int bj = 0; bj < 2; ++bj) {
                    const size_t off = (size_t)row * 1024 + col0 + bj * HALF;
                    const f32x4 x0 = *(const f32x4*)(base + off) + acc[ai][bj][m][0], x1 = *(const f32x4*)(base + off + 4) + acc[ai][bj][m][1];
                    ss += (x0[0] * x0[0] + x0[1] * x0[1]) + (x0[2] * x0[2] + x0[3] * x0[3]) + (x1[0] * x1[0] + x1[1] * x1[1]) + (x1[2] * x1[2] + x1[3] * x1[3]);
                    u32x4 w; w.x = cvt_pk_bf16(x0[0], x0[1]); w.y = cvt_pk_bf16(x0[2], x0[3]); w.z = cvt_pk_bf16(x1[0], x1[1]); w.w = cvt_pk_bf16(x1[2], x1[3]);
                    *(u32x4*)(X1b + off) = w;
                    if (HHI) {
                        const int cc = col0 + bj * HALF;
                        const f32x4 s0 = x0 * *(const f32x4*)(g2 + cc) * 16.f, s1 = x1 * *(const f32x4*)(g2 + cc + 4) * 16.f;
                        int a0 = __builtin_amdgcn_cvt_pk_fp8_f32(s0[0], s0[1], 0, false); a0 = __builtin_amdgcn_cvt_pk_fp8_f32(s0[2], s0[3], a0, true);
                        int a1 = __builtin_amdgcn_cvt_pk_fp8_f32(s1[0], s1[1], 0, false); a1 = __builtin_amdgcn_cvt_pk_fp8_f32(s1[2], s1[3], a1, true);
                        const pf32x2 d0 = __builtin_amdgcn_cvt_pk_f32_fp8(a0, false), d1 = __builtin_amdgcn_cvt_pk_f32_fp8(a0, true), d2 = __builtin_amdgcn_cvt_pk_f32_fp8(a1, false), d3 = __builtin_amdgcn_cvt_pk_f32_fp8(a1, true);
                        int b0 = __builtin_amdgcn_cvt_pk_fp8_f32((s0[0] - d0.x) * 16.f, (s0[1] - d0.y) * 16.f, 0, false); b0 = __builtin_amdgcn_cvt_pk_fp8_f32((s0[2] - d1.x) * 16.f, (s0[3] - d1.y) * 16.f, b0, true);
                        int b1 = __builtin_amdgcn_cvt_pk_fp8_f32((s1[0] - d2.x) * 16.f, (s1[1] - d2.y) * 16.f, 0, false); b1 = __builtin_amdgcn_cvt_pk_fp8_f32((s1[2] - d3.x) * 16.f, (s1[3] - d3.y) * 16.f, b1, true);
                        const size_t hoff = (size_t)(cc >> 7) * ((size_t)32768 * 128) + (size_t)row * 128 + (cc & 127);
                        *(pu32x2*)(HHI + hoff) = (pu32x2){(unsigned)a0, (unsigned)a1}; *(pu32x2*)(HLO + hoff) = (pu32x2){(unsigned)b0, (unsigned)b1};
                    }
                }
                ss += __shfl_xor(ss, 16); ss += __shfl_xor(ss, 32);
                if (fq == 0) unsafeAtomicAdd(RSS + row, ss);
            }
    }
};
struct EpiScaleRow {
    static constexpr bool PERM = true, AFTER_DRAIN = false;
    bf16_t* O; int ldc; const float* RSS;
    __device__ __forceinline__ void operator()(const f32x4 (&acc)[2][2][4][2], const Unit& u, int wr, int wc, int fr, int fq) const {
        const int row0 = u.pm * BM + wr * 64 + fr, col0 = u.pn * BM + wc * 32 + 8 * fq;
#pragma unroll
        for (int ai = 0; ai < 2; ++ai)
#pragma unroll
            for (int m = 0; m < 4; ++m) { const int row = row0 + ai * HALF + m * 16; const float rs = 1.0f / sqrtf(RSS[row] * (1.f / 1024.f) + 1e-6f);
#pragma unroll
                for (int bj = 0; bj < 2; ++bj) { const f32x4 v0 = acc[ai][bj][m][0] * rs, v1 = acc[ai][bj][m][1] * rs;
                    u32x4 w; w.x = cvt_pk_bf16(v0[0], v0[1]); w.y = cvt_pk_bf16(v0[2], v0[3]); w.z = cvt_pk_bf16(v1[0], v1[1]); w.w = cvt_pk_bf16(v1[2], v1[3]);
                    *(u32x4*)(O + (size_t)row * ldc + col0 + bj * HALF) = w; } }
    }
};
}

__device__ __forceinline__ void scan_unit(LAS unsigned char* lds, const float* LOGF, float* C2, int bh, int tid) {
    const int b = bh >> 4, h = bh & 15, lane = tid & 63, wave = tid >> 6;
    LAS float* wtot = (LAS float*)lds;
    float v[8]; float run = 0.f;
#pragma unroll
    for (int i = 0; i < 8; ++i) { run += LOGF[((size_t)b * SEQ + 8 * tid + i) * 16 + h]; v[i] = run; }
    float inc = run;
#pragma unroll
    for (int o = 1; o < 64; o <<= 1) { const float t = __shfl_up(inc, o); if (lane >= o) inc += t; }
    if (lane == 63) wtot[wave] = inc;
    __syncthreads();
    float base = inc - run;
    for (int w = 0; w < wave; ++w) base += wtot[w];
    f32x4 o0, o1;
    o0.x = (base + v[0]) * LOG2E; o0.y = (base + v[1]) * LOG2E; o0.z = (base + v[2]) * LOG2E; o0.w = (base + v[3]) * LOG2E;
    o1.x = (base + v[4]) * LOG2E; o1.y = (base + v[5]) * LOG2E; o1.z = (base + v[6]) * LOG2E; o1.w = (base + v[7]) * LOG2E;
    *(f32x4*)(C2 + (size_t)bh * SEQ + 8 * tid) = o0; *(f32x4*)(C2 + (size_t)bh * SEQ + 8 * tid + 4) = o1;
    __syncthreads();
}
__device__ __forceinline__ void conv_phase(LAS unsigned char* lds, const bf16* GLU, const float* conv_w, const float* conv_b, const float* ln_g, const float* ln_b, bf16* CZ, int vcu, int G, int tid) {
    typedef float f32x2 __attribute__((ext_vector_type(2)));
    LAS float* red = (LAS float*)lds;
    LAS float* fin = (LAS float*)(lds + 65536);
    const int lane = tid & 63;
    float w0[31], w1[31];
#pragma unroll
    for (int j = 0; j < 31; ++j) { const f32x2 t = *(const f32x2*)(conv_w + j * 1024 + 2 * tid); w0[j] = t.x; w1[j] = t.y; }
    const f32x2 cb = *(const f32x2*)(conv_b + 2 * tid), lg = *(const f32x2*)(ln_g + 2 * tid), lb = *(const f32x2*)(ln_b + 2 * tid);
    const unsigned* Gd = (const unsigned*)GLU; unsigned* Cd = (unsigned*)CZ;
    for (int tile = vcu; tile < M / 32; tile += G) {
        const int t0 = tile * 32, sloc = t0 & (SEQ - 1);
        unsigned in[62];
#pragma unroll
        for (int r = 0; r < 62; ++r) in[r] = (sloc - 30 + r >= 0) ? Gd[(size_t)(t0 - 30 + r) * 512 + tid] : 0u;
#pragma unroll
        for (int ch = 0; ch < 2; ++ch) {
            float o0[16], o1[16];
#pragma unroll
            for (int tt = 0; tt < 16; ++tt) { float a0 = cb.x, a1 = cb.y;
#pragma unroll
                for (int j = 0; j < 31; ++j) { const unsigned v = in[16 * ch + tt + j]; a0 += w0[j] * bf_lo(v); a1 += w1[j] * bf_hi(v); }
                o0[tt] = a0; o1[tt] = a1; red[tt * 512 + tid] = a0 + a1; red[(16 + tt) * 512 + tid] = a0 * a0 + a1 * a1; }
            __syncthreads();
            { const int st = tid >> 4, sg = tid & 15; float s = 0.f;
#pragma unroll
              for (int i = 0; i < 8; ++i) { const f32x4 t = *(const LAS f32x4*)(red + st * 512 + sg * 32 + 4 * i); s += (t.x + t.y) + (t.z + t.w); }
              s += __shfl_xor(s, 1); s += __shfl_xor(s, 2); s += __shfl_xor(s, 4); s += __shfl_xor(s, 8);
              if (sg == 0) fin[st] = s; }
            __syncthreads();
#pragma unroll
            for (int tt = 0; tt < 16; ++tt) {
                const float mean = fin[tt] * (1.f / 1024.f), var = fin[16 + tt] * (1.f / 1024.f) - mean * mean, rstd = 1.0f / sqrtf(fmaxf(var, 0.f) + EPS);
                const float y0 = (o0[tt] - mean) * rstd * lg.x + lb.x, y1 = (o1[tt] - mean) * rstd * lg.y + lb.y;
                Cd[(size_t)(t0 + 16 * ch + tt) * 512 + tid] = pk2(y0 * sigmoidf_(y0), y1 * sigmoidf_(y1));
            }
        }
    }
    (void)lane;
}

__device__ __forceinline__ void norm2_phase(const float* X1, const float* g2, bf16* H2, int gw, int NGW, int lane) {
    const GAS f32x4* gp = (const GAS f32x4*)g2 + lane; f32x4 gv[4];
#pragma unroll
    for (int j = 0; j < 4; ++j) gv[j] = gp[64 * j];
    for (int m = gw; m < M; m += NGW) {
        const GAS f32x4* xr = (const GAS f32x4*)(X1 + (size_t)m * D) + lane;
        f32x4 v[4]; float s = 0.f;
#pragma unroll
        for (int j = 0; j < 4; ++j) { v[j] = xr[64 * j]; s += (v[j].x * v[j].x + v[j].y * v[j].y) + (v[j].z * v[j].z + v[j].w * v[j].w); }
        const float rstd = 1.0f / sqrtf(wave_sum(s) * (1.f / D) + EPS);
        GAS unsigned long long* o8 = (GAS unsigned long long*)(H2 + (size_t)m * D) + lane;
#pragma unroll
        for (int j = 0; j < 4; ++j) { const f32x4 t = v[j] * rstd * gv[j]; o8[64 * j] = (unsigned long long)pk2(t.x, t.y) | ((unsigned long long)pk2(t.z, t.w) << 32); }
    }
}

typedef float f32x16 __attribute__((ext_vector_type(16)));
__device__ __forceinline__ unsigned f_ord(float f) { const unsigned b = __float_as_uint(f); return b ^ ((unsigned)((int)b >> 31) | 0x80000000u); }
__device__ __forceinline__ float f_unord(unsigned k) { return __uint_as_float((k & 0x80000000u) ? (k ^ 0x80000000u) : ~k); }
#define CE_DESC(a, b) do { const unsigned hi_ = (a) > (b) ? (a) : (b), lo_ = (a) > (b) ? (b) : (a); (a) = hi_; (b) = lo_; } while (0)
#define CE_ASC(a, b)  do { const unsigned hi_ = (a) > (b) ? (a) : (b), lo_ = (a) > (b) ? (b) : (a); (a) = lo_; (b) = hi_; } while (0)
__device__ __forceinline__ void sort16_desc(unsigned (&v)[16]) {
#pragma unroll
    for (int k = 2; k <= 16; k <<= 1)
#pragma unroll
        for (int j = k >> 1; j > 0; j >>= 1)
#pragma unroll
            for (int i = 0; i < 16; ++i) { const int l = i ^ j; if (l > i) { if ((i & k) == 0) CE_DESC(v[i], v[l]); else CE_ASC(v[i], v[l]); } }
}
__device__ __forceinline__ void merge16_desc(unsigned (&a)[16], const unsigned (&b)[16]) {
#pragma unroll
    for (int i = 0; i < 16; ++i) a[i] = a[i] > b[15 - i] ? a[i] : b[15 - i];
#pragma unroll
    for (int j = 8; j > 0; j >>= 1)
#pragma unroll
        for (int i = 0; i < 16; ++i) { const int l = i ^ j; if (l > i) CE_DESC(a[i], a[l]); }
}
__device__ __forceinline__ void xchg_merge16(unsigned (&a)[16]) {
    unsigned b[16];
#pragma unroll
    for (int i = 0; i < 16; ++i) { auto rr = __builtin_amdgcn_permlane32_swap(a[i], a[i], false, false); b[i] = (threadIdx.x & 32) ? rr[0] : rr[1]; }
    merge16_desc(a, b);
}
constexpr int RK_OFF = 8192, RK_ROWB = 272, RK_HALFB = 128 * RK_ROWB;
__device__ __forceinline__ void route_unit(LAS unsigned char* tabw, const LAS unsigned char* keys, const bf16* QP, unsigned short* IDX, float* GATE, int tok0, int head, int lane) {
    const int r = lane & 31, hi = lane >> 5;
    unsigned L[2][16];
    bf16x8 bqa[2][8];
#pragma unroll
    for (int half = 0; half < 2; ++half) { const bf16* qrow = QP + (size_t)(tok0 + r) * NQP + head * PDK + half * 128 + 8 * hi;
#pragma unroll
        for (int s = 0; s < 8; ++s) bqa[half][s] = *(const bf16x8*)(qrow + 16 * s); }
#pragma unroll
    for (int half = 0; half < 2; ++half) {
        const LAS unsigned char* kb = keys + half * RK_HALFB + r * RK_ROWB + 16 * hi;
        bf16x8 bq[8];
#pragma unroll
        for (int s = 0; s < 8; ++s) bq[s] = bqa[half][s];
        unsigned R[16];
#pragma unroll
        for (int i = 0; i < 16; ++i) R[i] = 0u;
#pragma unroll 1
        for (int nb = 0; nb < 4; ++nb) {
            f32x16 acc = f32x16{};
#pragma unroll
            for (int s = 0; s < 8; ++s) { const bf16x8 ak = *(const LAS bf16x8*)(kb + nb * 32 * RK_ROWB + 32 * s); acc = __builtin_amdgcn_mfma_f32_32x32x16_bf16(ak, bq[s], acc, 0, 0, 0); }
            unsigned g[16];
#pragma unroll
            for (int q = 0; q < 16; ++q) { const int n = 32 * nb + (q & 3) + 8 * (q >> 2) + 4 * hi; g[q] = (f_ord(acc[q]) & ~127u) | (unsigned)(127 - n); }
            sort16_desc(g);
            merge16_desc(R, g);
        }
        xchg_merge16(R);
#pragma unroll
        for (int i = 0; i < 16; ++i) L[half][i] = R[i];
    }
    {
        LAS unsigned* tp = (LAS unsigned*)(tabw + r * 32 + hi * 16);
#pragma unroll
        for (int d = 0; d < 4; ++d) { unsigned w = 0;
#pragma unroll
            for (int b = 0; b < 4; ++b) { const unsigned k1 = L[0][4 * d + b], k2 = L[1][4 * d + b]; const unsigned n = 127u - ((hi ? k2 : k1) & 127u); w |= n << (8 * b); }
            tp[d] = w; }
    }
    float F1[16], F2[16];
#pragma unroll
    for (int i = 0; i < 16; ++i) { F1[i] = f_unord(L[0][i] & ~127u); F2[i] = f_unord(L[1][i] & ~127u); }
    unsigned c0[16], c1[16];
#define CAND(dst, ai, aj, bi, bj) do { const float f1_ = hi ? F1[bi] : F1[ai], f2_ = hi ? F2[bj] : F2[aj]; \
        dst = (f_ord(f1_ + f2_) & ~255u) | (hi ? (unsigned)(255 - ((bi) * 16 + (bj))) : (unsigned)(255 - ((ai) * 16 + (aj)))); } while (0)
    CAND(c0[0], 0, 0, 1, 0);  CAND(c0[1], 0, 1, 1, 1);  CAND(c0[2], 0, 2, 1, 2);  CAND(c0[3], 0, 3, 1, 3);
    CAND(c0[4], 0, 4, 1, 4);  CAND(c0[5], 0, 5, 1, 5);  CAND(c0[6], 0, 6, 1, 6);  CAND(c0[7], 0, 7, 1, 7);
    CAND(c0[8], 0, 8, 2, 0);  CAND(c0[9], 0, 9, 2, 1);  CAND(c0[10], 0, 10, 2, 2); CAND(c0[11], 0, 11, 2, 3);
    CAND(c0[12], 0, 12, 2, 4); CAND(c0[13], 0, 13, 3, 0); CAND(c0[14], 0, 14, 3, 1); CAND(c0[15], 0, 15, 3, 2);
    CAND(c1[0], 8, 0, 3, 3);  CAND(c1[1], 9, 0, 4, 1);  CAND(c1[2], 10, 0, 4, 2); CAND(c1[3], 11, 0, 5, 0);
    CAND(c1[4], 12, 0, 5, 1); CAND(c1[5], 13, 0, 6, 0); CAND(c1[6], 14, 0, 6, 1); CAND(c1[7], 15, 0, 7, 0);
    CAND(c1[8], 4, 0, 7, 1);
#undef CAND
#pragma unroll
    for (int s = 9; s < 16; ++s) c1[s] = 0u;
    sort16_desc(c0); sort16_desc(c1); merge16_desc(c0, c1); xchg_merge16(c0);
    float sc[16]; float ssum = 0.f;
#pragma unroll
    for (int k = 0; k < 16; ++k) { sc[k] = __builtin_amdgcn_exp2f((f_unord(c0[k] & ~255u) - f_unord(c0[0] & ~255u)) * LOG2E); ssum += sc[k]; }
    const float rs = 1.0f / ssum;
    const LAS unsigned char* tb = (const LAS unsigned char*)(tabw + r * 32);
    unsigned ew[4]; f32x4 g0, g1;
#pragma unroll
    for (int kk = 0; kk < 8; ++kk) {
        unsigned ka_ = c0[kk], kb_ = c0[8 + kk]; float sa_ = sc[kk], sb_ = sc[8 + kk];
        asm volatile("" : "+v"(ka_), "+v"(kb_), "+v"(sa_), "+v"(sb_));
        const unsigned key = hi ? kb_ : ka_; const float gt = (hi ? sb_ : sa_) * rs;
        const unsigned code = 255u - (key & 255u); const unsigned e1 = tb[code >> 4], e2 = tb[16 + (code & 15u)];
        const unsigned e = e1 * 128u + e2;
        if (kk & 1) ew[kk >> 1] |= e << 16; else ew[kk >> 1] = e;
        if (kk < 4) g0[kk] = gt; else g1[kk - 4] = gt;
    }
    const size_t o = (size_t)(tok0 + r) * NSEL + head * PTOPK + 8 * hi;
    *(v4u*)(IDX + o) = (v4u){ew[0], ew[1], ew[2], ew[3]};
    *(f32x4*)(GATE + o) = g0; *(f32x4*)(GATE + o + 4) = g1;
}

__device__ __forceinline__ float gelu_tanh(float x) {
    const float y = 0.7978845608028654f * (x + 0.044715f * x * x * x);
    const float t = 1.f - 2.f * __builtin_amdgcn_rcpf(1.f + __builtin_amdgcn_exp2f(2.f * LOG2E * y));
    return 0.5f * x * (1.f + t);
}
__device__ __forceinline__ float dot8(v4u a, v4u b, float acc) {
#pragma unroll
    for (int i = 0; i < 4; ++i) { acc += bf_lo(a[i]) * bf_lo(b[i]); acc += bf_hi(a[i]) * bf_hi(b[i]); }
    return acc;
}
typedef float f32x2 __attribute__((ext_vector_type(2)));
template <int MODE = 0> __device__ __forceinline__ void peer_phase(LAS unsigned char* wl, const bf16* H2, const unsigned char* Uq, const unsigned char* Vq, const unsigned short* IDX, const float* GATE, const float* RSS, const float* g2, float* XO, const float* gf, int gw, int NGW, int lane, unsigned emask = 0xffffu, unsigned eor = 0u, float* ACTg = nullptr) {
    LAS unsigned* lid = (LAS unsigned*)wl; LAS float* la = (LAS float*)(wl + 512);
    float g2v[16];
#pragma unroll
    for (int i = 0; i < 16; ++i) g2v[i] = g2[16 * lane + i];
    for (int tok = gw; tok < M; tok += NGW) {
        const float rs_u = (1.f / U_SCALE) / sqrtf(RSS[tok] * (1.f / D) + EPS);
        float h[16], x1v[16];
        { const v4u hA = *(const v4u*)(H2 + (size_t)tok * D + 16 * lane), hB = *(const v4u*)(H2 + (size_t)tok * D + 16 * lane + 8);
#pragma unroll
          for (int i = 0; i < 4; ++i) { x1v[2 * i] = bf_lo(hA[i]); x1v[2 * i + 1] = bf_hi(hA[i]); x1v[8 + 2 * i] = bf_lo(hB[i]); x1v[8 + 2 * i + 1] = bf_hi(hB[i]); }
#pragma unroll
          for (int i = 0; i < 16; ++i) h[i] = x1v[i] * g2v[i]; }
        lid[lane] = (IDX[(size_t)tok * NSEL + lane] & emask) | eor; lid[64 + lane] = (IDX[(size_t)tok * NSEL + 64 + lane] & emask) | eor;
#pragma unroll 1
        for (int b = 0; b < ((MODE == 1 || MODE == 4) ? 0 : 8); ++b) {
            const float gate = GATE[(size_t)tok * NSEL + 16 * b + ((lane >> 2) & 15)];
            float p[16];
#pragma unroll
            for (int e = 0; e < 16; ++e) {
                const unsigned eid = (unsigned)__builtin_amdgcn_readfirstlane((int)lid[16 * b + e]);
                const v4u w = *(const v4u*)(Uq + (size_t)eid * D + 16 * lane);
                float s = 0.f;
#pragma unroll
                for (int j = 0; j < 4; ++j) { const f32x2 lo = __builtin_amdgcn_cvt_pk_f32_fp8((int)w[j], false), hi2 = __builtin_amdgcn_cvt_pk_f32_fp8((int)w[j], true);
                    s += lo.x * h[4 * j] + lo.y * h[4 * j + 1] + hi2.x * h[4 * j + 2] + hi2.y * h[4 * j + 3]; }
                p[e] = s;
            }
#pragma unroll
            for (int st = 0; st < 4; ++st) { const int msk = 32 >> st, n = 8 >> st; const bool up = (lane & msk) != 0;
#pragma unroll
                for (int i = 0; i < n; ++i) { const float mine = up ? p[i + n] : p[i], theirs = up ? p[i] : p[i + n]; p[i] = mine + __shfl_xor(theirs, msk); } }
            float d = p[0]; d += __shfl_xor(d, 1); d += __shfl_xor(d, 2);
            if ((lane & 3) == 0) la[16 * b + ((lane >> 2) & 15)] = gelu_tanh(d * rs_u) * gate * (1.f / V_SCALE);
        }
        if (MODE == 3) { ACTg[(size_t)tok * NSEL + lane] = la[lane]; ACTg[(size_t)tok * NSEL + 64 + lane] = la[64 + lane]; continue; }
        if (MODE == 4) { la[lane] = ACTg[(size_t)tok * NSEL + lane]; la[64 + lane] = ACTg[(size_t)tok * NSEL + 64 + lane]; }
        float o[16];
#pragma unroll
        for (int i = 0; i < 16; ++i) o[i] = 0.f;
#pragma unroll 1
        for (int b = 0; b < (MODE == 2 ? 0 : 16); ++b) {
#pragma unroll
            for (int e = 0; e < 8; ++e) {
                const unsigned eid = (unsigned)__builtin_amdgcn_readfirstlane((int)lid[8 * b + e]);
                const float a = la[8 * b + e];
                const v4u w = *(const v4u*)(Vq + (size_t)eid * D + 16 * lane);
#pragma unroll
                for (int j = 0; j < 4; ++j) { const f32x2 lo = __builtin_amdgcn_cvt_pk_f32_fp8((int)w[j], false), hi2 = __builtin_amdgcn_cvt_pk_f32_fp8((int)w[j], true);
                    o[4 * j] += a * lo.x; o[4 * j + 1] += a * lo.y; o[4 * j + 2] += a * hi2.x; o[4 * j + 3] += a * hi2.y; }
            }
        }
        float* xr = XO + (size_t)tok * D + 16 * lane; const float* gp = gf + 16 * lane;
        f32x4 xv[4]; float s = 0.f;
#pragma unroll
        for (int j = 0; j < 4; ++j) { xv[j] = (f32x4){x1v[4 * j], x1v[4 * j + 1], x1v[4 * j + 2], x1v[4 * j + 3]} + (f32x4){o[4 * j], o[4 * j + 1], o[4 * j + 2], o[4 * j + 3]}; s += (xv[j].x * xv[j].x + xv[j].y * xv[j].y) + (xv[j].z * xv[j].z + xv[j].w * xv[j].w); }
        const float rstd = 1.0f / sqrtf(wave_sum(s) * (1.f / D) + EPS);
#pragma unroll
        for (int j = 0; j < 4; ++j) *(f32x4*)(xr + 4 * j) = xv[j] * rstd * *(const f32x4*)(gp + 4 * j);
    }
}

template <int UVAR = 0> __device__ __forceinline__ void peer_u_phase(const unsigned char* Uq, const bf16* X1b, const float* g2, const unsigned short* IDX, bf16* PART, LAS unsigned char* wl, LAS unsigned char* obuf_unused, int x, int wrank, int nwv, int lane) {
    const int ip = lane >> 3, jd = lane & 7, r = lane & 15, g = lane >> 4;
    const unsigned char* usl = Uq + (size_t)x * ((size_t)NEXP * 128); const unsigned voff0 = 16u * (unsigned)jd;
    const int tpw = (M + nwv - 1) / nwv, tbeg = wrank * tpw, tend = (tbeg + tpw < M) ? tbeg + tpw : M;
    if (tbeg >= tend || (UVAR & 8)) return;
    (void)g2; (void)obuf_unused;
    LAS unsigned char* obb = wl + 8192; LAS unsigned char* eimg = wl + 12288; LAS unsigned char* obg = obb + 32 * g;
#define PU_STAGE(t0) do { const int t0_ = (t0); v4u si_[4], sx_[4]; \
        _Pragma("unroll") for (int j_ = 0; j_ < 4; ++j_) { si_[j_] = *(const v4u*)((const unsigned char*)IDX + (size_t)t0_ * 256 + 1024 * j_ + 16 * lane); \
            const int ta_ = (t0_ + 4 * j_ + (lane >> 4) < M) ? t0_ + 4 * j_ + (lane >> 4) : M - 1; sx_[j_] = *(const v4u*)(X1b + (size_t)ta_ * D + 128 * x + 8 * (lane & 15)); } \
        _Pragma("unroll") for (int j_ = 0; j_ < 4; ++j_) { *(LAS v4u*)(wl + 1024 * j_ + 16 * lane) = si_[j_]; \
            float hf_[8]; _Pragma("unroll") for (int i_ = 0; i_ < 4; ++i_) { hf_[2 * i_] = fminf(fmaxf(bf_lo(sx_[j_][i_]) * H_SCALE, -440.f), 440.f); hf_[2 * i_ + 1] = fminf(fmaxf(bf_hi(sx_[j_][i_]) * H_SCALE, -440.f), 440.f); } \
            int a0 = __builtin_amdgcn_cvt_pk_fp8_f32(hf_[0], hf_[1], 0, false); a0 = __builtin_amdgcn_cvt_pk_fp8_f32(hf_[2], hf_[3], a0, true); \
            int a1 = __builtin_amdgcn_cvt_pk_fp8_f32(hf_[4], hf_[5], 0, false); a1 = __builtin_amdgcn_cvt_pk_fp8_f32(hf_[6], hf_[7], a1, true); \
            const f32x2 d0 = __builtin_amdgcn_cvt_pk_f32_fp8(a0, false), d1 = __builtin_amdgcn_cvt_pk_f32_fp8(a0, true), d2 = __builtin_amdgcn_cvt_pk_f32_fp8(a1, false), d3 = __builtin_amdgcn_cvt_pk_f32_fp8(a1, true); \
            int b0 = __builtin_amdgcn_cvt_pk_fp8_f32((hf_[0] - d0.x) * 16.f, (hf_[1] - d0.y) * 16.f, 0, false); b0 = __builtin_amdgcn_cvt_pk_fp8_f32((hf_[2] - d1.x) * 16.f, (hf_[3] - d1.y) * 16.f, b0, true); \
            int b1 = __builtin_amdgcn_cvt_pk_fp8_f32((hf_[4] - d2.x) * 16.f, (hf_[5] - d2.y) * 16.f, 0, false); b1 = __builtin_amdgcn_cvt_pk_fp8_f32((hf_[6] - d3.x) * 16.f, (hf_[7] - d3.y) * 16.f, b1, true); \
            *(LAS u32x2*)(wl + 4096 + (4 * j_ + (lane >> 4)) * 128 + 8 * (lane & 15)) = (u32x2){(unsigned)a0, (unsigned)a1}; \
            *(LAS u32x2*)(wl + 6144 + (4 * j_ + (lane >> 4)) * 128 + 8 * (lane & 15)) = (u32x2){(unsigned)b0, (unsigned)b1}; } } while (0)
#define PU_EID(i0, i1, ld) (((ld) < 8) ? (((ld) & 1) ? (i0[((ld) & 7) >> 1] >> 16) : (i0[((ld) & 7) >> 1] & 0xffffu)) : (((ld) & 1) ? (i1[((ld) & 7) >> 1] >> 16) : (i1[((ld) & 7) >> 1] & 0xffffu)))
#define PU_ROWS(sl, wv) do { const v4u i0_ = *(const LAS v4u*)(wl + (sl) * 256 + 32 * ip), i1_ = *(const LAS v4u*)(wl + (sl) * 256 + 32 * ip + 16); \
        _Pragma("unroll") for (int ld = 0; ld < 16; ++ld) wv[ld] = *(const v4u*)(usl + (PU_EID(i0_, i1_, ld) * 128u + voff0)); \
        __builtin_amdgcn_sched_barrier(0); } while (0)
#define PU_L2(v) ((long)(((unsigned long long)(v).y << 32) | (v).x))
#define PU_COMPUTE(wv, sl) do { \
        const LAS unsigned char* hb_ = wl + 4096 + ((r >= 8) ? 2048 : 0) + (sl) * 128 + 8 * g; \
        long Bk[4]; _Pragma("unroll") for (int s_ = 0; s_ < 4; ++s_) { const u32x2 t_ = *(const LAS u32x2*)(hb_ + 32 * s_); Bk[s_] = PU_L2(t_); } \
        _Pragma("unroll") for (int q = 0; q < 4; ++q) { \
            _Pragma("unroll") for (int l1 = 0; l1 < 4; ++l1) *(LAS v4u*)(eimg + (4 * ip + l1) * 144 + 16 * jd) = wv[4 * q + l1]; \
            _Pragma("unroll") for (int jt = 0; jt < 2; ++jt) { f32x4 acc = {0.f, 0.f, 0.f, 0.f}; \
                _Pragma("unroll") for (int s_ = 0; s_ < 4; ++s_) { const u32x2 a_ = *(const LAS u32x2*)(eimg + (16 * jt + r) * 144 + 32 * s_ + 8 * g); acc = __builtin_amdgcn_mfma_f32_16x16x32_fp8_fp8(PU_L2(a_), Bk[s_], acc, 0, 0, 0); } \
                float v_[4]; _Pragma("unroll") for (int i_ = 0; i_ < 4; ++i_) { const float y_ = __builtin_bit_cast(float, __builtin_amdgcn_update_dpp(0, __builtin_bit_cast(int, acc[i_]), 0x128, 0xf, 0xf, false)); \
                    v_[i_] = acc[i_] * (1.f / H_SCALE) + y_ * (1.f / (16.f * H_SCALE)); } \
                if (r == 0) *(LAS u32x2*)(obg + ((sl) * 256 + 128 * jt + 8 * q)) = (u32x2){pk2(v_[0], v_[1]), pk2(v_[2], v_[3])}; } } \
        __builtin_amdgcn_sched_barrier(0); \
    } while (0)
    for (int t0 = tbeg; t0 < tend; t0 += 16) {
        const int nb = (tend - t0 < 16) ? tend - t0 : 16;
        PU_STAGE(t0);
        v4u wA[16], wB[16];
        PU_ROWS(0, wA);
        if (nb == 16) {
#pragma unroll
            for (int s = 0; s < 16; s += 2) {
                PU_ROWS(s + 1, wB);
                PU_COMPUTE(wA, s);
                if (s + 2 < 16) PU_ROWS(s + 2, wA);
                PU_COMPUTE(wB, s + 1);
            }
        } else {
#pragma unroll 1
            for (int s = 0; s < nb; ++s) { PU_ROWS(s, wA); PU_COMPUTE(wA, s); }
        }
        { unsigned char* dst_ = (unsigned char*)(PART + ((size_t)x * M + t0) * NSEL); const int n16_ = nb * 16;
#pragma unroll
          for (int j = 0; j < 4; ++j) { const int c_ = j * 64 + lane; if (c_ < n16_) *(v4u*)(dst_ + 16 * c_) = *(const LAS v4u*)(obb + 16 * c_); } }
    }
#undef PU_STAGE
#undef PU_EID
#undef PU_ROWS
#undef PU_L2
#undef PU_COMPUTE
}
__device__ __forceinline__ void peer_c_phase(const bf16* PART, const float* GATE, const float* RSS, bf16* ACT, int gtid, int ngt) {
    constexpr int NIT = M * (NSEL / 8);
    for (int it0 = gtid; it0 < NIT; it0 += 2 * ngt) {
        v4u pv[2][8]; f32x4 g0[2], g1[2]; float rss[2];
#pragma unroll
        for (int u = 0; u < 2; ++u) { const int it = (it0 + u * ngt < NIT) ? it0 + u * ngt : it0, tok = it >> 4, k8 = (it & 15) * 8;
#pragma unroll
            for (int xx = 0; xx < 8; ++xx) pv[u][xx] = *(const v4u*)(PART + ((size_t)xx * M + tok) * NSEL + k8);
            g0[u] = *(const f32x4*)(GATE + (size_t)tok * NSEL + k8); g1[u] = *(const f32x4*)(GATE + (size_t)tok * NSEL + k8 + 4); rss[u] = RSS[tok]; }
#pragma unroll
        for (int u = 0; u < 2; ++u) { const int it = (it0 + u * ngt < NIT) ? it0 + u * ngt : it0, tok = it >> 4, k8 = (it & 15) * 8;
            const float rs = (1.f / U_SCALE) / sqrtf(rss[u] * (1.f / D) + EPS);
            float s[8];
#pragma unroll
            for (int i = 0; i < 8; ++i) s[i] = 0.f;
#pragma unroll
            for (int xx = 0; xx < 8; ++xx)
#pragma unroll
                for (int i = 0; i < 4; ++i) { s[2 * i] += bf_lo(pv[u][xx][i]); s[2 * i + 1] += bf_hi(pv[u][xx][i]); }
            float o[8];
#pragma unroll
            for (int i = 0; i < 4; ++i) { o[i] = fminf(gelu_tanh(s[i] * rs) * g0[u][i] * A_SCALE, 440.f); o[4 + i] = fminf(gelu_tanh(s[4 + i] * rs) * g1[u][i] * A_SCALE, 440.f); }
            int w0 = __builtin_amdgcn_cvt_pk_fp8_f32(o[0], o[1], 0, false); w0 = __builtin_amdgcn_cvt_pk_fp8_f32(o[2], o[3], w0, true);
            int w1 = __builtin_amdgcn_cvt_pk_fp8_f32(o[4], o[5], 0, false); w1 = __builtin_amdgcn_cvt_pk_fp8_f32(o[6], o[7], w1, true);
            *(u32x2*)((unsigned char*)ACT + (size_t)tok * NSEL + k8) = (u32x2){(unsigned)w0, (unsigned)w1}; }
    }
}
__device__ __forceinline__ void peer_v_phase(const unsigned char* Vq, const unsigned short* IDX, const bf16* ACT, bf16* PO, LAS unsigned char* wl, LAS unsigned char* obuf, int x, int wrank, int nwv, int lane) {
    const int ip = lane >> 3, jd = lane & 7;
    const unsigned char* vsl = Vq + (size_t)x * ((size_t)NEXP * 128); const unsigned voff0 = 16u * (unsigned)jd;
    const int tpw = (M + nwv - 1) / nwv, tbeg = wrank * tpw, tend = (tbeg + tpw < M) ? tbeg + tpw : M;
    if (tbeg >= tend) return;
    LAS float* ob = (LAS float*)obuf;
#define PV_STAGE(t0) do { const int t0_ = (t0); \
        const v4u s0_ = *(const v4u*)((const unsigned char*)IDX + (size_t)t0_ * 256 + 16 * lane), s1_ = *(const v4u*)((const unsigned char*)IDX + (size_t)t0_ * 256 + 1024 + 16 * lane); \
        const v4u s2a_ = *(const v4u*)((const unsigned char*)IDX + (size_t)t0_ * 256 + 2048 + 16 * lane), s3a_ = *(const v4u*)((const unsigned char*)IDX + (size_t)t0_ * 256 + 3072 + 16 * lane); \
        const v4u a0_ = *(const v4u*)((const unsigned char*)ACT + (size_t)t0_ * 128 + 16 * lane), a1_ = *(const v4u*)((const unsigned char*)ACT + (size_t)t0_ * 128 + 1024 + 16 * lane); \
        *(LAS v4u*)(wl + 16 * lane) = s0_; *(LAS v4u*)(wl + 1024 + 16 * lane) = s1_; *(LAS v4u*)(wl + 2048 + 16 * lane) = s2a_; *(LAS v4u*)(wl + 3072 + 16 * lane) = s3a_; \
        *(LAS v4u*)(wl + 4096 + 16 * lane) = a0_; *(LAS v4u*)(wl + 5120 + 16 * lane) = a1_; } while (0)
#define PV_EID(i0, i1, ld) (((ld) < 8) ? (((ld) & 1) ? (i0[((ld) & 7) >> 1] >> 16) : (i0[((ld) & 7) >> 1] & 0xffffu)) : (((ld) & 1) ? (i1[((ld) & 7) >> 1] >> 16) : (i1[((ld) & 7) >> 1] & 0xffffu)))
#define PV_ROWS(sl, wv) do { const v4u i0_ = *(const LAS v4u*)(wl + (sl) * 256 + 32 * ip), i1_ = *(const LAS v4u*)(wl + (sl) * 256 + 32 * ip + 16); \
        _Pragma("unroll") for (int ld = 0; ld < 16; ++ld) wv[ld] = *(const v4u*)(vsl + (PV_EID(i0_, i1_, ld) * 128u + voff0)); \
        __builtin_amdgcn_sched_barrier(0); } while (0)
#define PV_COMPUTE(wv, sl) do { \
          \
        const v4u ab_ = *(const LAS v4u*)(wl + 4096 + (sl) * 128 + 16 * ip); \
        f32x4 c1_ = (f32x4){0.f, 0.f, 0.f, 0.f}, c2_ = (f32x4){0.f, 0.f, 0.f, 0.f}; \
        _Pragma("unroll") for (int ld = 0; ld < 16; ++ld) { const unsigned sft_ = ((ab_[ld >> 2] >> (8 * (ld & 3))) & 0xffu) << sh8; \
            const unsigned alo_ = jhi ? 0u : sft_, ahi_ = jhi ? sft_ : 0u; \
            const long A_ = (long)(((unsigned long long)ahi_ << 32) | alo_); const v4u w = wv[ld]; \
            c1_ = __builtin_amdgcn_mfma_f32_16x16x32_fp8_fp8(A_, (long)(((unsigned long long)w.y << 32) | w.x), c1_, 0, 0, 0); \
            c2_ = __builtin_amdgcn_mfma_f32_16x16x32_fp8_fp8(A_, (long)(((unsigned long long)w.w << 32) | w.z), c2_, 0, 0, 0); } \
        float r_[8] = {c1_[0], c1_[1], c1_[2], c1_[3], c2_[0], c2_[1], c2_[2], c2_[3]}; \
        _Pragma("unroll") for (int i = 0; i < 8; ++i) r_[i] = (r_[i] + __shfl(r_[i], plane)) * (1.f / (A_SCALE * V_SCALE)); \
        { LAS unsigned char* op_ = obase + (sl) * ostride; *(LAS f32x4*)op_ = (f32x4){r_[0], r_[1], r_[2], r_[3]}; *(LAS f32x4*)(op_ + 32) = (f32x4){r_[4], r_[5], r_[6], r_[7]}; } \
        __builtin_amdgcn_sched_barrier(0); \
    } while (0)
    const unsigned sh8 = 8u * (unsigned)(jd & 3); const bool jhi = (jd & 4) != 0; const int plane = (lane + 40) & 63;
    const bool ovalid = ((lane & 15) < 8) && (lane < 32);
    LAS unsigned char* obase = ovalid ? obuf + 4 * (16 * (lane & 15) + 4 * (lane >> 4)) : wl + 6144 + 16 * lane; const int ostride = ovalid ? 512 : 0;
    for (int t0 = tbeg; t0 < tend; t0 += 16) {
        const int nb = (tend - t0 < 16) ? tend - t0 : 16;
        PV_STAGE(t0);
        v4u wA[16], wB[16];
        PV_ROWS(0, wA);
        if (nb == 16) {
#pragma unroll
            for (int s = 0; s < 16; s += 2) {
                PV_ROWS(s + 1, wB);
                PV_COMPUTE(wA, s);
                if (s + 2 < 16) PV_ROWS(s + 2, wA);
                PV_COMPUTE(wB, s + 1);
            }
        } else {
#pragma unroll 1
            for (int s = 0; s < nb; ++s) { PV_ROWS(s, wA); PV_COMPUTE(wA, s); }
        }
        { bf16* dst_ = PO + ((size_t)x * M + t0) * 128; const int n8_ = nb * 16;
#pragma unroll
          for (int j = 0; j < 4; ++j) { const int c_ = j * 64 + lane; if (c_ < n8_) { const f32x4 a_ = *(const LAS f32x4*)(ob + 8 * c_), b_ = *(const LAS f32x4*)(ob + 8 * c_ + 4);
              *(v4u*)(dst_ + 8 * c_) = (v4u){pk2(a_.x, a_.y), pk2(a_.z, a_.w), pk2(b_.x, b_.y), pk2(b_.z, b_.w)}; } } }
    }
#undef PV_STAGE
#undef PV_EID
#undef PV_ROWS
#undef PV_COMPUTE
}
__device__ __forceinline__ void peer_f_phase(const bf16* X1b, const bf16* PO, float* XO, const float* gf, int gw, int NGW, int lane) {
    const GAS f32x4* gp = (const GAS f32x4*)gf + lane; f32x4 gv[4];
#pragma unroll
    for (int j = 0; j < 4; ++j) gv[j] = gp[64 * j];
    for (int m = gw; m < M; m += NGW) {
        GAS f32x4* xr = (GAS f32x4*)(XO + (size_t)m * D) + lane;
        f32x4 v[4]; float s = 0.f;
#pragma unroll
        for (int j = 0; j < 4; ++j) { const int dd = 4 * lane + 256 * j; const u32x2 xb = *(const u32x2*)(X1b + (size_t)m * D + dd);
            const u32x2 pb = *(const u32x2*)(PO + ((size_t)(dd >> 7) * M + m) * 128 + (dd & 127));
            v[j] = (f32x4){bf_lo(xb.x), bf_hi(xb.x), bf_lo(xb.y), bf_hi(xb.y)} + (f32x4){bf_lo(pb.x), bf_hi(pb.x), bf_lo(pb.y), bf_hi(pb.y)};
            s += (v[j].x * v[j].x + v[j].y * v[j].y) + (v[j].z * v[j].z + v[j].w * v[j].w); }
        const float rstd = 1.0f / sqrtf(wave_sum(s) * (1.f / D) + EPS);
#pragma unroll
        for (int j = 0; j < 4; ++j) xr[64 * j] = v[j] * rstd * gv[j];
    }
}

#ifndef PEER_SPLIT
#define PEER_SPLIT 0
#endif
constexpr int N_PHASES = PEER_SLICED ? 12 : (PEER_SPLIT ? 10 : 9);
#ifndef MK_FUSED
#define MK_FUSED 1
#endif
struct Args { const float* in[18]; float* out; unsigned char* ws; int ph_lo, ph_hi; };
__global__ void __launch_bounds__(NWAVES * 64, 2) hyb_fwd(Args args) {
    extern __shared__ __attribute__((aligned(16))) unsigned char lds[];
    LAS unsigned char* L = (LAS unsigned char*)lds;
    volatile LAS unsigned* MISC = (volatile LAS unsigned*)(L + MISC_OFF);
    const int tid = threadIdx.x, lane = tid & 63, wave = __builtin_amdgcn_readfirstlane(tid >> 6);
    const int G = gridDim.x; const int bx = blockIdx.x; const int vcu = (G % 8 == 0) ? (bx % 8) * (G / 8) + bx / 8 : bx;
    const int gw = vcu * NWAVES + wave, NGW = G * NWAVES;
    unsigned char* ws = args.ws;
    gu32* ctl = (gu32*)(ws + WS_CTL);
    const float* x = args.in[0]; float* out = args.out;
    bf16 *WIN = (bf16*)(ws + WS_WIN), *WC = (bf16*)(ws + WS_WC), *WF = (bf16*)(ws + WS_WF), *WO = (bf16*)(ws + WS_WO), *WQ = (bf16*)(ws + WS_WQ);
    bf16 *K1b = (bf16*)(ws + WS_K1), *K2b = (bf16*)(ws + WS_K2); unsigned char *Uq = ws + WS_U, *Vq = ws + WS_VT;
    bf16 *XN = (bf16*)(ws + WS_XN), *CZ = XN, *GLU = (bf16*)(ws + WS_GLU), *MM = GLU, *QO = (bf16*)(ws + WS_QO), *KB = (bf16*)(ws + WS_K), *H2 = KB, *VB = (bf16*)(ws + WS_V);
    bf16 *QP = (bf16*)(ws + WS_QP), *GA = (bf16*)out, *GB = (bf16*)out + (size_t)M * D;
    float *LOGF = (float*)(ws + WS_LOGF), *C2 = (float*)(ws + WS_C2), *GATE = (float*)(ws + WS_GATE);
    unsigned short* IDX = (unsigned short*)(ws + WS_IDX);
    for (int u = tid; u < (LDS_BYTES - LDSCTL_OFF) / 4; u += NWAVES * 64) ((LAS unsigned*)(L + LDSCTL_OFF))[u] = 0u;
    __syncthreads();
#if MK_FUSED
    XcdBarrier bar = xcd_barrier_post((unsigned*)(ctl + CW_BAR), MISC + 8);
#define GRID_BAR() xcd_barrier(bar)
#else
#define GRID_BAR() do {} while (0)
    (void)MISC; (void)ctl;
#endif
    const int lo = args.ph_lo, hi = args.ph_hi;
#ifdef ONLY_PHASE
#define IN(k) ((k) == ONLY_PHASE)
#else
#define IN(k) (lo <= (k) && (k) < hi)
#endif
#define BOTH(k) (IN(k) && IN((k) + 1))
#ifdef REP_PHASE
#define REPS(k) for (int rep_ = ((k) == REP_PHASE) ? 0 : 1; rep_ < 2; ++rep_)
#define REP_BAR() do { if (rep_ == 0) GRID_BAR(); } while (0)
#else
#define REPS(k)
#define REP_BAR() do {} while (0)
constexpr int rep_ = 1;
#endif
#ifndef P0_PARTS
#define P0_PARTS 7
#endif
#ifndef REP_EMASK
#define REP_EMASK 0xffffu
#define REP_ESTRIDE 0u
#endif

    if (IN(0)) REPS(0) {
        P0Args a{args.in[11], x, args.in[1], args.in[2], args.in[7], args.in[9], args.in[10], args.in[12], args.in[13], args.in[14], args.in[15], args.in[16], args.in[8],
                 WIN, WC, WF, WO, WQ, K1b, K2b, Uq, Vq, XN, LOGF};
        p0_prologue(L, a, vcu, G, tid, rep_ ? 7 : P0_PARTS); REP_BAR();
        if (rep_ && BOTH(0)) GRID_BAR();
    }
    if (IN(1)) REPS(1) {
        pg8::Gemm g{XN, XN, WIN, WIN, M, N1, D}; pg8::StaticOrder S; S.init(M, N1, G, bx);
        pg8::EpiP1 E{GLU, QO, KB, VB, GA, GB, attn_body::C2, (unsigned*)(ctl + CW_STAT)};
        pg8::gemm_phase<pg8::EpiP1, pg8::StaticOrder, true, true>(L + RING_OFF, g, S, E); REP_BAR();
        if (rep_ && BOTH(1)) GRID_BAR();
    }
    if (IN(2)) REPS(2) {
        for (int bh = vcu; bh < BATCH * NHEADS; bh += G) scan_unit(L, LOGF, C2, bh, tid);
        conv_phase(L, GLU, args.in[3], args.in[4], args.in[5], args.in[6], CZ, vcu, G, tid); REP_BAR();
        if (rep_ && BOTH(2)) GRID_BAR();
    }
    if (IN(3)) REPS(3) {
        const attn_body::AttnTensors AT{(const attn_body::bf16*)QO, (const attn_body::bf16*)KB, (const attn_body::bf16*)VB, (attn_body::bf16*)(rep_ ? QO : GLU), C2};
#if MK_FUSED
        attn_body::attn_phase_queue<8>((char*)lds + RING_OFF, AT, (unsigned*)(ctl + CW_ATTQ) + (rep_ ? 0 : 64), (const float*)(ctl + CW_STAT), LDSCTL_OFF + 64); REP_BAR();
#else
        const attn_body::StaticOrder S(G, bx);
        attn_body::attn_phase<attn_body::StaticOrder>((char*)lds + RING_OFF, AT, S); REP_BAR();
#endif
        if (rep_ && BOTH(3)) GRID_BAR();
    }
    if (IN(4)) REPS(4) {
        pg8::Gemm g{CZ, QO, WC, WF, M, D, D}; pg8::DualOrder S; S.init(M, D, G, bx);
        pg8::EpiDual E{GA, GB, MM};
        pg8::gemm_phase<pg8::EpiDual, pg8::DualOrder, true, true>(L + RING_OFF, g, S, E); REP_BAR();
        if (rep_ && BOTH(4)) GRID_BAR();
    }
    if (IN(5)) REPS(5) {
        pg8::Gemm g{MM, MM, WO, WO, M, D, D}; pg8::StaticOrder S; S.init(M, D, G, bx);
        pg8::EpiResNorm E{x, H2, (float*)(ctl + CW_RSS), args.in[11], nullptr, nullptr};
        pg8::gemm_phase<pg8::EpiResNorm, pg8::StaticOrder, true, true>(L + RING_OFF, g, S, E); REP_BAR();
        if (rep_ && BOTH(5)) GRID_BAR();
    }
    if (IN(6)) REPS(6) {
        pg8::Gemm g{H2, H2, WQ, WQ, M, NQP, D}; pg8::StaticOrder S; S.init(M, NQP, G, bx);
        pg8::EpiScaleRow E{QP, NQP, (const float*)(ctl + CW_RSS)};
        pg8::gemm_phase<pg8::EpiScaleRow, pg8::StaticOrder, true, true>(L + RING_OFF, g, S, E); REP_BAR();
        if (rep_ && BOTH(6)) GRID_BAR();
    }
    if (IN(7)) REPS(7) {
        const int head = bx & 7, nwg_h = (G - head + 7) >> 3;
        for (int ci = tid; ci < 4096; ci += NWAVES * 64) { const int half = ci >> 11, row = (ci >> 4) & 127, c16 = ci & 15;
            *(LAS v4u*)(L + RK_OFF + half * RK_HALFB + row * RK_ROWB + c16 * 16) = *(const v4u*)((half ? K2b : K1b) + (size_t)(head * PNK + row) * 128 + c16 * 8); }
        __syncthreads();
        for (int tg = (bx >> 3) * NWAVES + wave; tg < M / 32; tg += nwg_h * NWAVES) route_unit(L + wave * 1024, L + RK_OFF, QP, IDX, GATE, tg * 32, head, lane);
        __syncthreads(); REP_BAR();
        if (rep_ && BOTH(7)) GRID_BAR();
    }
#if PEER_SLICED
    {
        const int xs = bx & 7, nwg_x = (G - xs + 7) >> 3, wrank = (bx >> 3) * NWAVES + wave, nwv = nwg_x * NWAVES;
        bf16 *PART = (bf16*)(ws + WS_PART), *PO = (bf16*)(ws + WS_PART), *ACT = (bf16*)(ws + WS_ACT);
        if (IN(8)) REPS(8) {
#ifdef PROBE_UVAR
            if (!rep_) { peer_u_phase<PROBE_UVAR>(Uq, H2, args.in[11], IDX, PART, L + wave * PU_LDS, L, xs, wrank, nwv, lane); REP_BAR(); continue; }
#endif
            peer_u_phase(Uq, H2, args.in[11], IDX, PART, L + wave * PU_LDS, L, xs, wrank, nwv, lane); REP_BAR(); if (rep_ && BOTH(8)) GRID_BAR(); }
        if (IN(9)) REPS(9) { peer_c_phase(PART, GATE, (const float*)(ctl + CW_RSS), ACT, gw * 64 + lane, NGW * 64); REP_BAR(); if (rep_ && BOTH(9)) GRID_BAR(); }
        if (IN(10)) REPS(10) { peer_v_phase(Vq, IDX, ACT, PO, L + wave * 8192, L + 65536 + wave * 8192, xs, wrank, nwv, lane); REP_BAR(); if (rep_ && BOTH(10)) GRID_BAR(); }
        if (IN(11)) REPS(11) { peer_f_phase(H2, PO, out, args.in[17], gw, NGW, lane); REP_BAR(); }
    }
#elif PEER_SPLIT
    if (IN(8)) { peer_phase<3>(L + wave * 1024, H2, Uq, Vq, IDX, GATE, (const float*)(ctl + CW_RSS), args.in[11], out, args.in[17], gw, NGW, lane, 0xffffu, 0u, (float*)(ws + WS_ACT)); if (BOTH(8)) GRID_BAR(); }
    if (IN(9)) peer_phase<4>(L + wave * 1024, H2, Uq, Vq, IDX, GATE, (const float*)(ctl + CW_RSS), args.in[11], out, args.in[17], gw, NGW, lane, 0xffffu, 0u, (float*)(ws + WS_ACT));
#else
    if (IN(8)) REPS(8) {
#ifdef PROBE_MODE
        if (!rep_) { peer_phase<PROBE_MODE>(L + wave * 1024, H2, Uq, Vq, IDX, GATE, (const float*)(ctl + CW_RSS), args.in[11], (float*)QP, args.in[17], gw, NGW, lane, REP_EMASK, (unsigned)(bx & 7) * REP_ESTRIDE); REP_BAR(); continue; }
#endif
        peer_phase(L + wave * 1024, H2, Uq, Vq, IDX, GATE, (const float*)(ctl + CW_RSS), args.in[11], rep_ ? out : (float*)QP, args.in[17], gw, NGW, lane, rep_ ? 0xffffu : REP_EMASK, rep_ ? 0u : (unsigned)(bx & 7) * REP_ESTRIDE); REP_BAR(); }
#endif
#undef IN
#undef BOTH
}

extern "C" void kernel_launch(void* const* d_in, const int* in_sizes, int n_in, void* d_out, int out_size, void* d_ws, size_t ws_size, hipStream_t stream) {
    static int grid = 0;
    if (grid == 0) {
        if (n_in != 18 || in_sizes[0] != M * D || out_size != M * D || ws_size < WS_END) { fprintf(stderr, "kernel_launch: unexpected shapes (n_in %d, ws %zu)\n", n_in, ws_size); grid = -1; return; }
        int dev = 0, cus = 0, per_cu = 0;
        if (hipGetDevice(&dev) != hipSuccess || hipDeviceGetAttribute(&cus, hipDeviceAttributeMultiprocessorCount, dev) != hipSuccess) { grid = -1; return; }
        if (hipFuncSetAttribute((const void*)hyb_fwd, hipFuncAttributeMaxDynamicSharedMemorySize, LDS_BYTES) != hipSuccess) { fprintf(stderr, "kernel_launch: hipFuncSetAttribute failed\n"); grid = -1; return; }
        if (hipOccupancyMaxActiveBlocksPerMultiprocessor(&per_cu, (const void*)hyb_fwd, NWAVES * 64, LDS_BYTES) != hipSuccess || per_cu < 1) { fprintf(stderr, "kernel_launch: occupancy query says %d\n", per_cu); per_cu = 1; }
        (void)hipGetLastError();
        grid = cus;
    }
    if (grid < 0) return;
    Args a{};
    for (int i = 0; i < 18; ++i) a.in[i] = (const float*)d_in[i];
    a.out = (float*)d_out; a.ws = (unsigned char*)d_ws;
    (void)hipMemsetAsync((char*)d_ws + WS_CTL, 0, CTL_ZERO_BYTES, stream);
#if MK_FUSED
    a.ph_lo = 0; a.ph_hi = N_PHASES;
    void* kargs[] = {&a};
    hipError_t e = hipLaunchCooperativeKernel((const void*)hyb_fwd, dim3(grid), dim3(NWAVES * 64), kargs, LDS_BYTES, stream);
    if (e != hipSuccess) fprintf(stderr, "kernel_launch: cooperative launch failed: %s\n", hipGetErrorString(e));
#else
    for (int p = 0; p < N_PHASES; ++p) { a.ph_lo = p; a.ph_hi = p + 1; hipLaunchKernelGGL(hyb_fwd, dim3(grid), dim3(NWAVES * 64), LDS_BYTES, stream, a); }
#endif
}
```

```cpp
#include <hip/hip_runtime.h>
#include <hip/hip_bf16.h>
#include <cstdio>
#include <cstdint>
#include <cmath>
namespace pg8 {
#define PG8_LAS __attribute__((address_space(3)))
typedef unsigned short bf16_t;
typedef short bf16x8 __attribute__((ext_vector_type(8)));
typedef float f32x4 __attribute__((ext_vector_type(4)));
typedef unsigned u32x4 __attribute__((ext_vector_type(4)));
constexpr int BM = 256, BK = 64, HALF = 128, HTB = HALF * BK * 2  , STAGE_BYTES = 8 * HTB, NXCD = 8, WGM = 8;

__host__ __device__ __forceinline__ int lds_byte(int r, int c) { const int st = (r >> 4) * 2 + (c >> 5), rr = r & 15, cc = c & 31, ob = rr * 64 + cc * 2; return st * 1024 + (ob ^ (((ob >> 9) & 1) << 5)); }
__host__ __device__ __forceinline__ void stage_rc(int b, int& R, int& C) { const int st = b / 1024, sb = b % 1024, swz = sb ^ (((sb >> 9) & 1) << 5); R = (st >> 1) * 16 + swz / 64; C = (st & 1) * 32 + (swz % 64) / 2; }
__host__ __device__ __forceinline__ int perm32(int rho) { const int n = rho >> 4, i = rho & 15; return 8 * (i >> 2) + 4 * n + (i & 3); }

struct Unit { int pm, pn, seg; };
struct Gemm { const bf16_t *A0, *A1, *B0, *B1; int M, N, K; };

struct StaticOrder {
    int nM, nN, nwg, G, c;
    __host__ __device__ __forceinline__ void init(int M, int N, int G_, int c_) { nM = M / BM; nN = N / BM; nwg = nM * nN; G = G_; c = c_; }
    __host__ __device__ __forceinline__ bool next(int i, Unit& u) const {
        const long L = (long)i * G + c; if (L >= nwg) return false;
        int wgid = (int)L; { const int q = nwg / NXCD, r = nwg % NXCD, xcd = wgid % NXCD, off = wgid / NXCD; wgid = (xcd < r ? xcd * (q + 1) : r * (q + 1) + (xcd - r) * q) + off; }
        const int nig = WGM * nN, gid = wgid / nig, fm = gid * WGM, gsz = (nM - fm) < WGM ? (nM - fm) : WGM;
        u.pm = fm + ((wgid % nig) % gsz); u.pn = (wgid % nig) / gsz; u.seg = 0; return true;
    }
    __device__ __forceinline__ void a_ready(const Unit&) const {}
    __device__ __forceinline__ void done(const Unit&) const {}
};

__device__ __forceinline__ unsigned cvt_pk_bf16(float lo, float hi) { unsigned r; asm volatile("v_cvt_pk_bf16_f32 %0, %1, %2" : "=v"(r) : "v"(lo), "v"(hi)); return r; }
typedef float f32x2 __attribute__((ext_vector_type(2)));
__device__ __forceinline__ f32x2 gelu_pk(f32x2 v) {
    const f32x2 av = __builtin_elementwise_abs(v), d = av * 0.2316418882f + 1.0f;
    f32x2 t; t.x = __builtin_amdgcn_rcpf(d.x); t.y = __builtin_amdgcn_rcpf(d.y);
    f32x2 q = t * 0.5307027145f + (-0.7265760135f); q = q * t + 0.7107068705f; q = q * t + (-0.142248368f); q = q * t + 0.127414796f; q = q * t;
    const f32x2 s = (v * v) * (-0.72134752044f);
    f32x2 e; e.x = __builtin_amdgcn_exp2f(s.x); e.y = __builtin_amdgcn_exp2f(s.y);
    const f32x2 m = v * (q * e), r = v - m;
    f32x2 o; o.x = v.x < 0.f ? m.x : r.x; o.y = v.y < 0.f ? m.y : r.y; return o;
}

template <int ACT  > struct EpiBf16 {
    static constexpr bool PERM = true, AFTER_DRAIN = false; static_assert(ACT == 0 || ACT == 1, "EpiBf16: ACT is 0 (none) or 1 (gelu_pk)");
    bf16_t* O; int ldc; const float* bias; int split_cols; size_t split_stride; float scale0;
    __device__ __forceinline__ void operator()(const f32x4 (&acc)[2][2][4][2], const Unit& u, int wr, int wc, int fr, int fq) const {
        const int row0 = u.pm * BM + wr * 64 + fr; int colt = u.pn * BM; bf16_t* base = O;
        float sc = 1.f; if (split_cols) { const int t = colt / split_cols; base += (size_t)t * split_stride; colt -= t * split_cols; if (t == 0) sc = scale0; }
        const int col0 = colt + wc * 32 + 8 * fq, bcol0 = u.pn * BM + wc * 32 + 8 * fq;
        f32x4 bv[2][2];
#pragma unroll
        for (int bj = 0; bj < 2; ++bj)
#pragma unroll
            for (int n = 0; n < 2; ++n) bv[bj][n] = bias ? *(const f32x4*)(bias + bcol0 + bj * HALF + 4 * n) : (f32x4){0.f, 0.f, 0.f, 0.f};
#pragma unroll
        for (int ai = 0; ai < 2; ++ai)
#pragma unroll
            for (int m = 0; m < 4; ++m) { bf16_t* rowp = base + (size_t)(row0 + ai * HALF + m * 16) * ldc + col0;
#pragma unroll
                for (int bj = 0; bj < 2; ++bj) { f32x4 v0 = acc[ai][bj][m][0] + bv[bj][0], v1 = acc[ai][bj][m][1] + bv[bj][1];
                    if (ACT == 1) { f32x2 a = gelu_pk((f32x2){v0[0], v0[1]}), b = gelu_pk((f32x2){v0[2], v0[3]}), c = gelu_pk((f32x2){v1[0], v1[1]}), d = gelu_pk((f32x2){v1[2], v1[3]});
                        v0 = (f32x4){a.x, a.y, b.x, b.y}; v1 = (f32x4){c.x, c.y, d.x, d.y}; }
                    v0 = v0 * sc; v1 = v1 * sc; u32x4 w; w.x = cvt_pk_bf16(v0[0], v0[1]); w.y = cvt_pk_bf16(v0[2], v0[3]); w.z = cvt_pk_bf16(v1[0], v1[1]); w.w = cvt_pk_bf16(v1[2], v1[3]);
                    *(u32x4*)(rowp + bj * HALF) = w; } }
    }
};

struct PanelStats {
    unsigned* xbuf;
    unsigned* cnt;
    unsigned* tmo;
    int ntn; float eps;
    unsigned code;
    __device__ __forceinline__ bool run(const f32x4 (&v)[2][2][4][2], const Unit& u, int wr, int wc, int fr, int fq, PG8_LAS unsigned char* lds, int wid, int lane) const {
        typedef float f32x2v __attribute__((ext_vector_type(2)));
        PG8_LAS f32x2v* P = (PG8_LAS f32x2v*)lds;
        PG8_LAS f32x2v* S = (PG8_LAS f32x2v*)(lds + 8192);
        PG8_LAS unsigned* flag = (PG8_LAS unsigned*)(lds + 8192 + 2048);
#pragma unroll
        for (int ai = 0; ai < 2; ++ai)
#pragma unroll
            for (int m = 0; m < 4; ++m) {
                float s = 0.f;
#pragma unroll
                for (int bj = 0; bj < 2; ++bj)
#pragma unroll
                    for (int n = 0; n < 2; ++n) { const f32x4 x = v[ai][bj][m][n]; s += (x[0] + x[1]) + (x[2] + x[3]); }
                s += __shfl_xor(s, 16); s += __shfl_xor(s, 32);
                const float mw = s * (1.0f / 64.0f); float q = 0.f;
#pragma unroll
                for (int bj = 0; bj < 2; ++bj)
#pragma unroll
                    for (int n = 0; n < 2; ++n) { const f32x4 d = v[ai][bj][m][n] - mw; q += (d[0] * d[0] + d[1] * d[1]) + (d[2] * d[2] + d[3] * d[3]); }
                q += __shfl_xor(q, 16); q += __shfl_xor(q, 32);
                if (fq == 0) P[(ai * HALF + wr * 64 + m * 16 + fr) * 4 + wc] = (f32x2v){mw, q};
            }
        asm volatile("s_waitcnt lgkmcnt(0)" ::: "memory"); __builtin_amdgcn_s_barrier(); asm volatile("" ::: "memory");
#if defined(BROKEN_EXCHANGE_NO_WAIT)
#warning BROKEN CONTROL BUILD: the row-statistics exchange does not wait; results are wrong by design
        if (blockIdx.x >= 64) { const long long t0_ = clock64(); while (clock64() - t0_ < 60000) __builtin_amdgcn_s_sleep(8); }
#endif
        const int row = wid * 32 + (lane & 31);
        if (lane < 32) {
            const f32x2v a = P[row * 4 + 0], b = P[row * 4 + 1], c = P[row * 4 + 2], d = P[row * 4 + 3];
            const float mt = (a.x + b.x + c.x + d.x) * 0.25f;
            const float da = a.x - mt, db = b.x - mt, dc = c.x - mt, dd = d.x - mt;
            const float m2 = (a.y + b.y) + (c.y + d.y) + 64.0f * ((da * da + db * db) + (dc * dc + dd * dd));
            unsigned long long* slot = (unsigned long long*)xbuf + ((size_t)(u.pm * BM + row) * 4 + u.pn);
            __hip_atomic_store(slot, ((unsigned long long)__float_as_uint(m2) << 32) | __float_as_uint(mt), __ATOMIC_RELAXED, __HIP_MEMORY_SCOPE_AGENT);
        }
        asm volatile("s_waitcnt vmcnt(0)" ::: "memory");
        if (lane == 0) __hip_atomic_fetch_add(cnt + 64 * u.pm, 1u, __ATOMIC_RELAXED, __HIP_MEMORY_SCOPE_AGENT);
        if (wid == 0) {
            bool dead = false; const unsigned long long t0 = __builtin_amdgcn_s_memrealtime(); const unsigned want = 8u * (unsigned)ntn;
            for (;;) {
#if defined(BROKEN_EXCHANGE_NO_WAIT)
                break;
#endif
                if ((unsigned)__builtin_amdgcn_readfirstlane(__hip_atomic_load(cnt + 64 * u.pm, __ATOMIC_RELAXED, __HIP_MEMORY_SCOPE_AGENT)) >= want) break;
                if (__builtin_amdgcn_s_memrealtime() - t0 > 2000000ull) {
                    if (lane == 0) { unsigned expect = 0u; __hip_atomic_compare_exchange_strong(tmo + 1, &expect, code | (unsigned)(u.pm & 0xff), __ATOMIC_RELAXED, __ATOMIC_RELAXED, __HIP_MEMORY_SCOPE_AGENT);
                                     __hip_atomic_store(tmo, 1u, __ATOMIC_RELAXED, __HIP_MEMORY_SCOPE_AGENT); }
                    dead = true; break; }
                __builtin_amdgcn_s_sleep(2);
            }
            __builtin_amdgcn_fence(__ATOMIC_ACQUIRE, "agent");
            if (lane == 0) flag[0] = dead ? 1u : 0u;
        }
        asm volatile("s_waitcnt vmcnt(0) lgkmcnt(0)" ::: "memory"); __builtin_amdgcn_s_barrier(); asm volatile("" ::: "memory");
        const bool bad = flag[0] != 0u;
        if (lane < 32) {
            const unsigned long long* slot = (const unsigned long long*)xbuf + (size_t)(u.pm * BM + row) * 4; float mt[4], m2[4]; float ms = 0.f;
#pragma unroll
            for (int t = 0; t < 4; ++t) { if (t < ntn) { const unsigned long long w = __hip_atomic_load(slot + t, __ATOMIC_RELAXED, __HIP_MEMORY_SCOPE_AGENT); mt[t] = __uint_as_float((unsigned)w); m2[t] = __uint_as_float((unsigned)(w >> 32)); } else { mt[t] = 0.f; m2[t] = 0.f; } ms += mt[t]; }
            const float mean = ms / (float)ntn; float q = 0.f;
#pragma unroll
            for (int t = 0; t < 4; ++t) if (t < ntn) { const float dm = mt[t] - mean; q += m2[t] + 256.0f * dm * dm; }
            S[row] = (f32x2v){mean, 1.0f / sqrtf(q / (256.0f * (float)ntn) + eps)};
        }
        asm volatile("s_waitcnt lgkmcnt(0)" ::: "memory"); __builtin_amdgcn_s_barrier(); asm volatile("" ::: "memory");
        return bad;
    }
};
struct EpiLnRes {
    static constexpr bool PERM = false, AFTER_DRAIN = true;
    const float* base; float* out; int ldc; const float* bias; PanelStats st; unsigned poison;
    __device__ __forceinline__ void fused(f32x4 (&acc)[2][2][4][2], const Unit& u, int wr, int wc, int fr, int fq, PG8_LAS unsigned char* lds, int wid, int lane) const {
        typedef float f32x2v __attribute__((ext_vector_type(2)));
        const PG8_LAS f32x2v* S = (const PG8_LAS f32x2v*)(lds + 8192);
        const int col0 = u.pn * BM + wc * 32 + 4 * fq;
#pragma unroll
        for (int bj = 0; bj < 2; ++bj)
#pragma unroll
            for (int n = 0; n < 2; ++n) { const f32x4 bv = bias ? *(const f32x4*)(bias + col0 + bj * HALF + n * 16) : (f32x4){0.f, 0.f, 0.f, 0.f};
#pragma unroll
                for (int ai = 0; ai < 2; ++ai)
#pragma unroll
                    for (int m = 0; m < 4; ++m) acc[ai][bj][m][n] += bv; }
        f32x4 pre[4][2][2];
#pragma unroll
        for (int m = 0; m < 4; ++m) { const size_t off = (size_t)(u.pm * BM + wr * 64 + m * 16 + fr) * ldc + col0;
#pragma unroll
            for (int bj = 0; bj < 2; ++bj)
#pragma unroll
                for (int n = 0; n < 2; ++n) pre[m][bj][n] = *(const f32x4*)(base + off + bj * HALF + n * 16); }
        const bool bad = st.run(acc, u, wr, wc, fr, fq, lds, wid, lane) || poison != 0u;
        const float qnan = __builtin_nanf("");
#pragma unroll
        for (int ai = 0; ai < 2; ++ai)
#pragma unroll
            for (int m = 0; m < 4; ++m) { const int r = ai * HALF + wr * 64 + m * 16 + fr; const f32x2v sr = S[r]; const size_t off = (size_t)(u.pm * BM + r) * ldc + col0;
#pragma unroll
                for (int bj = 0; bj < 2; ++bj)
#pragma unroll
                    for (int n = 0; n < 2; ++n) { const f32x4 bs = ai == 0 ? pre[m][bj][n] : *(const f32x4*)(base + off + bj * HALF + n * 16); f32x4 o = bs + (acc[ai][bj][m][n] - sr.x) * sr.y;
                        if (bad) o = (f32x4){qnan, qnan, qnan, qnan}; *(f32x4*)(out + off + bj * HALF + n * 16) = o; }
                if (m & 1) asm volatile("" ::: "memory"); }
    }
};
struct EpiLnResLn {
    static constexpr bool PERM = false, AFTER_DRAIN = true;
    const float* base; float* out; bf16_t* xn; int ldc; const float* bias; PanelStats st1, st2; unsigned poison;
    __device__ __forceinline__ void fused(f32x4 (&acc)[2][2][4][2], const Unit& u, int wr, int wc, int fr, int fq, PG8_LAS unsigned char* lds, int wid, int lane) const {
        typedef float f32x2v __attribute__((ext_vector_type(2))); typedef unsigned u32x2v __attribute__((ext_vector_type(2)));
        const PG8_LAS f32x2v* S = (const PG8_LAS f32x2v*)(lds + 8192);
        const int col0 = u.pn * BM + wc * 32 + 4 * fq;
#pragma unroll
        for (int bj = 0; bj < 2; ++bj)
#pragma unroll
            for (int n = 0; n < 2; ++n) { const f32x4 bv = bias ? *(const f32x4*)(bias + col0 + bj * HALF + n * 16) : (f32x4){0.f, 0.f, 0.f, 0.f};
#pragma unroll
                for (int ai = 0; ai < 2; ++ai)
#pragma unroll
                    for (int m = 0; m < 4; ++m) acc[ai][bj][m][n] += bv; }
        bool bad = st1.run(acc, u, wr, wc, fr, fq, lds, wid, lane) || poison != 0u;
        const float qnan = __builtin_nanf("");
#pragma unroll
        for (int ai = 0; ai < 2; ++ai)
#pragma unroll
            for (int m = 0; m < 4; ++m) { const int r = ai * HALF + wr * 64 + m * 16 + fr; const f32x2v sr = S[r]; const size_t off = (size_t)(u.pm * BM + r) * ldc + col0;
#pragma unroll
                for (int bj = 0; bj < 2; ++bj)
#pragma unroll
                    for (int n = 0; n < 2; ++n) { const f32x4 bs = *(const f32x4*)(base + off + bj * HALF + n * 16); acc[ai][bj][m][n] = bs + (acc[ai][bj][m][n] - sr.x) * sr.y; }
                asm volatile("" : "+v"(acc[ai][0][m][0]), "+v"(acc[ai][0][m][1]), "+v"(acc[ai][1][m][0]), "+v"(acc[ai][1][m][1]));
                if (m & 1) asm volatile("" ::: "memory"); }
        const bool bad1 = bad;
        bad = st2.run(acc, u, wr, wc, fr, fq, lds, wid, lane) || bad;
#pragma unroll
        for (int ai = 0; ai < 2; ++ai)
#pragma unroll
            for (int m = 0; m < 4; ++m) { const int r = ai * HALF + wr * 64 + m * 16 + fr; const f32x2v sr = S[r]; const size_t off = (size_t)(u.pm * BM + r) * ldc + col0;
#pragma unroll
                for (int bj = 0; bj < 2; ++bj)
#pragma unroll
                    for (int n = 0; n < 2; ++n) { const f32x4 x1 = acc[ai][bj][m][n]; *(f32x4*)(out + off + bj * HALF + n * 16) = bad1 ? (f32x4){qnan, qnan, qnan, qnan} : x1;
                        const f32x4 o = (x1 - sr.x) * sr.y; u32x2v w; w.x = cvt_pk_bf16(o[0], o[1]); w.y = cvt_pk_bf16(o[2], o[3]);
                        if (bad) { w.x = 0x7fc07fc0u; w.y = 0x7fc07fc0u; } *(u32x2v*)(xn + off + bj * HALF + n * 16) = w; }
                asm volatile("" ::: "memory"); }
    }
};

template <class Epi, class Sched, bool ALIGN_EPI = false, bool SP2 = false>
__device__ __forceinline__ void gemm_phase(PG8_LAS unsigned char* lds, const Gemm g, const Sched& S, const Epi& E) {
    const int tid = threadIdx.x, wid = __builtin_amdgcn_readfirstlane(tid >> 6), lane = tid & 63, wr = wid >> 2, wc = wid & 3, fr = lane & 15, fq = lane >> 4;
    const int K = g.K, nt = K / BK;
    unsigned voffA[2], voffB[2];
#pragma unroll
    for (int i = 0; i < 2; ++i) { int R, C; stage_rc(tid * 16 + i * 8192, R, C); const int Rb = Epi::PERM ? ((R & ~31) + perm32(R & 31)) : R;
        voffA[i] = (unsigned)(R * K + C) * 2u; voffB[i] = (unsigned)(Rb * K + C) * 2u; }
    const size_t kstep = (size_t)(BK * 2);
    const size_t hstep = (size_t)HALF * K * 2;
    const size_t tstep = 2 * hstep;
    const unsigned ldsw = (unsigned)wid * 1024u;
    const int aoff = lds_byte(wr * 64 + fr, fq * 8), boff = lds_byte(wc * 32 + fr, fq * 8);
#define PG8_SA(b, h) (((b) * 2 + (h)) * HTB)
#define PG8_SB(b, h) ((4 + (b) * 2 + (h)) * HTB)
#define PG8_STAGE(bufoff, gbase, voff) do { _Pragma("unroll") for (int _i = 0; _i < 2; ++_i) \
        __builtin_amdgcn_global_load_lds((const unsigned*)((const char*)(gbase) + (voff)[_i]), (PG8_LAS unsigned*)(lds + (bufoff) + ldsw + _i * 8192), 16, 0, 0); } while (0)
#define PG8_LDA(dst, b, h) do { _Pragma("unroll") for (int m = 0; m < 4; ++m) _Pragma("unroll") for (int k = 0; k < 2; ++k) dst[m][k] = *(const PG8_LAS bf16x8*)(lds + PG8_SA(b, h) + aoff + m * 2048 + k * 1024); } while (0)
#define PG8_LDB(dst, b, h) do { _Pragma("unroll") for (int n = 0; n < 2; ++n) _Pragma("unroll") for (int k = 0; k < 2; ++k) dst[n][k] = *(const PG8_LAS bf16x8*)(lds + PG8_SB(b, h) + boff + n * 2048 + k * 1024); } while (0)
#define PG8_MMA(ai, bj, At, Bt) do { __builtin_amdgcn_s_setprio(1); _Pragma("unroll") for (int m = 0; m < 4; ++m) _Pragma("unroll") for (int n = 0; n < 2; ++n) _Pragma("unroll") for (int k = 0; k < 2; ++k) \
        acc[ai][bj][m][n] = __builtin_amdgcn_mfma_f32_16x16x32_bf16(Bt[n][k], At[m][k], acc[ai][bj][m][n], 0, 0, 0); __builtin_amdgcn_s_setprio(0); } while (0)
#define PG8_WAIT_V(n) asm volatile("s_waitcnt vmcnt(" #n ")" ::: "memory")
#define PG8_WAIT_L(n) asm volatile("s_waitcnt lgkmcnt(" #n ")" ::: "memory")
#define PG8_BAR __builtin_amdgcn_s_barrier()
#define PG8_SCHED __builtin_amdgcn_sched_barrier(0)
    Unit cur, nxt; int ui = 0;
    if (!S.next(0, cur)) return;
    f32x4 acc[2][2][4][2];
#pragma unroll
    for (int a = 0; a < 2; ++a)
#pragma unroll
        for (int b = 0; b < 2; ++b)
#pragma unroll
            for (int m = 0; m < 4; ++m)
#pragma unroll
                for (int n = 0; n < 2; ++n) acc[a][b][m][n] = (f32x4){0.f, 0.f, 0.f, 0.f};
    bf16x8 At[4][2], B0[2][2], B1[2][2];
    const char* cA = (const char*)(cur.seg ? g.A1 : g.A0) + (size_t)cur.pm * tstep; const char* cB = (const char*)(cur.seg ? g.B1 : g.B0) + (size_t)cur.pn * tstep;
    S.a_ready(cur);
    if constexpr (SP2) {
        PG8_STAGE(PG8_SB(0, 0), cB, voffB); PG8_STAGE(PG8_SB(0, 1), cB + hstep, voffB); PG8_STAGE(PG8_SA(0, 0), cA, voffA); PG8_STAGE(PG8_SA(0, 1), cA + hstep, voffA);
        if (wr == 1) PG8_BAR;
        PG8_WAIT_V(2); PG8_BAR;
        PG8_STAGE(PG8_SB(1, 0), cB + kstep, voffB); PG8_STAGE(PG8_SA(1, 0), cA + kstep, voffA); PG8_STAGE(PG8_SB(1, 1), cB + hstep + kstep, voffB);
        PG8_WAIT_V(6); PG8_BAR;
    } else {
        PG8_STAGE(PG8_SB(0, 0), cB, voffB); PG8_STAGE(PG8_SA(0, 0), cA, voffA); PG8_STAGE(PG8_SB(0, 1), cB + hstep, voffB); PG8_STAGE(PG8_SA(0, 1), cA + hstep, voffA);
        if (wr == 1) PG8_BAR;
        PG8_WAIT_V(4); PG8_BAR;
        PG8_STAGE(PG8_SB(1, 0), cB + kstep, voffB); PG8_STAGE(PG8_SA(1, 0), cA + kstep, voffA); PG8_STAGE(PG8_SB(1, 1), cB + hstep + kstep, voffB);
        PG8_WAIT_V(6); PG8_BAR;
    }
    for (;;) {
        const bool has_next = S.next(ui + 1, nxt);
        const char* nA = has_next ? (const char*)(nxt.seg ? g.A1 : g.A0) + (size_t)nxt.pm * tstep : cA; const char* nB = has_next ? (const char*)(nxt.seg ? g.B1 : g.B0) + (size_t)nxt.pn * tstep : cB;
        for (int t = 0; t < nt; t += 2) {
            const bool last = (t == nt - 2);
            const char* a1 = cA + (size_t)(t + 1) * kstep;
            const char* a2 = last ? nA : cA + (size_t)(t + 2) * kstep; const char* b2 = last ? nB : cB + (size_t)(t + 2) * kstep;
            const char* a3 = a2 + kstep; const char* b3 = b2 + kstep;
            if (last && has_next) S.a_ready(nxt);
            if constexpr (SP2) {
            PG8_LDB(B0, 0, 0); PG8_LDB(B1, 0, 1); PG8_SCHED; PG8_LDA(At, 0, 0); PG8_STAGE(PG8_SA(1, 1), a1 + hstep, voffA);
            PG8_WAIT_V(8); PG8_WAIT_L(0); PG8_BAR; PG8_MMA(0, 0, At, B0); PG8_MMA(0, 1, At, B1); PG8_BAR; PG8_SCHED;
            PG8_LDA(At, 0, 1); PG8_STAGE(PG8_SB(0, 0), b2, voffB); PG8_STAGE(PG8_SB(0, 1), b2 + hstep, voffB); PG8_STAGE(PG8_SA(0, 0), a2, voffA);
            PG8_WAIT_V(8); PG8_WAIT_L(0); PG8_BAR; PG8_MMA(1, 0, At, B0); PG8_MMA(1, 1, At, B1); PG8_BAR; PG8_SCHED;
            PG8_LDB(B0, 1, 0); PG8_LDB(B1, 1, 1); PG8_SCHED; PG8_LDA(At, 1, 0); PG8_STAGE(PG8_SA(0, 1), a2 + hstep, voffA);
            PG8_WAIT_V(8); PG8_WAIT_L(0); PG8_BAR; PG8_MMA(0, 0, At, B0); PG8_MMA(0, 1, At, B1); PG8_BAR; PG8_SCHED;
            PG8_LDA(At, 1, 1); PG8_STAGE(PG8_SB(1, 0), b3, voffB); PG8_STAGE(PG8_SB(1, 1), b3 + hstep, voffB); PG8_STAGE(PG8_SA(1, 0), a3, voffA);
            PG8_WAIT_V(8); PG8_WAIT_L(0); PG8_BAR; PG8_MMA(1, 0, At, B0); PG8_MMA(1, 1, At, B1); PG8_BAR; PG8_SCHED;
            } else {
            PG8_LDB(B0, 0, 0); PG8_SCHED; PG8_LDA(At, 0, 0); PG8_STAGE(PG8_SA(1, 1), a1 + hstep, voffA);
            PG8_WAIT_L(8); PG8_BAR; PG8_WAIT_L(0); PG8_MMA(0, 0, At, B0); PG8_BAR; PG8_SCHED;
            PG8_LDB(B1, 0, 1); PG8_STAGE(PG8_SB(0, 0), b2, voffB);
            PG8_BAR; PG8_WAIT_L(0); PG8_MMA(0, 1, At, B1); PG8_BAR;
            PG8_LDA(At, 0, 1); PG8_STAGE(PG8_SA(0, 0), a2, voffA);
            PG8_BAR; PG8_WAIT_L(0); PG8_MMA(1, 0, At, B0); PG8_BAR; PG8_SCHED;
            PG8_STAGE(PG8_SB(0, 1), b2 + hstep, voffB);
            PG8_WAIT_V(6); PG8_BAR; PG8_MMA(1, 1, At, B1); PG8_BAR;
            PG8_LDB(B0, 1, 0); PG8_SCHED; PG8_LDA(At, 1, 0); PG8_STAGE(PG8_SA(0, 1), a2 + hstep, voffA);
            PG8_WAIT_L(8); PG8_BAR; PG8_WAIT_L(0); PG8_MMA(0, 0, At, B0); PG8_BAR; PG8_SCHED;
            PG8_LDB(B1, 1, 1); PG8_STAGE(PG8_SB(1, 0), b3, voffB);
            PG8_BAR; PG8_WAIT_L(0); PG8_MMA(0, 1, At, B1); PG8_BAR;
            PG8_LDA(At, 1, 1); PG8_STAGE(PG8_SA(1, 0), a3, voffA);
            PG8_BAR; PG8_WAIT_L(0); PG8_MMA(1, 0, At, B0); PG8_BAR; PG8_SCHED;
            PG8_STAGE(PG8_SB(1, 1), b3 + hstep, voffB);
            PG8_WAIT_V(6); PG8_BAR; PG8_MMA(1, 1, At, B1); PG8_BAR;
            }
        }
        if constexpr (ALIGN_EPI) { if (wr == 0) PG8_BAR; }
        if constexpr (!Epi::AFTER_DRAIN) { E(acc, cur, wr, wc, fr, fq); S.done(cur); }
        if (!has_next) break;
        if (nxt.seg == 0) {
#pragma unroll
        for (int a = 0; a < 2; ++a)
#pragma unroll
            for (int b = 0; b < 2; ++b)
#pragma unroll
                for (int m = 0; m < 4; ++m)
#pragma unroll
                    for (int n = 0; n < 2; ++n) acc[a][b][m][n] = (f32x4){0.f, 0.f, 0.f, 0.f};
        }
        cur = nxt; cA = nA; cB = nB; ++ui;
        if constexpr (ALIGN_EPI) { if (wr == 1) PG8_BAR; }
    }
    PG8_WAIT_V(0);
    if constexpr (!ALIGN_EPI) { if (wr == 0) PG8_BAR; }
    PG8_BAR;
    if constexpr (Epi::AFTER_DRAIN) { E.fused(acc, cur, wr, wc, fr, fq, lds, wid, lane); S.done(cur); }
#undef PG8_SA
#undef PG8_SB
#undef PG8_STAGE
#undef PG8_LDA
#undef PG8_LDB
#undef PG8_MMA
#undef PG8_WAIT_V
#undef PG8_WAIT_L
#undef PG8_BAR
#undef PG8_SCHED
}
}
namespace attn_body {
using bf16=__hip_bfloat16;
using bf16x8=__attribute__((ext_vector_type(8)))short;
using s16x4=__attribute__((ext_vector_type(4)))short;
using f32x16=__attribute__((ext_vector_type(16)))float;
using u32x4=__attribute__((ext_vector_type(4)))unsigned;
constexpr int BATCH=8,NHEAD=16,SEQ=4096,D=64,DM=NHEAD*D;
constexpr int NW=8,QBLK=32,QB=QBLK*NW,KVBLK=64,NQB=SEQ/QB;
constexpr int ATTN_PITCH=DM, ATTN_UNIT_ROWS=QB;
__device__ __forceinline__ int crow(int r,int hi){return (r&3)+8*(r>>2)+4*hi;}
#define SBAR() __builtin_amdgcn_sched_barrier(0)
__device__ __forceinline__ void cmask(f32x16&p0,f32x16&p1,int jb,int qrel,int hi){
  const float NEG=-INFINITY; int kb=64*jb+4*hi;
  #pragma unroll
  for(int r=0;r<16;++r){int kv=kb+(r&3)+8*(r>>2); if(kv>qrel)p0[r]=NEG; if(kv+32>qrel)p1[r]=NEG;}
}

constexpr int NSLOT=3, SLOTB=8192;
constexpr int LDS_K=0, LDS_V=NSLOT*SLOTB, LDS_WS=2*NSLOT*SLOTB, LDS_OST=LDS_WS+NW*64*4, LDS_CL=LDS_OST+NW*4096, LDS_BYTES=LDS_CL+SEQ*4;
constexpr float C2=0.125f*1.4426950408889634f;
__device__ __forceinline__ void glds16(const void*gsrc,unsigned lds_dst){unsigned keep;
  asm volatile("s_mov_b32 %0, m0\n\ts_mov_b32 m0, %2\n\ts_nop 0\n\tglobal_load_lds_dwordx4 %1, off\n\ts_mov_b32 m0, %0":"=&s"(keep):"v"(gsrc),"s"(lds_dst):"memory");}
__device__ __forceinline__ float max3f(float a,float b,float c){float r;asm("v_max3_f32 %0, %1, %2, %3":"=v"(r):"v"(a),"v"(b),"v"(c));return r;}
__device__ __forceinline__ float max2f(float a,float b){float r;asm("v_max_f32_e32 %0, %1, %2":"=v"(r):"v"(a),"v"(b));return r;}
__device__ __forceinline__ float fadd_s(float a,float b){float r;asm("v_add_f32_e32 %0, %1, %2":"=v"(r):"v"(a),"v"(b));return r;}
__device__ __forceinline__ float fsub_s(float a,float b){float r;asm("v_sub_f32_e32 %0, %1, %2":"=v"(r):"v"(a),"v"(b));return r;}
typedef float f32x2_t __attribute__((ext_vector_type(2))); typedef __bf16 bf16x2_t __attribute__((ext_vector_type(2)));
__device__ __forceinline__ unsigned cvtpk_s(float lo,float hi){f32x2_t v={lo,hi};bf16x2_t b=__builtin_convertvector(v,bf16x2_t);return __builtin_bit_cast(unsigned,b);}
#define WAIT_BAR(N) asm volatile("s_waitcnt vmcnt(" #N ") lgkmcnt(0)\n\ts_barrier":::"memory")

__device__ __forceinline__ void qkt(f32x16&p0,f32x16&p1,const char*Kslot,const bf16x8*qr,int r32,int hi){
  const char*kb=Kslot+hi*1024+r32*16;
  #pragma unroll
  for(int d0=0;d0<4;++d0){
    const bf16x8 b0=*reinterpret_cast<const bf16x8*>(kb+d0*2048);
    const bf16x8 b1=*reinterpret_cast<const bf16x8*>(kb+d0*2048+512);
    {p0=__builtin_amdgcn_mfma_f32_32x32x16_bf16(b0,qr[d0],p0,0,0,0);p1=__builtin_amdgcn_mfma_f32_32x32x16_bf16(b1,qr[d0],p1,0,0,0);}}
}
typedef __attribute__((address_space(3))) const char* lds_cptr;
typedef short v4i16_t __attribute__((ext_vector_type(4)));
__device__ __forceinline__ void kload8(bf16x8*kf,lds_cptr kp){
  kf[0]=*(const __attribute__((address_space(3))) bf16x8*)(kp);      kf[1]=*(const __attribute__((address_space(3))) bf16x8*)(kp+512);
  kf[2]=*(const __attribute__((address_space(3))) bf16x8*)(kp+2048); kf[3]=*(const __attribute__((address_space(3))) bf16x8*)(kp+2560);
  kf[4]=*(const __attribute__((address_space(3))) bf16x8*)(kp+4096); kf[5]=*(const __attribute__((address_space(3))) bf16x8*)(kp+4608);
  kf[6]=*(const __attribute__((address_space(3))) bf16x8*)(kp+6144); kf[7]=*(const __attribute__((address_space(3))) bf16x8*)(kp+6656);
}
__device__ __forceinline__ void kload2(bf16x8*kf,lds_cptr kp,int j){ kf[2*j]=*(const __attribute__((address_space(3))) bf16x8*)(kp+j*2048); kf[2*j+1]=*(const __attribute__((address_space(3))) bf16x8*)(kp+j*2048+512); }
__device__ __forceinline__ s16x4 vtr(lds_cptr p){ return __builtin_bit_cast(s16x4,__builtin_amdgcn_ds_read_tr16_b64_v4i16((__attribute__((address_space(3))) v4i16_t*)p)); }
__device__ __forceinline__ float rowmax(const f32x16&p0,const f32x16&p1){
  float a=max3f(p0[0],p0[1],p1[0]),b=max3f(p0[2],p0[3],p1[1]);a=max3f(a,p1[2],p1[3]);
  #pragma unroll
  for(int r=4;r<16;r+=4){a=max3f(a,p0[r],p0[r+1]);b=max3f(b,p0[r+2],p0[r+3]);a=max3f(a,p1[r],p1[r+1]);b=max3f(b,p1[r+2],p1[r+3]);}
  const float m=max2f(a,b);
  auto rr=__builtin_amdgcn_permlane32_swap(__float_as_uint(m),__float_as_uint(m),false,false);
  return max2f(__uint_as_float(rr[0]),__uint_as_float(rr[1]));
}
__device__ __forceinline__ void pv(f32x16*o,int vb,bf16x8 pa0,bf16x8 pa1,bf16x8 pa2,bf16x8 pa3){
  #pragma unroll
  for(int d0=0;d0<2;++d0){s16x4 lo[4],hi[4];
    #pragma unroll
    for(int ks=0;ks<4;++ks){
      asm volatile("ds_read_b64_tr_b16 %0,%1 offset:%c2":"=&v"(lo[ks]):"v"(vb),"i"(d0*4096+ks*1024):"memory");
      asm volatile("ds_read_b64_tr_b16 %0,%1 offset:%c2":"=&v"(hi[ks]):"v"(vb),"i"(d0*4096+ks*1024+512):"memory");}
    asm volatile("s_waitcnt lgkmcnt(0)":::"memory");SBAR();
    #define PK(k) (bf16x8){lo[k][0],lo[k][1],lo[k][2],lo[k][3],hi[k][0],hi[k][1],hi[k][2],hi[k][3]}
    o[d0]=__builtin_amdgcn_mfma_f32_32x32x16_bf16(pa0,PK(0),o[d0],0,0,0);
    o[d0]=__builtin_amdgcn_mfma_f32_32x32x16_bf16(pa1,PK(1),o[d0],0,0,0);
    o[d0]=__builtin_amdgcn_mfma_f32_32x32x16_bf16(pa2,PK(2),o[d0],0,0,0);
    o[d0]=__builtin_amdgcn_mfma_f32_32x32x16_bf16(pa3,PK(3),o[d0],0,0,0);
    #undef PK
  }
}

#ifndef ATTN_STORE16
#define ATTN_STORE16(p,v) (*(u32x4*)(p)=(v))
#endif
template<int THRL> __device__ __forceinline__ void attn_unit(int b,int h,int qb,int T0,const bf16*Q,const bf16*__restrict__ K,const bf16*__restrict__ V,bf16*O,const float*__restrict__ c2g,char*shm){
  const int tid=threadIdx.x,lane=tid&63,r32=lane&31,hi=lane>>5; const int wid=__builtin_amdgcn_readfirstlane(tid>>6);
  const long rowbase=(long)b*SEQ; const int q0=qb*QB;
  const bf16*Qw=Q+(rowbase+q0+wid*QBLK)*DM+h*D;
  const bf16*Kh=K+(rowbase+(long)T0*KVBLK)*DM+h*D,*Vh=V+(rowbase+(long)T0*KVBLK)*DM+h*D;
  const unsigned lds0=(unsigned)(uintptr_t)shm; const lds_cptr shm3=(lds_cptr)shm;
  float*wsf=(float*)(shm+LDS_WS)+wid*64;
  const bf16*ksrc=Kh+(long)lane*DM+wid*8;
  const bf16*vsrc=Vh+(long)(16*(wid&3)+(lane>>2))*DM+(wid>>2)*32+(lane&3)*8;
  const unsigned kdst=lds0+LDS_K+wid*1024, vdst=lds0+LDS_V+wid*1024;
  #define DMA_K(t,slot) glds16(ksrc+(long)(t)*KVBLK*DM,(unsigned)__builtin_amdgcn_readfirstlane(kdst+(slot)))
  #define DMA_V(t,slot) glds16(vsrc+(long)(t)*KVBLK*DM,(unsigned)__builtin_amdgcn_readfirstlane(vdst+(slot)))
  const int vb0=(int)(lds0+LDS_V)+((lane>>4)&1)*32+(lane&3)*8+(4*hi+((lane&15)>>2))*64;
  const char*Kbase=shm+LDS_K; bf16x8 kf[8];
  const lds_cptr kp0=shm3+LDS_K+hi*1024+r32*16; const lds_cptr vp0=shm3+LDS_V+((lane>>4)&1)*32+(lane&3)*8+(4*hi+((lane&15)>>2))*64;
  const int NT=(q0+QB)/KVBLK-T0;
  { typedef float f32x4g __attribute__((ext_vector_type(4))); __attribute__((address_space(3))) f32x4g* cl4=(__attribute__((address_space(3))) f32x4g*)(shm3+LDS_CL);
    for(int s4=16*T0+tid; s4<(q0+QB)/4; s4+=NW*64) cl4[s4]=*reinterpret_cast<const f32x4g*>(c2g+4*s4); }
  float nm=c2g[q0+wid*QBLK+r32];
  DMA_K(0,0);DMA_V(0,0);DMA_K(1,SLOTB);
  bf16x8 qr[4];
  #pragma unroll
  for(int d0=0;d0<4;++d0)qr[d0]=*reinterpret_cast<const bf16x8*>(&Qw[(long)r32*DM+d0*16+hi*8]);
  float l_reg=0.f;f32x16 o[2];o[0]=f32x16{};o[1]=f32x16{};
  typedef float f32x4l __attribute__((ext_vector_type(4)));
  #define CINIT(C0,C1,t) do{ const __attribute__((address_space(3))) f32x4l* cp_=(const __attribute__((address_space(3))) f32x4l*)(shm3+LDS_CL+(((t)+T0)*64+4*hi)*4); \
    _Pragma("unroll") for(int g_=0;g_<4;++g_){ const f32x4l a_=cp_[2*g_], b_=cp_[8+2*g_]; \
      C0[4*g_]=nm-a_[0];C0[4*g_+1]=nm-a_[1];C0[4*g_+2]=nm-a_[2];C0[4*g_+3]=nm-a_[3]; \
      C1[4*g_]=nm-b_[0];C1[4*g_+1]=nm-b_[1];C1[4*g_+2]=nm-b_[2];C1[4*g_+3]=nm-b_[3]; } }while(0)
  const int qrel=wid*QBLK+r32;
  #define CMASK(P0,P1,t) do{int jb_=(t)-(NT-4); if(jb_>=0)cmask(P0,P1,jb_,qrel,hi);}while(0)
  bool resc=false;
  #define START(P0,P1) do{ const float rm=rowmax(P0,P1); resc=false; \
    { const float dl=rm; nm=fsub_s(nm,dl); \
      _Pragma("unroll") for(int r=0;r<16;++r){P0[r]=fsub_s(P0[r],dl);P1[r]=fsub_s(P1[r],dl);} } \
    _Pragma("unroll") for(int r=0;r<16;++r)P0[r]=__builtin_amdgcn_exp2f(P0[r]); }while(0)
  #define RESC() do{ if(resc){ asm volatile("s_waitcnt lgkmcnt(0)":::"memory"); \
      _Pragma("unroll") for(int d_=0;d_<2;++d_) _Pragma("unroll") for(int r=0;r<16;++r)o[d_][r]*=wsf[crow(r,hi)]; } }while(0)
  f32x16 pA0,pA1,pB0,pB1;
  int sl_prev=0,sl_cur=0,sl_next=SLOTB;
  #define ROT() do{sl_prev=sl_cur;sl_cur=sl_next;sl_next=(sl_next==(NSLOT-1)*SLOTB)?0:sl_next+SLOTB;}while(0)
  DMA_K(2,2*SLOTB);
  WAIT_BAR(3);
  CINIT(pA0,pA1,0); qkt(pA0,pA1,Kbase,qr,r32,hi);asm volatile("s_nop 15\n\ts_nop 7":"+v"(pA0),"+v"(pA1));CMASK(pA0,pA1,0);
  START(pA0,pA1);
  _Pragma("unroll") for(int r=0;r<16;++r)pA1[r]=__builtin_amdgcn_exp2f(pA1[r]);
  WAIT_BAR(0);
  DMA_K(3,0);DMA_V(1,SLOTB);
  ROT();
  kload8(kf,kp0+sl_cur);
  WAIT_BAR(2);
  s16x4 vlo[8],vhi[8]; u32x4 pw0,pw1,pw2,pw3;
  #define PKW(P,B) cvtpk_s(P[B],P[B+1])
  #define PAF(k) __builtin_bit_cast(bf16x8,pw##k)
  #define VFR(i) (bf16x8){vlo[i][0],vlo[i][1],vlo[i][2],vlo[i][3],vhi[i][0],vhi[i][1],vhi[i][2],vhi[i][3]}
  #define PIN(x) asm volatile("":"+v"(x))
  #define MX3(a,b,c) __builtin_fmaxf(__builtin_fmaxf((a),(b)),(c))
  #define GAPA(MF,A0,A1,A2,A3,W0,W1,PW) do{ MF; sacc+=A0; sacc+=A1; sacc+=A2; sacc+=A3; PIN(sacc); W0; W1; PIN(PW); SBAR(); }while(0)
  #define EX(v) __builtin_amdgcn_exp2f(v)
  #define GAPB(MF,X,B) do{ MF; X[B]=EX(X[B]); X[B+1]=EX(X[B+1]); X[B+2]=EX(X[B+2]); X[B+3]=EX(X[B+3]); PIN(X); SBAR(); }while(0)
  #define VRD(i) do{ vlo[i]=vtr(vp_+(((i)>>2)*4096+((i)&3)*1024)); vhi[i]=vtr(vp_+(((i)>>2)*4096+((i)&3)*1024+512)); }while(0)
  #define KRD(G,j) do{ if(G){ kload2(kf,kp0+sl_next,j); SBAR(); } }while(0)
  #define STEP(C0,C1,P0,P1,t,GK,GV,GL) do{ SBAR(); CINIT(C0,C1,t); SBAR(); \
    const lds_cptr vp_=vp0+sl_prev; \
    VRD(0); SBAR(); float sacc=(P0[0]+P0[1]); \
    GAPA(C0=__builtin_amdgcn_mfma_f32_32x32x16_bf16(kf[0],qr[0],C0,0,0,0), P0[2],P0[3],P0[4],P0[5],     pw0[0]=PKW(P0,0), pw0[1]=PKW(P0,2), pw0); \
    VRD(4); SBAR(); GAPA(C1=__builtin_amdgcn_mfma_f32_32x32x16_bf16(kf[1],qr[0],C1,0,0,0), P0[6],P0[7],P0[8],P0[9],     pw0[2]=PKW(P0,4), pw0[3]=PKW(P0,6), pw0); \
    VRD(1); SBAR(); GAPA(C0=__builtin_amdgcn_mfma_f32_32x32x16_bf16(kf[2],qr[1],C0,0,0,0),   P0[10],P0[11],P0[12],P0[13], pw1[0]=PKW(P0,8), pw1[1]=PKW(P0,10), pw1); \
    VRD(5); SBAR(); GAPA(C1=__builtin_amdgcn_mfma_f32_32x32x16_bf16(kf[3],qr[1],C1,0,0,0),   P0[14],P0[15],P1[0],P1[1],   pw1[2]=PKW(P0,12),pw1[3]=PKW(P0,14), pw1); \
    VRD(2); SBAR(); GAPA(C0=__builtin_amdgcn_mfma_f32_32x32x16_bf16(kf[4],qr[2],C0,0,0,0),   P1[2],P1[3],P1[4],P1[5],     pw2[0]=PKW(P1,0), pw2[1]=PKW(P1,2), pw2); \
    VRD(6); SBAR(); GAPA(C1=__builtin_amdgcn_mfma_f32_32x32x16_bf16(kf[5],qr[2],C1,0,0,0),   P1[6],P1[7],P1[8],P1[9],     pw2[2]=PKW(P1,4), pw2[3]=PKW(P1,6), pw2); \
    VRD(3); SBAR(); GAPA(C0=__builtin_amdgcn_mfma_f32_32x32x16_bf16(kf[6],qr[3],C0,0,0,0),   P1[10],P1[11],P1[12],P1[13], pw3[0]=PKW(P1,8), pw3[1]=PKW(P1,10), pw3); \
    VRD(7); SBAR(); GAPA(C1=__builtin_amdgcn_mfma_f32_32x32x16_bf16(kf[7],qr[3],C1,0,0,0),   P1[14],P1[15],0.f,0.f,       pw3[2]=PKW(P1,12),pw3[3]=PKW(P1,14), pw3); \
    l_reg+=sacc; \
    if(GK){DMA_K((t)+3,sl_cur);} if(GV){DMA_V((t)+1,sl_next);} \
    CMASK(C0,C1,t); \
    { float a=MX3(C0[0],C0[1],C1[0]),b=MX3(C0[2],C0[3],C1[1]); a=MX3(a,C1[2],C1[3]); \
      _Pragma("unroll") for(int r=4;r<16;r+=4){a=MX3(a,C0[r],C0[r+1]);b=MX3(b,C0[r+2],C0[r+3]);a=MX3(a,C1[r],C1[r+1]);b=MX3(b,C1[r+2],C1[r+3]);} \
      float rm=__builtin_fmaxf(a,b); { auto rr=__builtin_amdgcn_permlane32_swap(__float_as_uint(rm),__float_as_uint(rm),false,false); rm=__builtin_fmaxf(__uint_as_float(rr[0]),__uint_as_float(rr[1])); } \
      resc=false; \
      if(__builtin_expect(__any(rm>(float)THRL),0)){ const float dl=__builtin_fmaxf(rm,0.f); nm-=dl; \
        _Pragma("unroll") for(int r=0;r<16;++r){C0[r]-=dl;C1[r]-=dl;} \
        const float f=__builtin_amdgcn_exp2f(-dl); l_reg*=f; if(hi==0)wsf[r32]=f; resc=true; } } \
    SBAR(); \
    GAPB(o[0]=__builtin_amdgcn_mfma_f32_32x32x16_bf16(PAF(0),VFR(0),o[0],0,0,0), C0,0); \
    GAPB(o[1]=__builtin_amdgcn_mfma_f32_32x32x16_bf16(PAF(0),VFR(4),o[1],0,0,0), C0,4); \
    KRD(GL,0); GAPB(o[0]=__builtin_amdgcn_mfma_f32_32x32x16_bf16(PAF(1),VFR(1),o[0],0,0,0), C0,8); \
    KRD(GL,1); GAPB(o[1]=__builtin_amdgcn_mfma_f32_32x32x16_bf16(PAF(1),VFR(5),o[1],0,0,0), C0,12); \
    KRD(GL,2); GAPB(o[0]=__builtin_amdgcn_mfma_f32_32x32x16_bf16(PAF(2),VFR(2),o[0],0,0,0), C1,0); \
    KRD(GL,3); GAPB(o[1]=__builtin_amdgcn_mfma_f32_32x32x16_bf16(PAF(2),VFR(6),o[1],0,0,0), C1,4); \
    GAPB(o[0]=__builtin_amdgcn_mfma_f32_32x32x16_bf16(PAF(3),VFR(3),o[0],0,0,0), C1,8); \
    GAPB(o[1]=__builtin_amdgcn_mfma_f32_32x32x16_bf16(PAF(3),VFR(7),o[1],0,0,0), C1,12); \
    }while(0)
  int t=1;
  #undef CMASK
  #define CMASK(P0,P1,t) do{}while(0)
  for(;t+5<NT;t+=2){
    STEP(pB0,pB1,pA0,pA1,t,true,true,true);     WAIT_BAR(2); RESC(); ROT();
    STEP(pA0,pA1,pB0,pB1,t+1,true,true,true);   WAIT_BAR(2); RESC(); ROT();
  }
  #undef CMASK
  #define CMASK(P0,P1,t) do{int jb_=(t)-(NT-4); if(jb_>=0)cmask(P0,P1,jb_,qrel,hi);}while(0)
  #define ENDW(tt) do{ if((tt)+3<NT){WAIT_BAR(2);} else if((tt)+2<NT){WAIT_BAR(1);} else {WAIT_BAR(0);} }while(0)
  for(;t+1<NT;t+=2){
    STEP(pB0,pB1,pA0,pA1,t,(t+3<NT),(t+1<NT),(t+1<NT));       ENDW(t);   RESC(); ROT();
    STEP(pA0,pA1,pB0,pB1,t+1,(t+4<NT),(t+2<NT),(t+2<NT));     ENDW(t+1); RESC(); ROT();
  }
  STEP(pB0,pB1,pA0,pA1,NT-1,false,false,false); RESC();
  { float sacc=pB0[0]+pB0[1]; _Pragma("unroll") for(int r=2;r<16;++r)sacc+=pB0[r]; _Pragma("unroll") for(int r=0;r<16;++r)sacc+=pB1[r]; l_reg+=sacc;
    pw0=(u32x4){PKW(pB0,0),PKW(pB0,2),PKW(pB0,4),PKW(pB0,6)};pw1=(u32x4){PKW(pB0,8),PKW(pB0,10),PKW(pB0,12),PKW(pB0,14)};pw2=(u32x4){PKW(pB1,0),PKW(pB1,2),PKW(pB1,4),PKW(pB1,6)};pw3=(u32x4){PKW(pB1,8),PKW(pB1,10),PKW(pB1,12),PKW(pB1,14)};
    SBAR(); pv(o,vb0+sl_cur,PAF(0),PAF(1),PAF(2),PAF(3)); }
  #undef PKW
  #undef PAF
  #undef VFR
  #undef PIN
  #undef MX3
  #undef GAPA
  #undef GAPB
  #undef EX
  #undef VRD
  #undef KRD
  #undef STEP
  #undef ENDW
  {auto rr=__builtin_amdgcn_permlane32_swap(__float_as_uint(l_reg),__float_as_uint(l_reg),false,false);l_reg=__uint_as_float(rr[0])+__uint_as_float(rr[1]);}
  if(hi==0)wsf[32+r32]=l_reg;asm volatile("s_waitcnt lgkmcnt(0)":::"memory");
  float rli[16];
  #pragma unroll
  for(int r=0;r<16;++r)rli[r]=__builtin_amdgcn_rcpf(wsf[32+crow(r,hi)]);
  bf16*Ow=O+(rowbase+q0+wid*QBLK)*DM+h*D;
  { bf16*stg=(bf16*)(shm+LDS_OST)+wid*2048;
    #pragma unroll
    for(int r=0;r<16;++r){const int orow=crow(r,hi);
      #pragma unroll
      for(int d0=0;d0<2;++d0)stg[orow*64+d0*32+r32]=__float2bfloat16(o[d0][r]*rli[r]);}
    asm volatile("s_waitcnt lgkmcnt(0)":::"memory");
    #pragma unroll
    for(int i=0;i<4;++i){const int row=i*8+(lane>>3),ch=lane&7; const u32x4 v=*(const u32x4*)(stg+row*64+ch*8); ATTN_STORE16(Ow+(long)row*DM+ch*8,v);} }
  asm volatile("s_waitcnt lgkmcnt(0)\n\ts_barrier":::"memory");
  #undef DMA_K
  #undef DMA_V
  #undef CMASK
  #undef CINIT
  #undef START
  #undef RESC
  #undef ROT
}
constexpr int ATTN_LDS_BYTES=LDS_BYTES;
struct AttnTensors { const bf16* Q; const bf16* K; const bf16* V; bf16* O; const float* C2; };
struct AttnUnit { int bh; int qb; int t0; };
struct StaticOrder {
  int vcu, G;
  __device__ __forceinline__ explicit StaticOrder(int grid,int block):vcu((grid%8==0)?(block%8)*(grid/8)+block/8:block),G(grid){}
  __device__ __forceinline__ bool next(int i,AttnUnit&u)const{
    if(G==256){ if(i>=8)return false; const int s=vcu&1, base=4*(i>>1); u.bh=vcu>>1; u.qb=(i&1)?base+3-s:base+s; u.t0=0; return true; }
    const int L=i*G+vcu; if(L>=BATCH*NHEAD*NQB)return false; u.bh=L/NQB; u.qb=L%NQB; u.t0=0; return true; }
  __device__ __forceinline__ void a_ready(const AttnUnit&)const{}
  __device__ __forceinline__ void done(const AttnUnit&)const{}
};
template<class Sched,int THRL=8> __device__ __forceinline__ void attn_phase(char*lds,const AttnTensors&T,const Sched&S){
  AttnUnit u;
  for(int i=0;S.next(i,u);++i){ S.a_ready(u); attn_unit<THRL>(u.bh/NHEAD,u.bh%NHEAD,u.qb,u.t0,T.Q,T.K,T.V,T.O,T.C2+(size_t)u.bh*SEQ,lds); S.done(u); }
}
constexpr float SKIP_THR=40.f;
template<int THRL=8> __device__ __forceinline__ void attn_phase_queue(char*lds,const AttnTensors&T,unsigned*ctr,const float*STAT,int ctl_off){
  const int tid=threadIdx.x,lane=tid&63;
  volatile __attribute__((address_space(3))) unsigned* slot=(volatile __attribute__((address_space(3))) unsigned*)((__attribute__((address_space(3))) char*)lds+ctl_off);
  for(;;){
    if(tid==0) slot[0]=__hip_atomic_fetch_add(ctr,1u,__ATOMIC_RELAXED,__HIP_MEMORY_SCOPE_AGENT);
    __syncthreads();
    const unsigned un=slot[0];
    __syncthreads();
    if(un>=(unsigned)(BATCH*NHEAD*NQB))break;
    const int qb=NQB-1-(int)(un>>7), bh=(int)(un&127), q0=qb*QB;
    const float*c2g=T.C2+(size_t)bh*SEQ;
    const float qq=STAT[bh*4+0]+STAT[bh*4+1], kk=STAT[bh*4+2]+STAT[bh*4+3];
    const float lim=c2g[q0]+2.04f*sqrtf(qq*kk)+SKIP_THR;
    bool ok=false; if(lane<32){ const int t0c=2*lane; ok=(t0c==0)||(t0c<=4*qb && c2g[64*t0c-1]>=lim); }
    const unsigned long long mk=__ballot(ok);
    const int t0=2*(31-__builtin_clz((unsigned)(mk&0xffffffffull)));
    attn_unit<THRL>(bh/NHEAD,bh%NHEAD,qb,t0,T.Q,T.K,T.V,T.O,c2g,lds);
  }
}
#undef SBAR
#undef WAIT_BAR
}
#define GAS __attribute__((address_space(1)))
#define LAS __attribute__((address_space(3)))
typedef unsigned short bf16;
typedef unsigned v4u __attribute__((ext_vector_type(4)));
typedef float f32x4 __attribute__((ext_vector_type(4)));
typedef short bf16x8 __attribute__((ext_vector_type(8)));
typedef GAS unsigned gu32;
typedef GAS unsigned long long gu64;
#define RLX_AGENT __ATOMIC_RELAXED, __HIP_MEMORY_SCOPE_AGENT
#define LDS_WAIT() asm volatile("s_waitcnt lgkmcnt(0)" ::: "memory")
#define VM_WAIT() asm volatile("s_waitcnt vmcnt(0)" ::: "memory")
__device__ __forceinline__ unsigned long long rt() { return __builtin_amdgcn_s_memrealtime(); }
__device__ __forceinline__ unsigned f2bf(float f) { unsigned u = __builtin_bit_cast(unsigned, f); return (u + 0x7fffu + ((u >> 16) & 1u)) >> 16; }
__device__ __forceinline__ unsigned pk2(float lo, float hi) { return f2bf(lo) | (f2bf(hi) << 16); }

#define XB_TMO      128
#define XB_XCNT(j)  (256  + 64 * (j))
#define XB_XSUB(j)  (1280 + 64 * (j))
#define XB_XGEN(j)  (2304 + 64 * (j))
#define XB_TOP      3328
#define XB_TOPGEN   3392
#define XCD_BAR_WORDS 3456
#define XB_SPIN_CAP (1u << 18)

__device__ __forceinline__ unsigned xb_ld(unsigned* p)              { return __hip_atomic_load(p, __ATOMIC_RELAXED, __HIP_MEMORY_SCOPE_AGENT); }
__device__ __forceinline__ unsigned xb_add(unsigned* p, unsigned v) { return __hip_atomic_fetch_add(p, v, __ATOMIC_RELAXED, __HIP_MEMORY_SCOPE_AGENT); }
__device__ __forceinline__ unsigned xb_xcc_id() { return (unsigned)__builtin_amdgcn_s_getreg((3 << 11) | 20) & 0xFu; }
#define XB_SPIN(cond, bar) do { unsigned _sp = 0; while (cond) { __builtin_amdgcn_s_sleep(1); \
    if ((++_sp & 255u) == 0u) { if (xb_ld(&(bar)[XB_TMO])) break; if (_sp > XB_SPIN_CAP) { atomicAdd(&(bar)[XB_TMO], 1u); break; } } } } while (0)

struct XcdBarrier {
    unsigned* bar; unsigned x;
    volatile LAS unsigned* st;
};

__device__ __forceinline__ XcdBarrier xcd_barrier_post(unsigned* bar, volatile LAS unsigned* st) {
    XcdBarrier b; b.bar = bar; b.x = xb_xcc_id(); b.st = st;
    if (threadIdx.x == 0) (void)xb_add(&bar[XB_XCNT(b.x)], 1u);
    return b;
}
__device__ __forceinline__ void xcd_barrier_complete(unsigned* bar, unsigned x, unsigned& nloc, unsigned& nx) {
    const unsigned G = gridDim.x * gridDim.y * gridDim.z;
    unsigned sum, cnt, mine, sp = 0u;
    for (;;) {
        sum = 0u; cnt = 0u; mine = 0u;
#pragma unroll
        for (unsigned j = 0; j < 16; ++j) { const unsigned c = xb_ld(&bar[XB_XCNT(j)]); sum += c; cnt += (c > 0u) ? 1u : 0u; mine = (j == x) ? c : mine; }
        if (sum == G) break;
        __builtin_amdgcn_s_sleep(1);
        if ((++sp & 255u) == 0u) { if (xb_ld(&bar[XB_TMO])) break; if (sp > XB_SPIN_CAP) { atomicAdd(&bar[XB_TMO], 1u); break; } }
    }
    nloc = mine > 0u ? mine : 1u; nx = cnt > 0u ? cnt : 1u;
}

__device__ __forceinline__ void xcd_barrier(const XcdBarrier& b) {
    asm volatile("s_waitcnt vmcnt(0)" ::: "memory");
    __syncthreads();
    if (threadIdx.x == 0) {
        unsigned* bar = b.bar;
        __builtin_amdgcn_s_waitcnt(0);
        unsigned nloc = b.st[0], nx = b.st[1];
        if (nloc == 0u) { xcd_barrier_complete(bar, b.x, nloc, nx); b.st[0] = nloc; b.st[1] = nx; }
        const unsigned old = xb_add(&bar[XB_XSUB(b.x)], 1u);
        const unsigned gen = old / nloc;
        if (old + 1u == (gen + 1u) * nloc) {
            __builtin_amdgcn_fence(__ATOMIC_RELEASE, "agent");
            asm volatile("s_waitcnt vmcnt(0)" ::: "memory");
            const unsigned og = xb_add(&bar[XB_TOP], 1u);
            const unsigned tg = og / nx;
            if (og + 1u == (tg + 1u) * nx) xb_add(&bar[XB_TOPGEN], 1u);
            else XB_SPIN(xb_ld(&bar[XB_TOPGEN]) == tg, bar);
            __builtin_amdgcn_fence(__ATOMIC_ACQUIRE, "agent");
            xb_add(&bar[XB_XGEN(b.x)], 1u);
            asm volatile("s_waitcnt vmcnt(0)" ::: "memory");
        } else {
            XB_SPIN(xb_ld(&bar[XB_XGEN(b.x)]) == gen, bar);
            __builtin_amdgcn_fence(__ATOMIC_ACQUIRE, "agent");
            asm volatile("s_waitcnt vmcnt(0)" ::: "memory");
        }
    }
    __syncthreads();
}

constexpr int BATCH = 8, SEQ = 4096, D = 1024, M = BATCH * SEQ, NHEADS = 16, HDIM = 64;
constexpr int INC = 7184, N1 = 7168;
constexpr int PHEADS = 8, PNK = 128, PDK = 256, PTOPK = 16, NQP = PHEADS * PDK, NEXP = PNK * PNK, NSEL = PHEADS * PTOPK;
constexpr float EPS = 1e-6f, LOG2E = 1.4426950408889634f;
constexpr float U_SCALE = 800.f, V_SCALE = 16.f, A_SCALE = 32.f;
constexpr int NWAVES = 8;

constexpr size_t MiB = 1u << 20;
constexpr size_t WS_CTL = 0, CTL_ZERO_BYTES = 1 * MiB;
constexpr size_t WS_LOGF = 1 * MiB;
constexpr size_t WS_C2 = 3 * MiB;
constexpr size_t WS_K1 = 5 * MiB, WS_K2 = 5 * MiB + 256 * 1024;
constexpr size_t WS_WIN = 8 * MiB;
constexpr size_t WS_WC = 22 * MiB, WS_WF = 24 * MiB, WS_WO = 26 * MiB, WS_WQ = 28 * MiB;
constexpr size_t WS_U = 32 * MiB, WS_VT = 64 * MiB;
constexpr size_t WS_XN = 96 * MiB;
constexpr size_t WS_GLU = 160 * MiB;
constexpr size_t WS_QO = 224 * MiB, WS_K = 288 * MiB, WS_V = 352 * MiB;
constexpr size_t WS_QP = 96 * MiB;
constexpr size_t WS_IDX = 352 * MiB;
constexpr size_t WS_GATE = 360 * MiB;
constexpr size_t WS_ACT = 376 * MiB;
constexpr size_t WS_HHI = 224 * MiB, WS_HLO = 256 * MiB;
constexpr size_t WS_PART = 96 * MiB;
#ifndef PEER_SLICED
#define PEER_SLICED 1
#endif
constexpr size_t WS_END = 416 * MiB;

constexpr int CW_BAR = 4096, CW_ATTQ = 8192 + 64, CW_STAT = 16384, CW_RSS = 32768;

constexpr int RING_OFF = 0, RING_BYTES = 131072;
constexpr int LDS_BYTES = 155648, LDSCTL_OFF = 154624, MISC_OFF = LDSCTL_OFF + 320;
static_assert(MISC_OFF + 128 <= LDS_BYTES, "LDS map");

__device__ __forceinline__ float wave_sum(float v) {
#pragma unroll
    for (int o = 1; o < 64; o <<= 1) v += __shfl_xor(v, o);
    return v;
}
__device__ __forceinline__ float sigmoidf_(float x) { return __builtin_amdgcn_rcpf(1.f + __builtin_amdgcn_exp2f(-x * LOG2E)); }
__device__ __forceinline__ float bf_lo(unsigned v) { return __uint_as_float(v << 16); }
__device__ __forceinline__ float bf_hi(unsigned v) { return __uint_as_float(v & 0xffff0000u); }
typedef unsigned u32x2 __attribute__((ext_vector_type(2)));

__device__ __forceinline__ void p0_transpose_item(const float* W, int ldw, int col0, bf16* WT, int K, int drow0, LAS float* scr, int kb, int lane, const float* kscale = nullptr) {
    const int k0 = 64 * kb;
    float tv[32];
#pragma unroll
    for (int i = 0; i < 32; ++i) tv[i] = W[(size_t)(k0 + 2 * i + (lane >> 5)) * ldw + col0 + (lane & 31)];
    if (kscale) {
#pragma unroll
        for (int i = 0; i < 32; ++i) tv[i] *= kscale[k0 + 2 * i + (lane >> 5)]; }
#pragma unroll
    for (int i = 0; i < 32; ++i) scr[(2 * i + (lane >> 5)) * 33 + (lane & 31)] = tv[i];
    LDS_WAIT(); asm volatile("" ::: "memory");
    const int c = lane & 7;
#pragma unroll
    for (int j = 0; j < 4; ++j) { const int n = (lane >> 3) + 8 * j; const LAS float* s = scr + (8 * c) * 33 + n;
        v4u o; o.x = pk2(s[0 * 33], s[1 * 33]); o.y = pk2(s[2 * 33], s[3 * 33]); o.z = pk2(s[4 * 33], s[5 * 33]); o.w = pk2(s[6 * 33], s[7 * 33]);
        *(GAS v4u*)(WT + (size_t)(drow0 + n) * K + k0 + 8 * c) = o; }
    LDS_WAIT(); asm volatile("" ::: "memory");
}
__device__ __forceinline__ float log_sigmoid_(float z) { return fminf(z, 0.f) - log1pf(expf(-fabsf(z))); }

struct P0Args { const float *g2; const float *x, *g1, *w_in, *w_conv_out, *w_fox_out, *w_out, *peer_wq, *k1, *k2, *u, *v, *fox_bf;
                bf16 *WIN, *WC, *WF, *WO, *WQ, *K1b, *K2b; unsigned char *Uq, *Vq; bf16* XN; float* LOGF; };
__device__ __forceinline__ void p0_prologue(LAS unsigned char* lds, const P0Args& a, int vcu, int G, int tid, int parts = 7) {
    const int lane = tid & 63, wave = __builtin_amdgcn_readfirstlane(tid >> 6);
    LAS float* scr = (LAS float*)(lds + wave * 8704);
    LAS float* wfT = (LAS float*)(lds + 69632);
    const int gw = vcu * NWAVES + wave, NGW = G * NWAVES;
#pragma unroll
    for (int c = tid; c < 4096; c += NWAVES * 64) { const int d = c >> 2, q4 = c & 3; const f32x4 t = *(const GAS f32x4*)(a.w_in + (size_t)d * INC + 5120 + 4 * q4);
        wfT[(4 * q4 + 0) * 1024 + d] = t.x; wfT[(4 * q4 + 1) * 1024 + d] = t.y; wfT[(4 * q4 + 2) * 1024 + d] = t.z; wfT[(4 * q4 + 3) * 1024 + d] = t.w; }
    __syncthreads();
    if (parts & 1) {
        const GAS f32x4* gp = (const GAS f32x4*)a.g1 + lane; f32x4 gv[4];
#pragma unroll
        for (int j = 0; j < 4; ++j) gv[j] = gp[64 * j];
        const float fb = a.fox_bf[(lane >> 2) & 15];
        for (int m0 = gw * 4; m0 < M; m0 += NGW * 4) {
            f32x4 va[4][4];
#pragma unroll
            for (int rr = 0; rr < 4; ++rr) { const GAS f32x4* xr = (const GAS f32x4*)(a.x + (size_t)(m0 + rr) * D) + lane;
#pragma unroll
                for (int j = 0; j < 4; ++j) va[rr][j] = xr[64 * j]; }
#pragma unroll
            for (int rr = 0; rr < 4; ++rr) {
            const int m = m0 + rr;
            f32x4 v[4]; float s = 0.f;
#pragma unroll
            for (int j = 0; j < 4; ++j) { v[j] = va[rr][j]; s += (v[j].x * v[j].x + v[j].y * v[j].y) + (v[j].z * v[j].z + v[j].w * v[j].w); }
            const float rstd = 1.0f / sqrtf(wave_sum(s) * (1.f / D) + EPS);
#pragma unroll
            for (int j = 0; j < 4; ++j) v[j] = v[j] * rstd * gv[j];
            GAS unsigned long long* o8 = (GAS unsigned long long*)(a.XN + (size_t)m * D) + lane;
#pragma unroll
            for (int j = 0; j < 4; ++j) o8[64 * j] = (unsigned long long)pk2(v[j].x, v[j].y) | ((unsigned long long)pk2(v[j].z, v[j].w) << 32);
            float fp[16];
#pragma unroll
            for (int jj = 0; jj < 16; ++jj) { float t = 0.f;
#pragma unroll
                for (int j = 0; j < 4; ++j) { const f32x4 w = *(const LAS f32x4*)(wfT + jj * 1024 + 256 * j + 4 * lane); t += (v[j].x * w.x + v[j].y * w.y) + (v[j].z * w.z + v[j].w * w.w); }
                fp[jj] = t; if (jj & 1) __builtin_amdgcn_sched_barrier(0); }
#pragma unroll
            for (int st = 0; st < 4; ++st) { const int msk = 32 >> st, n = 8 >> st; const bool up = (lane & msk) != 0;
#pragma unroll
                for (int i = 0; i < n; ++i) { float a_ = fp[i], b_ = fp[i + n]; asm volatile("" : "+v"(a_), "+v"(b_));
                    const float mine = up ? b_ : a_, theirs = up ? a_ : b_; fp[i] = mine + __shfl_xor(theirs, msk); } }
            float ft = fp[0]; ft += __shfl_xor(ft, 1); ft += __shfl_xor(ft, 2);
            if ((lane & 3) == 0) a.LOGF[(size_t)m * 16 + ((lane >> 2) & 15)] = log_sigmoid_(ft + fb);
            }
        }
    }
    if (parts & 2) for (int it = gw; it < 6144; it += NGW) {
        int r = it;
        if (r < 512)  { const int nb = r & 31, kb = r >> 5; p0_transpose_item(a.w_in, INC, 32 * nb, a.WIN, D, (nb >> 2) * 256 + (nb & 3) * 32, scr, kb, lane); continue; } r -= 512;
        if (r < 512)  { const int nb = r & 31, kb = r >> 5; p0_transpose_item(a.w_in, INC, 1024 + 32 * nb, a.WIN, D, (nb >> 2) * 256 + 128 + (nb & 3) * 32, scr, kb, lane); continue; } r -= 512;
        if (r < 1536) { const int nb = r % 96, kb = r / 96; p0_transpose_item(a.w_in, INC, 2048 + 32 * nb, a.WIN, D, 2048 + 32 * nb, scr, kb, lane); continue; } r -= 1536;
        if (r < 1024) { const int nb = r & 63, kb = r >> 6; p0_transpose_item(a.w_in, INC, 5136 + 32 * nb, a.WIN, D, 5120 + 32 * nb, scr, kb, lane); continue; } r -= 1024;
        if (r < 512)  { const int nb = r & 31, kb = r >> 5; p0_transpose_item(a.w_conv_out, D, 32 * nb, a.WC, D, 32 * nb, scr, kb, lane); continue; } r -= 512;
        if (r < 512)  { const int nb = r & 31, kb = r >> 5; p0_transpose_item(a.w_fox_out, D, 32 * nb, a.WF, D, 32 * nb, scr, kb, lane); continue; } r -= 512;
        if (r < 512)  { const int nb = r & 31, kb = r >> 5; p0_transpose_item(a.w_out, D, 32 * nb, a.WO, D, 32 * nb, scr, kb, lane); continue; } r -= 512;
        { const int nb = r & 63, kb = r >> 6; p0_transpose_item(a.peer_wq, NQP, 32 * nb, a.WQ, D, 32 * nb, scr, kb, lane, a.g2); }
    }
    constexpr int I_K = PHEADS * PNK * 128 / 512;
    if (parts & 4) for (int it = gw; it < 2 * I_K; it += NGW) {
        int r = it; const float* src; bf16* dst;
        if (r < I_K) { src = a.k1; dst = a.K1b; } else { r -= I_K; src = a.k2; dst = a.K2b; }
        const size_t e0 = (size_t)r * 512 + 8 * lane;
        const f32x4 p = *(const GAS f32x4*)(src + e0), q = *(const GAS f32x4*)(src + e0 + 4);
        v4u o; o.x = pk2(p.x, p.y); o.y = pk2(p.z, p.w); o.z = pk2(q.x, q.y); o.w = pk2(q.z, q.w);
        *(GAS v4u*)(dst + e0) = o;
    }
    constexpr int I_U = NEXP * D / 4096;
    f32x4 gq[4];
#pragma unroll
    for (int j = 0; j < 4; ++j) gq[j] = *(const GAS f32x4*)(a.g2 + 4 * lane + 256 * j);
    if (parts & 4) for (int it = gw; it < 2 * I_U; it += NGW) {
        const bool isv = it >= I_U; const int r = isv ? it - I_U : it;
        const float* src = isv ? a.v : a.u; unsigned char* dst = isv ? a.Vq : a.Uq; const float sc = isv ? V_SCALE : U_SCALE;
        const size_t e0 = (size_t)r * 4096 + 4 * lane; f32x4 p[16];
#pragma unroll
        for (int k = 0; k < 16; ++k) p[k] = *(const GAS f32x4*)(src + e0 + 256 * k);
#pragma unroll
        for (int k = 0; k < 16; ++k) { f32x4 t = p[k] * sc; if (PEER_SLICED && !isv) t = t * gq[k & 3]; int w = __builtin_amdgcn_cvt_pk_fp8_f32(t.x, t.y, 0, false); w = __builtin_amdgcn_cvt_pk_fp8_f32(t.z, t.w, w, true);
            if (PEER_SLICED && !isv) {
                const int q0 = (int)__builtin_rintf(fminf(fmaxf(t.x, -127.f), 127.f)), q1 = (int)__builtin_rintf(fminf(fmaxf(t.y, -127.f), 127.f)), q2 = (int)__builtin_rintf(fminf(fmaxf(t.z, -127.f), 127.f)), q3 = (int)__builtin_rintf(fminf(fmaxf(t.w, -127.f), 127.f));
                w = (q0 & 0xff) | ((q1 & 0xff) << 8) | ((q2 & 0xff) << 16) | (q3 << 24); }
            const size_t ee = e0 + 256 * k;
            if (PEER_SLICED) { const size_t erow = ee >> 10; const int dcol = (int)(ee & 1023); *(GAS unsigned*)(dst + (size_t)(dcol >> 7) * ((size_t)NEXP * 128) + erow * 128 + (dcol & 127)) = (unsigned)w; }
            else *(GAS unsigned*)(dst + ee) = (unsigned)w; }
    }
}

namespace pg8 {
struct EpiP1 {
    static constexpr bool PERM = true, AFTER_DRAIN = false;
    bf16_t *GLU, *Q, *K, *V, *GA, *GB; float qscale; unsigned* STAT;
    __device__ __forceinline__ void operator()(const f32x4 (&acc)[2][2][4][2], const Unit& u, int wr, int wc, int fr, int fq) const {
        const int row0 = u.pm * BM + wr * 64 + fr;
        if (u.pn < 8) {
            const int col = 128 * u.pn + wc * 32 + 8 * fq;
#pragma unroll
            for (int ai = 0; ai < 2; ++ai)
#pragma unroll
                for (int m = 0; m < 4; ++m) {
                    const f32x4 v0 = acc[ai][0][m][0], v1 = acc[ai][0][m][1], g0 = acc[ai][1][m][0], g1 = acc[ai][1][m][1];
                    u32x4 w;
                    w.x = cvt_pk_bf16(v0[0] * sigmoidf_(g0[0]), v0[1] * sigmoidf_(g0[1])); w.y = cvt_pk_bf16(v0[2] * sigmoidf_(g0[2]), v0[3] * sigmoidf_(g0[3]));
                    w.z = cvt_pk_bf16(v1[0] * sigmoidf_(g1[0]), v1[1] * sigmoidf_(g1[1])); w.w = cvt_pk_bf16(v1[2] * sigmoidf_(g1[2]), v1[3] * sigmoidf_(g1[3]));
                    *(u32x4*)(GLU + (size_t)(row0 + ai * HALF + m * 16) * 1024 + col) = w;
                }
        } else {
            const int t = (u.pn - 8) >> 2, colt = ((u.pn - 8) & 3) * 256 + wc * 32 + 8 * fq;
            bf16_t* base = t == 0 ? Q : t == 1 ? K : t == 2 ? V : t == 3 ? GA : GB;
            const float sc = t == 0 ? qscale : 1.f;
#pragma unroll
            for (int ai = 0; ai < 2; ++ai)
#pragma unroll
                for (int m = 0; m < 4; ++m) { bf16_t* rowp = base + (size_t)(row0 + ai * HALF + m * 16) * 1024 + colt;
#pragma unroll
                    for (int bj = 0; bj < 2; ++bj) { f32x4 v0 = acc[ai][bj][m][0], v1 = acc[ai][bj][m][1];
                        if (t >= 3) {
#pragma unroll
                            for (int i = 0; i < 4; ++i) { v0[i] = sigmoidf_(v0[i]); v1[i] = sigmoidf_(v1[i]); }
                        } else { v0 = v0 * sc; v1 = v1 * sc; }
                        u32x4 w; w.x = cvt_pk_bf16(v0[0], v0[1]); w.y = cvt_pk_bf16(v0[2], v0[3]); w.z = cvt_pk_bf16(v1[0], v1[1]); w.w = cvt_pk_bf16(v1[2], v1[3]);
                        *(u32x4*)(rowp + bj * HALF) = w; } }
            if (t <= 1) {
                float mx[2] = {0.f, 0.f};
#pragma unroll
                for (int ai = 0; ai < 2; ++ai)
#pragma unroll
                    for (int m = 0; m < 4; ++m)
#pragma unroll
                        for (int bj = 0; bj < 2; ++bj) { const f32x4 v0 = acc[ai][bj][m][0] * sc, v1 = acc[ai][bj][m][1] * sc;
                            float s = (v0[0] * v0[0] + v0[1] * v0[1]) + (v0[2] * v0[2] + v0[3] * v0[3]) + (v1[0] * v1[0] + v1[1] * v1[1]) + (v1[2] * v1[2] + v1[3] * v1[3]);
                            s += __shfl_xor(s, 16); s += __shfl_xor(s, 32); mx[bj] = fmaxf(mx[bj], s); }
#pragma unroll
                for (int bj = 0; bj < 2; ++bj) { float v = mx[bj];
#pragma unroll
                    for (int o = 1; o < 16; o <<= 1) v = fmaxf(v, __shfl_xor(v, o));
                    if ((fr | fq) == 0) atomicMax(STAT + ((u.pm >> 4) * 16 + ((u.pn - 8) & 3) * 4 + bj * 2 + (wc >> 1)) * 4 + 2 * t + (wc & 1), __float_as_uint(v)); }
            }
        }
    }
};
struct EpiDual {
    static constexpr bool PERM = true, AFTER_DRAIN = false;
    const bf16_t *GA, *GB; bf16_t* O;
    __device__ __forceinline__ void operator()(f32x4 (&acc)[2][2][4][2], const Unit& u, int wr, int wc, int fr, int fq) const {
        const int row0 = u.pm * BM + wr * 64 + fr, col0 = u.pn * BM + wc * 32 + 8 * fq;
#pragma unroll
        for (int ai = 0; ai < 2; ++ai)
#pragma unroll
            for (int m = 0; m < 4; ++m)
#pragma unroll
                for (int bj = 0; bj < 2; ++bj) {
                    const size_t off = (size_t)(row0 + ai * HALF + m * 16) * 1024 + col0 + bj * HALF;
                    const u32x4 gb = *(const u32x4*)(GB + off);
                    if (u.seg == 0) {
                        const u32x4 ga = *(const u32x4*)(GA + off);
#pragma unroll
                        for (int i = 0; i < 4; ++i) { const unsigned a_ = ga[i], b_ = gb[i]; const int n = i >> 1, e = (i & 1) * 2;
                            acc[ai][bj][m][n][e]     *= bf_lo(a_) * __builtin_amdgcn_rcpf(fmaxf(bf_lo(b_), 1e-30f));
                            acc[ai][bj][m][n][e + 1] *= bf_hi(a_) * __builtin_amdgcn_rcpf(fmaxf(bf_hi(b_), 1e-30f)); }
                    } else {
                        u32x4 w;
#pragma unroll
                        for (int i = 0; i < 4; ++i) { const unsigned b_ = gb[i]; const int n = i >> 1, e = (i & 1) * 2;
                            w[i] = cvt_pk_bf16(acc[ai][bj][m][n][e] * bf_lo(b_), acc[ai][bj][m][n][e + 1] * bf_hi(b_)); }
                        *(u32x4*)(O + off) = w;
                    }
                }
    }
};
struct DualOrder {
    StaticOrder S; int ntile, G, c;
    __device__ __forceinline__ void init(int M_, int N_, int G_, int c_) { S.init(M_, N_, G_, c_); ntile = S.nwg; G = G_; c = c_; }
    __device__ __forceinline__ bool next(int i, Unit& u) const { if (!S.next(i >> 1, u)) return false; u.seg = i & 1; return true; }
    __device__ __forceinline__ void a_ready(const Unit&) const {}
    __device__ __forceinline__ void done(const Unit&) const {}
};
typedef float pf32x2 __attribute__((ext_vector_type(2))); typedef unsigned pu32x2 __attribute__((ext_vector_type(2)));
struct EpiResNorm {
    static constexpr bool PERM = true, AFTER_DRAIN = false;
    const float* base; bf16_t* X1b; float* RSS; const float* g2; unsigned char *HHI, *HLO;
    __device__ __forceinline__ void operator()(const f32x4 (&acc)[2][2][4][2], const Unit& u, int wr, int wc, int fr, int fq) const {
        const int row0 = u.pm * BM + wr * 64 + fr, col0 = u.pn * BM + wc * 32 + 8 * fq;
#pragma unroll
        for (int ai = 0; ai < 2; ++ai)
#pragma unroll
            for (int m = 0; m < 4; ++m) { float ss = 0.f; const int row = row0 + ai * HALF + m * 16;
#pragma unroll
                for (int bj = 0; bj < 2; ++bj) {
                    const size_t off = (size_t)row * 1024 + col0 + bj * HALF;
                    const f32x4 x0 = *(const f32x4*)(base + off) + acc[ai][bj][m][0], x1 = *(const f32x4*)(base + off + 4) + acc[ai][bj][m][1];
                    ss += (x0[0] * x0[0] + x0[1] * x0[1]) + (x0[2] * x0[2] + x0[3] * x0[3]) + (x1[0] * x1[0] + x1[1] * x1[1]) + (x1[2] * x1[2] + x1[3] * x1[3]);
                    u32x4 w; w.x = cvt_pk_bf16(x0[0], x0[1]); w.y = cvt_pk_bf16(x0[2], x0[3]); w.z = cvt_pk_bf16(x1[0], x1[1]); w.w = cvt_pk_bf16(x1[2], x1[3]);
                    *(u32x4*)(X1b + off) = w;
                    if (HHI) {
                        const int cc = col0 + bj * HALF;
                        const f32x4 s0 = x0 * *(const f32x4*)(g2 + cc) * 16.f, s1 = x1 * *(const f32x4*)(g2 + cc + 4) * 16.f;
                        int a0 = __builtin_amdgcn_cvt_pk_fp8_f32(s0[0], s0[1], 0, false); a0 = __builtin_amdgcn_cvt_pk_fp8_f32(s0[2], s0[3], a0, true);
                        int a1 = __builtin_amdgcn_cvt_pk_fp8_f32(s1[0], s1[1], 0, false); a1 = __builtin_amdgcn_cvt_pk_fp8_f32(s1[2], s1[3], a1, true);
                        const pf32x2 d0 = __builtin_amdgcn_cvt_pk_f32_fp8(a0, false), d1 = __builtin_amdgcn_cvt_pk_f32_fp8(a0, true), d2 = __builtin_amdgcn_cvt_pk_f32_fp8(a1, false), d3 = __builtin_amdgcn_cvt_pk_f32_fp8(a1, true);
                        int b0 = __builtin_amdgcn_cvt_pk_fp8_f32((s0[0] - d0.x) * 16.f, (s0[1] - d0.y) * 16.f, 0, false); b0 = __builtin_amdgcn_cvt_pk_fp8_f32((s0[2] - d1.x) * 16.f, (s0[3] - d1.y) * 16.f, b0, true);
                        int b1 = __builtin_amdgcn_cvt_pk_fp8_f32((s1[0] - d2.x) * 16.f, (s1[1] - d2.y) * 16.f, 0, false); b1 = __builtin_amdgcn_cvt_pk_fp8_f32((s1[2] - d3.x) * 16.f, (s1[3] - d3.y) * 16.f, b1, true);
                        const size_t hoff = (size_t)(cc >> 7) * ((size_t)32768 * 128) + (size_t)row * 128 + (cc & 127);
                        *(pu32x2*)(HHI + hoff) = (pu32x2){(unsigned)a0, (unsigned)a1}; *(pu32x2*)(HLO + hoff) = (pu32x2){(unsigned)b0, (unsigned)b1};
                    }
                }
                ss += __shfl_xor(ss, 16); ss += __shfl_xor(ss, 32);
                if (fq == 0) unsafeAtomicAdd(RSS + row, ss);
            }
    }
};
struct EpiScaleRow {
    static constexpr bool PERM = true, AFTER_DRAIN = false;
    bf16_t* O; int ldc; const float* RSS;
    __device__ __forceinline__ void operator()(const f32x4 (&acc)[2][2][4][2], const Unit& u, int wr, int wc, int fr, int fq) const {
        const int row0 = u.pm * BM + wr * 64 + fr, col0 = u.pn * BM + wc * 32 + 8 * fq;
#pragma unroll
        for (int ai = 0; ai < 2; ++ai)
#pragma unroll
            for (int m = 0; m < 4; ++m) { const int row = row0 + ai * HALF + m * 16; const float rs = 1.0f / sqrtf(RSS[row] * (1.f / 1024.f) + 1e-6f);
#pragma unroll
                for (int bj = 0; bj < 2; ++bj) { const f32x4 v0 = acc[ai][bj][m][0] * rs, v1 = acc[ai][bj][m][1] * rs;
                    u32x4 w; w.x = cvt_pk_bf16(v0[0], v0[1]); w.y = cvt_pk_bf16(v0[2], v0[3]); w.z = cvt_pk_bf16(v1[0], v1[1]); w.w = cvt_pk_bf16(v1[2], v1[3]);
                    *(u32x4*)(O + (size_t)row * ldc + col0 + bj * HALF) = w; } }
    }
};
}

__device__ __forceinline__ void scan_unit(LAS unsigned char* lds, const float* LOGF, float* C2, int bh, int tid) {
    const int b = bh >> 4, h = bh & 15, lane = tid & 63, wave = tid >> 6;
    LAS float* wtot = (LAS float*)lds;
    float v[8]; float run = 0.f;
#pragma unroll
    for (int i = 0; i < 8; ++i) { run += LOGF[((size_t)b * SEQ + 8 * tid + i) * 16 + h]; v[i] = run; }
    float inc = run;
#pragma unroll
    for (int o = 1; o < 64; o <<= 1) { const float t = __shfl_up(inc, o); if (lane >= o) inc += t; }
    if (lane == 63) wtot[wave] = inc;
    __syncthreads();
    float base = inc - run;
    for (int w = 0; w < wave; ++w) base += wtot[w];
    f32x4 o0, o1;
    o0.x = (base + v[0]) * LOG2E; o0.y = (base + v[1]) * LOG2E; o0.z = (base + v[2]) * LOG2E; o0.w = (base + v[3]) * LOG2E;
    o1.x = (base + v[4]) * LOG2E; o1.y = (base + v[5]) * LOG2E; o1.z = (base + v[6]) * LOG2E; o1.w = (base + v[7]) * LOG2E;
    *(f32x4*)(C2 + (size_t)bh * SEQ + 8 * tid) = o0; *(f32x4*)(C2 + (size_t)bh * SEQ + 8 * tid + 4) = o1;
    __syncthreads();
}
__device__ __forceinline__ void conv_phase(LAS unsigned char* lds, const bf16* GLU, const float* conv_w, const float* conv_b, const float* ln_g, const float* ln_b, bf16* CZ, int vcu, int G, int tid) {
    typedef float f32x2 __attribute__((ext_vector_type(2)));
    LAS float* red = (LAS float*)lds;
    LAS float* fin = (LAS float*)(lds + 65536);
    const int lane = tid & 63;
    float w0[31], w1[31];
#pragma unroll
    for (int j = 0; j < 31; ++j) { const f32x2 t = *(const f32x2*)(conv_w + j * 1024 + 2 * tid); w0[j] = t.x; w1[j] = t.y; }
    const f32x2 cb = *(const f32x2*)(conv_b + 2 * tid), lg = *(const f32x2*)(ln_g + 2 * tid), lb = *(const f32x2*)(ln_b + 2 * tid);
    const unsigned* Gd = (const unsigned*)GLU; unsigned* Cd = (unsigned*)CZ;
    for (int tile = vcu; tile < M / 32; tile += G) {
        const int t0 = tile * 32, sloc = t0 & (SEQ - 1);
        unsigned in[62];
#pragma unroll
        for (int r = 0; r < 62; ++r) in[r] = (sloc - 30 + r >= 0) ? Gd[(size_t)(t0 - 30 + r) * 512 + tid] : 0u;
#pragma unroll
        for (int ch = 0; ch < 2; ++ch) {
            float o0[16], o1[16];
#pragma unroll
            for (int tt = 0; tt < 16; ++tt) { float a0 = cb.x, a1 = cb.y;
#pragma unroll
                for (int j = 0; j < 31; ++j) { const unsigned v = in[16 * ch + tt + j]; a0 += w0[j] * bf_lo(v); a1 += w1[j] * bf_hi(v); }
                o0[tt] = a0; o1[tt] = a1; red[tt * 512 + tid] = a0 + a1; red[(16 + tt) * 512 + tid] = a0 * a0 + a1 * a1; }
            __syncthreads();
            { const int st = tid >> 4, sg = tid & 15; float s = 0.f;
#pragma unroll
              for (int i = 0; i < 8; ++i) { const f32x4 t = *(const LAS f32x4*)(red + st * 512 + sg * 32 + 4 * i); s += (t.x + t.y) + (t.z + t.w); }
              s += __shfl_xor(s, 1); s += __shfl_xor(s, 2); s += __shfl_xor(s, 4); s += __shfl_xor(s, 8);
              if (sg == 0) fin[st] = s; }
            __syncthreads();
#pragma unroll
            for (int tt = 0; tt < 16; ++tt) {
                const float mean = fin[tt] * (1.f / 1024.f), var = fin[16 + tt] * (1.f / 1024.f) - mean * mean, rstd = 1.0f / sqrtf(fmaxf(var, 0.f) + EPS);
                const float y0 = (o0[tt] - mean) * rstd * lg.x + lb.x, y1 = (o1[tt] - mean) * rstd * lg.y + lb.y;
                Cd[(size_t)(t0 + 16 * ch + tt) * 512 + tid] = pk2(y0 * sigmoidf_(y0), y1 * sigmoidf_(y1));
            }
        }
    }
    (void)lane;
}

__device__ __forceinline__ void norm2_phase(const float* X1, const float* g2, bf16* H2, int gw, int NGW, int lane) {
    const GAS f32x4* gp = (const GAS f32x4*)g2 + lane; f32x4 gv[4];
#pragma unroll
    for (int j = 0; j < 4; ++j) gv[j] = gp[64 * j];
    for (int m = gw; m < M; m += NGW) {
        const GAS f32x4* xr = (const GAS f32x4*)(X1 + (size_t)m * D) + lane;
        f32x4 v[4]; float s = 0.f;
#pragma unroll
        for (int j = 0; j < 4; ++j) { v[j] = xr[64 * j]; s += (v[j].x * v[j].x + v[j].y * v[j].y) + (v[j].z * v[j].z + v[j].w * v[j].w); }
        const float rstd = 1.0f / sqrtf(wave_sum(s) * (1.f / D) + EPS);
        GAS unsigned long long* o8 = (GAS unsigned long long*)(H2 + (size_t)m * D) + lane;
#pragma unroll
        for (int j = 0; j < 4; ++j) { const f32x4 t = v[j] * rstd * gv[j]; o8[64 * j] = (unsigned long long)pk2(t.x, t.y) | ((unsigned long long)pk2(t.z, t.w) << 32); }
    }
}

typedef float f32x16 __attribute__((ext_vector_type(16)));
__device__ __forceinline__ unsigned f_ord(float f) { const unsigned b = __float_as_uint(f); return b ^ ((unsigned)((int)b >> 31) | 0x80000000u); }
__device__ __forceinline__ float f_unord(unsigned k) { return __uint_as_float((k & 0x80000000u) ? (k ^ 0x80000000u) : ~k); }
#define CE_DESC(a, b) do { const unsigned hi_ = (a) > (b) ? (a) : (b), lo_ = (a) > (b) ? (b) : (a); (a) = hi_; (b) = lo_; } while (0)
#define CE_ASC(a, b)  do { const unsigned hi_ = (a) > (b) ? (a) : (b), lo_ = (a) > (b) ? (b) : (a); (a) = lo_; (b) = hi_; } while (0)
__device__ __forceinline__ void sort16_desc(unsigned (&v)[16]) {
#pragma unroll
    for (int k = 2; k <= 16; k <<= 1)
#pragma unroll
        for (int j = k >> 1; j > 0; j >>= 1)
#pragma unroll
            for (int i = 0; i < 16; ++i) { const int l = i ^ j; if (l > i) { if ((i & k) == 0) CE_DESC(v[i], v[l]); else CE_ASC(v[i], v[l]); } }
}
__device__ __forceinline__ void merge16_desc(unsigned (&a)[16], const unsigned (&b)[16]) {
#pragma unroll
    for (int i = 0; i < 16; ++i) a[i] = a[i] > b[15 - i] ? a[i] : b[15 - i];
#pragma unroll
    for (int j = 8; j > 0; j >>= 1)
#pragma unroll
        for (int i = 0; i < 16; ++i) { const int l = i ^ j; if (l > i) CE_DESC(a[i], a[l]); }
}
__device__ __forceinline__ void xchg_merge16(unsigned (&a)[16]) {
    unsigned b[16];
#pragma unroll
    for (int i = 0; i < 16; ++i) { auto rr = __builtin_amdgcn_permlane32_swap(a[i], a[i], false, false); b[i] = (threadIdx.x & 32) ? rr[0] : rr[1]; }
    merge16_desc(a, b);
}
constexpr int RK_OFF = 8192, RK_ROWB = 272, RK_HALFB = 128 * RK_ROWB;
__device__ __forceinline__ void route_unit(LAS unsigned char* tabw, const LAS unsigned char* keys, const bf16* QP, unsigned short* IDX, float* GATE, int tok0, int head, int lane) {
    const int r = lane & 31, hi = lane >> 5;
    unsigned L[2][16];
    bf16x8 bqa[2][8];
#pragma unroll
    for (int half = 0; half < 2; ++half) { const bf16* qrow = QP + (size_t)(tok0 + r) * NQP + head * PDK + half * 128 + 8 * hi;
#pragma unroll
        for (int s = 0; s < 8; ++s) bqa[half][s] = *(const bf16x8*)(qrow + 16 * s); }
#pragma unroll
    for (int half = 0; half < 2; ++half) {
        const LAS unsigned char* kb = keys + half * RK_HALFB + r * RK_ROWB + 16 * hi;
        bf16x8 bq[8];
#pragma unroll
        for (int s = 0; s < 8; ++s) bq[s] = bqa[half][s];
        unsigned R[16];
#pragma unroll
        for (int i = 0; i < 16; ++i) R[i] = 0u;
#pragma unroll 1
        for (int nb = 0; nb < 4; ++nb) {
            f32x16 acc = f32x16{};
#pragma unroll
            for (int s = 0; s < 8; ++s) { const bf16x8 ak = *(const LAS bf16x8*)(kb + nb * 32 * RK_ROWB + 32 * s); acc = __builtin_amdgcn_mfma_f32_32x32x16_bf16(ak, bq[s], acc, 0, 0, 0); }
            unsigned g[16];
#pragma unroll
            for (int q = 0; q < 16; ++q) { const int n = 32 * nb + (q & 3) + 8 * (q >> 2) + 4 * hi; g[q] = (f_ord(acc[q]) & ~127u) | (unsigned)(127 - n); }
            sort16_desc(g);
            merge16_desc(R, g);
        }
        xchg_merge16(R);
#pragma unroll
        for (int i = 0; i < 16; ++i) L[half][i] = R[i];
    }
    {
        LAS unsigned* tp = (LAS unsigned*)(tabw + r * 32 + hi * 16);
#pragma unroll
        for (int d = 0; d < 4; ++d) { unsigned w = 0;
#pragma unroll
            for (int b = 0; b < 4; ++b) { const unsigned k1 = L[0][4 * d + b], k2 = L[1][4 * d + b]; const unsigned n = 127u - ((hi ? k2 : k1) & 127u); w |= n << (8 * b); }
            tp[d] = w; }
    }
    float F1[16], F2[16];
#pragma unroll
    for (int i = 0; i < 16; ++i) { F1[i] = f_unord(L[0][i] & ~127u); F2[i] = f_unord(L[1][i] & ~127u); }
    unsigned c0[16], c1[16];
#define CAND(dst, ai, aj, bi, bj) do { const float f1_ = hi ? F1[bi] : F1[ai], f2_ = hi ? F2[bj] : F2[aj]; \
        dst = (f_ord(f1_ + f2_) & ~255u) | (hi ? (unsigned)(255 - ((bi) * 16 + (bj))) : (unsigned)(255 - ((ai) * 16 + (aj)))); } while (0)
    CAND(c0[0], 0, 0, 1, 0);  CAND(c0[1], 0, 1, 1, 1);  CAND(c0[2], 0, 2, 1, 2);  CAND(c0[3], 0, 3, 1, 3);
    CAND(c0[4], 0, 4, 1, 4);  CAND(c0[5], 0, 5, 1, 5);  CAND(c0[6], 0, 6, 1, 6);  CAND(c0[7], 0, 7, 1, 7);
    CAND(c0[8], 0, 8, 2, 0);  CAND(c0[9], 0, 9, 2, 1);  CAND(c0[10], 0, 10, 2, 2); CAND(c0[11], 0, 11, 2, 3);
    CAND(c0[12], 0, 12, 2, 4); CAND(c0[13], 0, 13, 3, 0); CAND(c0[14], 0, 14, 3, 1); CAND(c0[15], 0, 15, 3, 2);
    CAND(c1[0], 8, 0, 3, 3);  CAND(c1[1], 9, 0, 4, 1);  CAND(c1[2], 10, 0, 4, 2); CAND(c1[3], 11, 0, 5, 0);
    CAND(c1[4], 12, 0, 5, 1); CAND(c1[5], 13, 0, 6, 0); CAND(c1[6], 14, 0, 6, 1); CAND(c1[7], 15, 0, 7, 0);
    CAND(c1[8], 4, 0, 7, 1);
#undef CAND
#pragma unroll
    for (int s = 9; s < 16; ++s) c1[s] = 0u;
    sort16_desc(c0); sort16_desc(c1); merge16_desc(c0, c1); xchg_merge16(c0);
    float sc[16]; float ssum = 0.f;
#pragma unroll
    for (int k = 0; k < 16; ++k) { sc[k] = __builtin_amdgcn_exp2f((f_unord(c0[k] & ~255u) - f_unord(c0[0] & ~255u)) * LOG2E); ssum += sc[k]; }
    const float rs = 1.0f / ssum;
    const LAS unsigned char* tb = (const LAS unsigned char*)(tabw + r * 32);
    unsigned ew[4]; f32x4 g0, g1;
#pragma unroll
    for (int kk = 0; kk < 8; ++kk) {
        unsigned ka_ = c0[kk], kb_ = c0[8 + kk]; float sa_ = sc[kk], sb_ = sc[8 + kk];
        asm volatile("" : "+v"(ka_), "+v"(kb_), "+v"(sa_), "+v"(sb_));
        const unsigned key = hi ? kb_ : ka_; const float gt = (hi ? sb_ : sa_) * rs;
        const unsigned code = 255u - (key & 255u); const unsigned e1 = tb[code >> 4], e2 = tb[16 + (code & 15u)];
        const unsigned e = e1 * 128u + e2;
        if (kk & 1) ew[kk >> 1] |= e << 16; else ew[kk >> 1] = e;
        if (kk < 4) g0[kk] = gt; else g1[kk - 4] = gt;
    }
    const size_t o = (size_t)(tok0 + r) * NSEL + head * PTOPK + 8 * hi;
    *(v4u*)(IDX + o) = (v4u){ew[0], ew[1], ew[2], ew[3]};
    *(f32x4*)(GATE + o) = g0; *(f32x4*)(GATE + o + 4) = g1;
}

__device__ __forceinline__ float gelu_tanh(float x) {
    const float y = 0.7978845608028654f * (x + 0.044715f * x * x * x);
    const float t = 1.f - 2.f * __builtin_amdgcn_rcpf(1.f + __builtin_amdgcn_exp2f(2.f * LOG2E * y));
    return 0.5f * x * (1.f + t);
}
__device__ __forceinline__ float dot8(v4u a, v4u b, float acc) {
#pragma unroll
    for (int i = 0; i < 4; ++i) { acc += bf_lo(a[i]) * bf_lo(b[i]); acc += bf_hi(a[i]) * bf_hi(b[i]); }
    return acc;
}
typedef float f32x2 __attribute__((ext_vector_type(2)));
template <int MODE = 0> __device__ __forceinline__ void peer_phase(LAS unsigned char* wl, const bf16* H2, const unsigned char* Uq, const unsigned char* Vq, const unsigned short* IDX, const float* GATE, const float* RSS, const float* g2, float* XO, const float* gf, int gw, int NGW, int lane, unsigned emask = 0xffffu, unsigned eor = 0u, float* ACTg = nullptr) {
    LAS unsigned* lid = (LAS unsigned*)wl; LAS float* la = (LAS float*)(wl + 512);
    float g2v[16];
#pragma unroll
    for (int i = 0; i < 16; ++i) g2v[i] = g2[16 * lane + i];
    for (int tok = gw; tok < M; tok += NGW) {
        const float rs_u = (1.f / U_SCALE) / sqrtf(RSS[tok] * (1.f / D) + EPS);
        float h[16], x1v[16];
        { const v4u hA = *(const v4u*)(H2 + (size_t)tok * D + 16 * lane), hB = *(const v4u*)(H2 + (size_t)tok * D + 16 * lane + 8);
#pragma unroll
          for (int i = 0; i < 4; ++i) { x1v[2 * i] = bf_lo(hA[i]); x1v[2 * i + 1] = bf_hi(hA[i]); x1v[8 + 2 * i] = bf_lo(hB[i]); x1v[8 + 2 * i + 1] = bf_hi(hB[i]); }
#pragma unroll
          for (int i = 0; i < 16; ++i) h[i] = x1v[i] * g2v[i]; }
        lid[lane] = (IDX[(size_t)tok * NSEL + lane] & emask) | eor; lid[64 + lane] = (IDX[(size_t)tok * NSEL + 64 + lane] & emask) | eor;
#pragma unroll 1
        for (int b = 0; b < ((MODE == 1 || MODE == 4) ? 0 : 8); ++b) {
            const float gate = GATE[(size_t)tok * NSEL + 16 * b + ((lane >> 2) & 15)];
            float p[16];
#pragma unroll
            for (int e = 0; e < 16; ++e) {
                const unsigned eid = (unsigned)__builtin_amdgcn_readfirstlane((int)lid[16 * b + e]);
                const v4u w = *(const v4u*)(Uq + (size_t)eid * D + 16 * lane);
                float s = 0.f;
#pragma unroll
                for (int j = 0; j < 4; ++j) { const f32x2 lo = __builtin_amdgcn_cvt_pk_f32_fp8((int)w[j], false), hi2 = __builtin_amdgcn_cvt_pk_f32_fp8((int)w[j], true);
                    s += lo.x * h[4 * j] + lo.y * h[4 * j + 1] + hi2.x * h[4 * j + 2] + hi2.y * h[4 * j + 3]; }
                p[e] = s;
            }
#pragma unroll
            for (int st = 0; st < 4; ++st) { const int msk = 32 >> st, n = 8 >> st; const bool up = (lane & msk) != 0;
#pragma unroll
                for (int i = 0; i < n; ++i) { const float mine = up ? p[i + n] : p[i], theirs = up ? p[i] : p[i + n]; p[i] = mine + __shfl_xor(theirs, msk); } }
            float d = p[0]; d += __shfl_xor(d, 1); d += __shfl_xor(d, 2);
            if ((lane & 3) == 0) la[16 * b + ((lane >> 2) & 15)] = gelu_tanh(d * rs_u) * gate * (1.f / V_SCALE);
        }
        if (MODE == 3) { ACTg[(size_t)tok * NSEL + lane] = la[lane]; ACTg[(size_t)tok * NSEL + 64 + lane] = la[64 + lane]; continue; }
        if (MODE == 4) { la[lane] = ACTg[(size_t)tok * NSEL + lane]; la[64 + lane] = ACTg[(size_t)tok * NSEL + 64 + lane]; }
        float o[16];
#pragma unroll
        for (int i = 0; i < 16; ++i) o[i] = 0.f;
#pragma unroll 1
        for (int b = 0; b < (MODE == 2 ? 0 : 16); ++b) {
#pragma unroll
            for (int e = 0; e < 8; ++e) {
                const unsigned eid = (unsigned)__builtin_amdgcn_readfirstlane((int)lid[8 * b + e]);
                const float a = la[8 * b + e];
                const v4u w = *(const v4u*)(Vq + (size_t)eid * D + 16 * lane);
#pragma unroll
                for (int j = 0; j < 4; ++j) { const f32x2 lo = __builtin_amdgcn_cvt_pk_f32_fp8((int)w[j], false), hi2 = __builtin_amdgcn_cvt_pk_f32_fp8((int)w[j], true);
                    o[4 * j] += a * lo.x; o[4 * j + 1] += a * lo.y; o[4 * j + 2] += a * hi2.x; o[4 * j + 3] += a * hi2.y; }
            }
        }
        float* xr = XO + (size_t)tok * D + 16 * lane; const float* gp = gf + 16 * lane;
        f32x4 xv[4]; float s = 0.f;
#pragma unroll
        for (int j = 0; j < 4; ++j) { xv[j] = (f32x4){x1v[4 * j], x1v[4 * j + 1], x1v[4 * j + 2], x1v[4 * j + 3]} + (f32x4){o[4 * j], o[4 * j + 1], o[4 * j + 2], o[4 * j + 3]}; s += (xv[j].x * xv[j].x + xv[j].y * xv[j].y) + (xv[j].z * xv[j].z + xv[j].w * xv[j].w); }
        const float rstd = 1.0f / sqrtf(wave_sum(s) * (1.f / D) + EPS);
#pragma unroll
        for (int j = 0; j < 4; ++j) *(f32x4*)(xr + 4 * j) = xv[j] * rstd * *(const f32x4*)(gp + 4 * j);
    }
}

template <int UVAR = 0> __device__ __forceinline__ void peer_u_phase(const unsigned char* Uq, const bf16* X1b, const float* g2, const unsigned short* IDX, bf16* PART, LAS unsigned char* wl, LAS unsigned char* obuf, int x, int wrank, int nwv, int lane) {
    const int ip = lane >> 3, jd = lane & 7;
    const unsigned char* usl = Uq + (size_t)x * ((size_t)NEXP * 128); const unsigned voff0 = 16u * (unsigned)jd;
    const int tpw = (M + nwv - 1) / nwv, tbeg = wrank * tpw, tend = (tbeg + tpw < M) ? tbeg + tpw : M;
    if (tbeg >= tend || (UVAR & 8)) return;
    LAS float* ob = (LAS float*)obuf;
    (void)g2;
#define PU_STAGE(t0) do { const int t0_ = (t0); v4u si_[4], sx_[4]; \
        _Pragma("unroll") for (int j_ = 0; j_ < 4; ++j_) { si_[j_] = *(const v4u*)((const unsigned char*)IDX + (size_t)t0_ * 256 + 1024 * j_ + 16 * lane); \
            const int ta_ = (t0_ + 4 * j_ + (lane >> 4) < M) ? t0_ + 4 * j_ + (lane >> 4) : M - 1; sx_[j_] = *(const v4u*)(X1b + (size_t)ta_ * D + 128 * x + 8 * (lane & 15)); } \
        _Pragma("unroll") for (int j_ = 0; j_ < 4; ++j_) { *(LAS v4u*)(wl + 1024 * j_ + 16 * lane) = si_[j_]; \
              \
            float hf_[8]; _Pragma("unroll") for (int i_ = 0; i_ < 4; ++i_) { hf_[2 * i_] = bf_lo(sx_[j_][i_]); hf_[2 * i_ + 1] = bf_hi(sx_[j_][i_]); } \
            float am_ = fmaxf(fmaxf(fmaxf(fabsf(hf_[0]), fabsf(hf_[1])), fmaxf(fabsf(hf_[2]), fabsf(hf_[3]))), fmaxf(fmaxf(fabsf(hf_[4]), fabsf(hf_[5])), fmaxf(fabsf(hf_[6]), fabsf(hf_[7])))); \
            _Pragma("unroll") for (int m_ = 1; m_ < 16; m_ <<= 1) am_ = fmaxf(am_, __shfl_xor(am_, m_)); \
            am_ = fmaxf(am_, 1e-20f); const float qs_ = 127.f / am_; \
            int q_[8]; _Pragma("unroll") for (int i_ = 0; i_ < 8; ++i_) q_[i_] = (int)__builtin_rintf(hf_[i_] * qs_); \
            const unsigned w0_ = (unsigned)((q_[0] & 0xff) | ((q_[1] & 0xff) << 8) | ((q_[2] & 0xff) << 16) | (q_[3] << 24)), w1_ = (unsigned)((q_[4] & 0xff) | ((q_[5] & 0xff) << 8) | ((q_[6] & 0xff) << 16) | (q_[7] << 24)); \
            *(LAS u32x2*)(wl + 4096 + (4 * j_ + (lane >> 4)) * 128 + 8 * (lane & 15)) = (u32x2){w0_, w1_}; \
            *(LAS float*)(wl + 6144 + 4 * (4 * j_ + (lane >> 4))) = am_ * (1.f / 127.f); } } while (0)
#define PU_EID(i0, i1, ld) (((ld) < 8) ? (((ld) & 1) ? (i0[((ld) & 7) >> 1] >> 16) : (i0[((ld) & 7) >> 1] & 0xffffu)) : (((ld) & 1) ? (i1[((ld) & 7) >> 1] >> 16) : (i1[((ld) & 7) >> 1] & 0xffffu)))
#define PU_ROWS(sl, wv) do { const v4u i0_ = *(const LAS v4u*)(wl + (sl) * 256 + 32 * ip), i1_ = *(const LAS v4u*)(wl + (sl) * 256 + 32 * ip + 16); \
        _Pragma("unroll") for (int ld = 0; ld < 16; ++ld) wv[ld] = *(const v4u*)(usl + (PU_EID(i0_, i1_, ld) * 128u + voff0)); \
        __builtin_amdgcn_sched_barrier(0); } while (0)
#define PU_COMPUTE(wv, sl) do { \
        const v4u hq_ = *(const LAS v4u*)(wl + 4096 + (sl) * 128 + 16 * jd); const float hs_ = *(const LAS float*)(wl + 6144 + 4 * (sl)); \
        int p[16]; \
        _Pragma("unroll") for (int ld = 0; ld < 16; ++ld) { const v4u w = wv[ld]; int a_ = 0; \
            _Pragma("unroll") for (int j = 0; j < 4; ++j) a_ = __builtin_amdgcn_sdot4((int)w[j], (int)hq_[j], a_, false); \
            p[ld] = a_; } \
          \
        _Pragma("unroll") for (int st = 0; st < 3; ++st) { const int msk = 4 >> st, n = 8 >> st; const bool up = (lane & msk) != 0; \
            _Pragma("unroll") for (int j = 0; j < n; ++j) { int a_ = p[j], b_ = p[j + n]; asm volatile("" : "+v"(a_), "+v"(b_)); const int mine = up ? b_ : a_, theirs = up ? a_ : b_; p[j] = mine + __shfl_xor(theirs, msk); } } \
        *(LAS f32x2*)(ob + (sl) * 128 + 16 * ip + 8 * ((jd >> 2) & 1) + 4 * ((jd >> 1) & 1) + 2 * (jd & 1)) = (f32x2){(float)p[0] * hs_, (float)p[1] * hs_}; \
        __builtin_amdgcn_sched_barrier(0); \
    } while (0)
    for (int t0 = tbeg; t0 < tend; t0 += 16) {
        const int nb = (tend - t0 < 16) ? tend - t0 : 16;
        PU_STAGE(t0);
        v4u wA[16], wB[16];
        PU_ROWS(0, wA);
        if (nb == 16) {
#pragma unroll
            for (int s = 0; s < 16; s += 2) {
                PU_ROWS(s + 1, wB);
                PU_COMPUTE(wA, s);
                if (s + 2 < 16) PU_ROWS(s + 2, wA);
                PU_COMPUTE(wB, s + 1);
            }
        } else {
#pragma unroll 1
            for (int s = 0; s < nb; ++s) { PU_ROWS(s, wA); PU_COMPUTE(wA, s); }
        }
        { bf16* dst_ = PART + ((size_t)x * M + t0) * NSEL; const int n8_ = nb * 16;
#pragma unroll
          for (int j = 0; j < 4; ++j) { const int c_ = j * 64 + lane; if (c_ < n8_) { const f32x4 a_ = *(const LAS f32x4*)(ob + 8 * c_), b_ = *(const LAS f32x4*)(ob + 8 * c_ + 4);
              *(v4u*)(dst_ + 8 * c_) = (v4u){pk2(a_.x, a_.y), pk2(a_.z, a_.w), pk2(b_.x, b_.y), pk2(b_.z, b_.w)}; } } }
    }
#undef PU_STAGE
#undef PU_EID
#undef PU_ROWS
#undef PU_COMPUTE
}
__device__ __forceinline__ void peer_c_phase(const bf16* PART, const float* GATE, const float* RSS, bf16* ACT, int gtid, int ngt) {
    constexpr int NIT = M * (NSEL / 8);
    for (int it0 = gtid; it0 < NIT; it0 += 2 * ngt) {
        v4u pv[2][8]; f32x4 g0[2], g1[2]; float rss[2];
#pragma unroll
        for (int u = 0; u < 2; ++u) { const int it = (it0 + u * ngt < NIT) ? it0 + u * ngt : it0, tok = it >> 4, k8 = (it & 15) * 8;
#pragma unroll
            for (int xx = 0; xx < 8; ++xx) pv[u][xx] = *(const v4u*)(PART + ((size_t)xx * M + tok) * NSEL + k8);
            g0[u] = *(const f32x4*)(GATE + (size_t)tok * NSEL + k8); g1[u] = *(const f32x4*)(GATE + (size_t)tok * NSEL + k8 + 4); rss[u] = RSS[tok]; }
#pragma unroll
        for (int u = 0; u < 2; ++u) { const int it = (it0 + u * ngt < NIT) ? it0 + u * ngt : it0, tok = it >> 4, k8 = (it & 15) * 8;
            const float rs = (1.f / U_SCALE) / sqrtf(rss[u] * (1.f / D) + EPS);
            float s[8];
#pragma unroll
            for (int i = 0; i < 8; ++i) s[i] = 0.f;
#pragma unroll
            for (int xx = 0; xx < 8; ++xx)
#pragma unroll
                for (int i = 0; i < 4; ++i) { s[2 * i] += bf_lo(pv[u][xx][i]); s[2 * i + 1] += bf_hi(pv[u][xx][i]); }
            float o[8];
#pragma unroll
            for (int i = 0; i < 4; ++i) { o[i] = fminf(gelu_tanh(s[i] * rs) * g0[u][i] * A_SCALE, 440.f); o[4 + i] = fminf(gelu_tanh(s[4 + i] * rs) * g1[u][i] * A_SCALE, 440.f); }
            int w0 = __builtin_amdgcn_cvt_pk_fp8_f32(o[0], o[1], 0, false); w0 = __builtin_amdgcn_cvt_pk_fp8_f32(o[2], o[3], w0, true);
            int w1 = __builtin_amdgcn_cvt_pk_fp8_f32(o[4], o[5], 0, false); w1 = __builtin_amdgcn_cvt_pk_fp8_f32(o[6], o[7], w1, true);
            *(u32x2*)((unsigned char*)ACT + (size_t)tok * NSEL + k8) = (u32x2){(unsigned)w0, (unsigned)w1}; }
    }
}
__device__ __forceinline__ void peer_v_phase(const unsigned char* Vq, const unsigned short* IDX, const bf16* ACT, bf16* PO, LAS unsigned char* wl, LAS unsigned char* obuf, int x, int wrank, int nwv, int lane) {
    const int ip = lane >> 3, jd = lane & 7;
    const unsigned char* vsl = Vq + (size_t)x * ((size_t)NEXP * 128); const unsigned voff0 = 16u * (unsigned)jd;
    const int tpw = (M + nwv - 1) / nwv, tbeg = wrank * tpw, tend = (tbeg + tpw < M) ? tbeg + tpw : M;
    if (tbeg >= tend) return;
    LAS float* ob = (LAS float*)obuf;
#define PV_STAGE(t0) do { const int t0_ = (t0); \
        const v4u s0_ = *(const v4u*)((const unsigned char*)IDX + (size_t)t0_ * 256 + 16 * lane), s1_ = *(const v4u*)((const unsigned char*)IDX + (size_t)t0_ * 256 + 1024 + 16 * lane); \
        const v4u s2a_ = *(const v4u*)((const unsigned char*)IDX + (size_t)t0_ * 256 + 2048 + 16 * lane), s3a_ = *(const v4u*)((const unsigned char*)IDX + (size_t)t0_ * 256 + 3072 + 16 * lane); \
        const v4u a0_ = *(const v4u*)((const unsigned char*)ACT + (size_t)t0_ * 128 + 16 * lane), a1_ = *(const v4u*)((const unsigned char*)ACT + (size_t)t0_ * 128 + 1024 + 16 * lane); \
        *(LAS v4u*)(wl + 16 * lane) = s0_; *(LAS v4u*)(wl + 1024 + 16 * lane) = s1_; *(LAS v4u*)(wl + 2048 + 16 * lane) = s2a_; *(LAS v4u*)(wl + 3072 + 16 * lane) = s3a_; \
        *(LAS v4u*)(wl + 4096 + 16 * lane) = a0_; *(LAS v4u*)(wl + 5120 + 16 * lane) = a1_; } while (0)
#define PV_EID(i0, i1, ld) (((ld) < 8) ? (((ld) & 1) ? (i0[((ld) & 7) >> 1] >> 16) : (i0[((ld) & 7) >> 1] & 0xffffu)) : (((ld) & 1) ? (i1[((ld) & 7) >> 1] >> 16) : (i1[((ld) & 7) >> 1] & 0xffffu)))
#define PV_ROWS(sl, wv) do { const v4u i0_ = *(const LAS v4u*)(wl + (sl) * 256 + 32 * ip), i1_ = *(const LAS v4u*)(wl + (sl) * 256 + 32 * ip + 16); \
        _Pragma("unroll") for (int ld = 0; ld < 16; ++ld) wv[ld] = *(const v4u*)(vsl + (PV_EID(i0_, i1_, ld) * 128u + voff0)); \
        __builtin_amdgcn_sched_barrier(0); } while (0)
#define PV_COMPUTE(wv, sl) do { \
          \
        const v4u ab_ = *(const LAS v4u*)(wl + 4096 + (sl) * 128 + 16 * ip); \
        f32x4 c1_ = (f32x4){0.f, 0.f, 0.f, 0.f}, c2_ = (f32x4){0.f, 0.f, 0.f, 0.f}; \
        _Pragma("unroll") for (int ld = 0; ld < 16; ++ld) { const unsigned sft_ = ((ab_[ld >> 2] >> (8 * (ld & 3))) & 0xffu) << sh8; \
            const unsigned alo_ = jhi ? 0u : sft_, ahi_ = jhi ? sft_ : 0u; \
            const long A_ = (long)(((unsigned long long)ahi_ << 32) | alo_); const v4u w = wv[ld]; \
            c1_ = __builtin_amdgcn_mfma_f32_16x16x32_fp8_fp8(A_, (long)(((unsigned long long)w.y << 32) | w.x), c1_, 0, 0, 0); \
            c2_ = __builtin_amdgcn_mfma_f32_16x16x32_fp8_fp8(A_, (long)(((unsigned long long)w.w << 32) | w.z), c2_, 0, 0, 0); } \
        float r_[8] = {c1_[0], c1_[1], c1_[2], c1_[3], c2_[0], c2_[1], c2_[2], c2_[3]}; \
        _Pragma("unroll") for (int i = 0; i < 8; ++i) r_[i] = (r_[i] + __shfl(r_[i], plane)) * (1.f / (A_SCALE * V_SCALE)); \
        { LAS unsigned char* op_ = obase + (sl) * ostride; *(LAS f32x4*)op_ = (f32x4){r_[0], r_[1], r_[2], r_[3]}; *(LAS f32x4*)(op_ + 32) = (f32x4){r_[4], r_[5], r_[6], r_[7]}; } \
        __builtin_amdgcn_sched_barrier(0); \
    } while (0)
    const unsigned sh8 = 8u * (unsigned)(jd & 3); const bool jhi = (jd & 4) != 0; const int plane = (lane + 40) & 63;
    const bool ovalid = ((lane & 15) < 8) && (lane < 32);
    LAS unsigned char* obase = ovalid ? obuf + 4 * (16 * (lane & 15) + 4 * (lane >> 4)) : wl + 6144 + 16 * lane; const int ostride = ovalid ? 512 : 0;
    for (int t0 = tbeg; t0 < tend; t0 += 16) {
        const int nb = (tend - t0 < 16) ? tend - t0 : 16;
        PV_STAGE(t0);
        v4u wA[16], wB[16];
        PV_ROWS(0, wA);
        if (nb == 16) {
#pragma unroll
            for (int s = 0; s < 16; s += 2) {
                PV_ROWS(s + 1, wB);
                PV_COMPUTE(wA, s);
                if (s + 2 < 16) PV_ROWS(s + 2, wA);
                PV_COMPUTE(wB, s + 1);
            }
        } else {
#pragma unroll 1
            for (int s = 0; s < nb; ++s) { PV_ROWS(s, wA); PV_COMPUTE(wA, s); }
        }
        { bf16* dst_ = PO + ((size_t)x * M + t0) * 128; const int n8_ = nb * 16;
#pragma unroll
          for (int j = 0; j < 4; ++j) { const int c_ = j * 64 + lane; if (c_ < n8_) { const f32x4 a_ = *(const LAS f32x4*)(ob + 8 * c_), b_ = *(const LAS f32x4*)(ob + 8 * c_ + 4);
              *(v4u*)(dst_ + 8 * c_) = (v4u){pk2(a_.x, a_.y), pk2(a_.z, a_.w), pk2(b_.x, b_.y), pk2(b_.z, b_.w)}; } } }
    }
#undef PV_STAGE
#undef PV_EID
#undef PV_ROWS
#undef PV_COMPUTE
}
__device__ __forceinline__ void peer_f_phase(const bf16* X1b, const bf16* PO, float* XO, const float* gf, int gw, int NGW, int lane) {
    const GAS f32x4* gp = (const GAS f32x4*)gf + lane; f32x4 gv[4];
#pragma unroll
    for (int j = 0; j < 4; ++j) gv[j] = gp[64 * j];
    for (int m = gw; m < M; m += NGW) {
        GAS f32x4* xr = (GAS f32x4*)(XO + (size_t)m * D) + lane;
        f32x4 v[4]; float s = 0.f;
#pragma unroll
        for (int j = 0; j < 4; ++j) { const int dd = 4 * lane + 256 * j; const u32x2 xb = *(const u32x2*)(X1b + (size_t)m * D + dd);
            const u32x2 pb = *(const u32x2*)(PO + ((size_t)(dd >> 7) * M + m) * 128 + (dd & 127));
            v[j] = (f32x4){bf_lo(xb.x), bf_hi(xb.x), bf_lo(xb.y), bf_hi(xb.y)} + (f32x4){bf_lo(pb.x), bf_hi(pb.x), bf_lo(pb.y), bf_hi(pb.y)};
            s += (v[j].x * v[j].x + v[j].y * v[j].y) + (v[j].z * v[j].z + v[j].w * v[j].w); }
        const float rstd = 1.0f / sqrtf(wave_sum(s) * (1.f / D) + EPS);
#pragma unroll
        for (int j = 0; j < 4; ++j) xr[64 * j] = v[j] * rstd * gv[j];
    }
}

#ifndef PEER_SPLIT
#define PEER_SPLIT 0
#endif
constexpr int N_PHASES = PEER_SLICED ? 12 : (PEER_SPLIT ? 10 : 9);
#ifndef MK_FUSED
#define MK_FUSED 1
#endif
struct Args { const float* in[18]; float* out; unsigned char* ws; int ph_lo, ph_hi; };
__global__ void __launch_bounds__(NWAVES * 64, 2) hyb_fwd(Args args) {
    extern __shared__ __attribute__((aligned(16))) unsigned char lds[];
    LAS unsigned char* L = (LAS unsigned char*)lds;
    volatile LAS unsigned* MISC = (volatile LAS unsigned*)(L + MISC_OFF);
    const int tid = threadIdx.x, lane = tid & 63, wave = __builtin_amdgcn_readfirstlane(tid >> 6);
    const int G = gridDim.x; const int bx = blockIdx.x; const int vcu = (G % 8 == 0) ? (bx % 8) * (G / 8) + bx / 8 : bx;
    const int gw = vcu * NWAVES + wave, NGW = G * NWAVES;
    unsigned char* ws = args.ws;
    gu32* ctl = (gu32*)(ws + WS_CTL);
    const float* x = args.in[0]; float* out = args.out;
    bf16 *WIN = (bf16*)(ws + WS_WIN), *WC = (bf16*)(ws + WS_WC), *WF = (bf16*)(ws + WS_WF), *WO = (bf16*)(ws + WS_WO), *WQ = (bf16*)(ws + WS_WQ);
    bf16 *K1b = (bf16*)(ws + WS_K1), *K2b = (bf16*)(ws + WS_K2); unsigned char *Uq = ws + WS_U, *Vq = ws + WS_VT;
    bf16 *XN = (bf16*)(ws + WS_XN), *CZ = XN, *GLU = (bf16*)(ws + WS_GLU), *MM = GLU, *QO = (bf16*)(ws + WS_QO), *KB = (bf16*)(ws + WS_K), *H2 = KB, *VB = (bf16*)(ws + WS_V);
    bf16 *QP = (bf16*)(ws + WS_QP), *GA = (bf16*)out, *GB = (bf16*)out + (size_t)M * D;
    float *LOGF = (float*)(ws + WS_LOGF), *C2 = (float*)(ws + WS_C2), *GATE = (float*)(ws + WS_GATE);
    unsigned short* IDX = (unsigned short*)(ws + WS_IDX);
    for (int u = tid; u < (LDS_BYTES - LDSCTL_OFF) / 4; u += NWAVES * 64) ((LAS unsigned*)(L + LDSCTL_OFF))[u] = 0u;
    __syncthreads();
#if MK_FUSED
    XcdBarrier bar = xcd_barrier_post((unsigned*)(ctl + CW_BAR), MISC + 8);
#define GRID_BAR() xcd_barrier(bar)
#else
#define GRID_BAR() do {} while (0)
    (void)MISC; (void)ctl;
#endif
    const int lo = args.ph_lo, hi = args.ph_hi;
#ifdef ONLY_PHASE
#define IN(k) ((k) == ONLY_PHASE)
#else
#define IN(k) (lo <= (k) && (k) < hi)
#endif
#define BOTH(k) (IN(k) && IN((k) + 1))
#ifdef REP_PHASE
#define REPS(k) for (int rep_ = ((k) == REP_PHASE) ? 0 : 1; rep_ < 2; ++rep_)
#define REP_BAR() do { if (rep_ == 0) GRID_BAR(); } while (0)
#else
#define REPS(k)
#define REP_BAR() do {} while (0)
constexpr int rep_ = 1;
#endif
#ifndef P0_PARTS
#define P0_PARTS 7
#endif
#ifndef REP_EMASK
#define REP_EMASK 0xffffu
#define REP_ESTRIDE 0u
#endif

    if (IN(0)) REPS(0) {
        P0Args a{args.in[11], x, args.in[1], args.in[2], args.in[7], args.in[9], args.in[10], args.in[12], args.in[13], args.in[14], args.in[15], args.in[16], args.in[8],
                 WIN, WC, WF, WO, WQ, K1b, K2b, Uq, Vq, XN, LOGF};
        p0_prologue(L, a, vcu, G, tid, rep_ ? 7 : P0_PARTS); REP_BAR();
        if (rep_ && BOTH(0)) GRID_BAR();
    }
    if (IN(1)) REPS(1) {
        pg8::Gemm g{XN, XN, WIN, WIN, M, N1, D}; pg8::StaticOrder S; S.init(M, N1, G, bx);
        pg8::EpiP1 E{GLU, QO, KB, VB, GA, GB, attn_body::C2, (unsigned*)(ctl + CW_STAT)};
        pg8::gemm_phase<pg8::EpiP1, pg8::StaticOrder, true, true>(L + RING_OFF, g, S, E); REP_BAR();
        if (rep_ && BOTH(1)) GRID_BAR();
    }
    if (IN(2)) REPS(2) {
        for (int bh = vcu; bh < BATCH * NHEADS; bh += G) scan_unit(L, LOGF, C2, bh, tid);
        conv_phase(L, GLU, args.in[3], args.in[4], args.in[5], args.in[6], CZ, vcu, G, tid); REP_BAR();
        if (rep_ && BOTH(2)) GRID_BAR();
    }
    if (IN(3)) REPS(3) {
        const attn_body::AttnTensors AT{(const attn_body::bf16*)QO, (const attn_body::bf16*)KB, (const attn_body::bf16*)VB, (attn_body::bf16*)(rep_ ? QO : GLU), C2};
#if MK_FUSED
        attn_body::attn_phase_queue<8>((char*)lds + RING_OFF, AT, (unsigned*)(ctl + CW_ATTQ) + (rep_ ? 0 : 64), (const float*)(ctl + CW_STAT), LDSCTL_OFF + 64); REP_BAR();
#else
        const attn_body::StaticOrder S(G, bx);
        attn_body::attn_phase<attn_body::StaticOrder>((char*)lds + RING_OFF, AT, S); REP_BAR();
#endif
        if (rep_ && BOTH(3)) GRID_BAR();
    }
    if (IN(4)) REPS(4) {
        pg8::Gemm g{CZ, QO, WC, WF, M, D, D}; pg8::DualOrder S; S.init(M, D, G, bx);
        pg8::EpiDual E{GA, GB, MM};
        pg8::gemm_phase<pg8::EpiDual, pg8::DualOrder, true, true>(L + RING_OFF, g, S, E); REP_BAR();
        if (rep_ && BOTH(4)) GRID_BAR();
    }
    if (IN(5)) REPS(5) {
        pg8::Gemm g{MM, MM, WO, WO, M, D, D}; pg8::StaticOrder S; S.init(M, D, G, bx);
        pg8::EpiResNorm E{x, H2, (float*)(ctl + CW_RSS), args.in[11], nullptr, nullptr};
        pg8::gemm_phase<pg8::EpiResNorm, pg8::StaticOrder, true, true>(L + RING_OFF, g, S, E); REP_BAR();
        if (rep_ && BOTH(5)) GRID_BAR();
    }
    if (IN(6)) REPS(6) {
        pg8::Gemm g{H2, H2, WQ, WQ, M, NQP, D}; pg8::StaticOrder S; S.init(M, NQP, G, bx);
        pg8::EpiScaleRow E{QP, NQP, (const float*)(ctl + CW_RSS)};
        pg8::gemm_phase<pg8::EpiScaleRow, pg8::StaticOrder, true, true>(L + RING_OFF, g, S, E); REP_BAR();
        if (rep_ && BOTH(6)) GRID_BAR();
    }
    if (IN(7)) REPS(7) {
        const int head = bx & 7, nwg_h = (G - head + 7) >> 3;
        for (int ci = tid; ci < 4096; ci += NWAVES * 64) { const int half = ci >> 11, row = (ci >> 4) & 127, c16 = ci & 15;
            *(LAS v4u*)(L + RK_OFF + half * RK_HALFB + row * RK_ROWB + c16 * 16) = *(const v4u*)((half ? K2b : K1b) + (size_t)(head * PNK + row) * 128 + c16 * 8); }
        __syncthreads();
        for (int tg = (bx >> 3) * NWAVES + wave; tg < M / 32; tg += nwg_h * NWAVES) route_unit(L + wave * 1024, L + RK_OFF, QP, IDX, GATE, tg * 32, head, lane);
        __syncthreads(); REP_BAR();
        if (rep_ && BOTH(7)) GRID_BAR();
    }
#if PEER_SLICED
    {
        const int xs = bx & 7, nwg_x = (G - xs + 7) >> 3, wrank = (bx >> 3) * NWAVES + wave, nwv = nwg_x * NWAVES;
        bf16 *PART = (bf16*)(ws + WS_PART), *PO = (bf16*)(ws + WS_PART), *ACT = (bf16*)(ws + WS_ACT);
        if (IN(8)) REPS(8) {
#ifdef PROBE_UVAR
            if (!rep_) { peer_u_phase<PROBE_UVAR>(Uq, H2, args.in[11], IDX, PART, L + wave * 8192, L + 65536 + wave * 8192, xs, wrank, nwv, lane); REP_BAR(); continue; }
#endif
            peer_u_phase(Uq, H2, args.in[11], IDX, PART, L + wave * 8192, L + 65536 + wave * 8192, xs, wrank, nwv, lane); REP_BAR(); if (rep_ && BOTH(8)) GRID_BAR(); }
        if (IN(9)) REPS(9) { peer_c_phase(PART, GATE, (const float*)(ctl + CW_RSS), ACT, gw * 64 + lane, NGW * 64); REP_BAR(); if (rep_ && BOTH(9)) GRID_BAR(); }
        if (IN(10)) REPS(10) { peer_v_phase(Vq, IDX, ACT, PO, L + wave * 8192, L + 65536 + wave * 8192, xs, wrank, nwv, lane); REP_BAR(); if (rep_ && BOTH(10)) GRID_BAR(); }
        if (IN(11)) REPS(11) { peer_f_phase(H2, PO, out, args.in[17], gw, NGW, lane); REP_BAR(); }
    }
#elif PEER_SPLIT
    if (IN(8)) { peer_phase<3>(L + wave * 1024, H2, Uq, Vq, IDX, GATE, (const float*)(ctl + CW_RSS), args.in[11], out, args.in[17], gw, NGW, lane, 0xffffu, 0u, (float*)(ws + WS_ACT)); if (BOTH(8)) GRID_BAR(); }
    if (IN(9)) peer_phase<4>(L + wave * 1024, H2, Uq, Vq, IDX, GATE, (const float*)(ctl + CW_RSS), args.in[11], out, args.in[17], gw, NGW, lane, 0xffffu, 0u, (float*)(ws + WS_ACT));
#else
    if (IN(8)) REPS(8) {
#ifdef PROBE_MODE
        if (!rep_) { peer_phase<PROBE_MODE>(L + wave * 1024, H2, Uq, Vq, IDX, GATE, (const float*)(ctl + CW_RSS), args.in[11], (float*)QP, args.in[17], gw, NGW, lane, REP_EMASK, (unsigned)(bx & 7) * REP_ESTRIDE); REP_BAR(); continue; }
#endif
        peer_phase(L + wave * 1024, H2, Uq, Vq, IDX, GATE, (const float*)(ctl + CW_RSS), args.in[11], rep_ ? out : (float*)QP, args.in[17], gw, NGW, lane, rep_ ? 0xffffu : REP_EMASK, rep_ ? 0u : (unsigned)(bx & 7) * REP_ESTRIDE); REP_BAR(); }
#endif
#undef IN
#undef BOTH
}

extern "C" void kernel_launch(void* const* d_in, const int* in_sizes, int n_in, void* d_out, int out_size, void* d_ws, size_t ws_size, hipStream_t stream) {
    static int grid = 0;
    if (grid == 0) {
        if (n_in != 18 || in_sizes[0] != M * D || out_size != M * D || ws_size < WS_END) { fprintf(stderr, "kernel_launch: unexpected shapes (n_in %d, ws %zu)\n", n_in, ws_size); grid = -1; return; }
        int dev = 0, cus = 0, per_cu = 0;
        if (hipGetDevice(&dev) != hipSuccess || hipDeviceGetAttribute(&cus, hipDeviceAttributeMultiprocessorCount, dev) != hipSuccess) { grid = -1; return; }
        if (hipFuncSetAttribute((const void*)hyb_fwd, hipFuncAttributeMaxDynamicSharedMemorySize, LDS_BYTES) != hipSuccess) { fprintf(stderr, "kernel_launch: hipFuncSetAttribute failed\n"); grid = -1; return; }
        if (hipOccupancyMaxActiveBlocksPerMultiprocessor(&per_cu, (const void*)hyb_fwd, NWAVES * 64, LDS_BYTES) != hipSuccess || per_cu < 1) { fprintf(stderr, "kernel_launch: occupancy query says %d\n", per_cu); per_cu = 1; }
        (void)hipGetLastError();
        grid = cus;
    }
    if (grid < 0) return;
    Args a{};
    for (int i = 0; i < 18; ++i) a.in[i] = (const float*)d_in[i];
    a.out = (float*)d_out; a.ws = (unsigned char*)d_ws;
    (void)hipMemsetAsync((char*)d_ws + WS_CTL, 0, CTL_ZERO_BYTES, stream);
#if MK_FUSED
    a.ph_lo = 0; a.ph_hi = N_PHASES;
    void* kargs[] = {&a};
    hipError_t e = hipLaunchCooperativeKernel((const void*)hyb_fwd, dim3(grid), dim3(NWAVES * 64), kargs, LDS_BYTES, stream);
    if (e != hipSuccess) fprintf(stderr, "kernel_launch: cooperative launch failed: %s\n", hipGetErrorString(e));
#else
    for (int p = 0; p < N_PHASES; ++p) { a.ph_lo = p; a.ph_hi = p + 1; hipLaunchKernelGGL(hyb_fwd, dim3(grid), dim3(NWAVES * 64), LDS_BYTES, stream, a); }
#endif
}
```

```cpp
#include <hip/hip_runtime.h>
#include <hip/hip_bf16.h>
#include <cstdio>
#include <cstdint>
#include <cmath>
namespace pg8 {
#define PG8_LAS __attribute__((address_space(3)))
typedef unsigned short bf16_t;
typedef short bf16x8 __attribute__((ext_vector_type(8)));
typedef float f32x4 __attribute__((ext_vector_type(4)));
typedef unsigned u32x4 __attribute__((ext_vector_type(4)));
constexpr int BM = 256, BK = 64, HALF = 128, HTB = HALF * BK * 2  , STAGE_BYTES = 8 * HTB, NXCD = 8, WGM = 8;

__host__ __device__ __forceinline__ int lds_byte(int r, int c) { const int st = (r >> 4) * 2 + (c >> 5), rr = r & 15, cc = c & 31, ob = rr * 64 + cc * 2; return st * 1024 + (ob ^ (((ob >> 9) & 1) << 5)); }
__host__ __device__ __forceinline__ void stage_rc(int b, int& R, int& C) { const int st = b / 1024, sb = b % 1024, swz = sb ^ (((sb >> 9) & 1) << 5); R = (st >> 1) * 16 + swz / 64; C = (st & 1) * 32 + (swz % 64) / 2; }
__host__ __device__ __forceinline__ int perm32(int rho) { const int n = rho >> 4, i = rho & 15; return 8 * (i >> 2) + 4 * n + (i & 3); }

struct Unit { int pm, pn, seg; };
struct Gemm { const bf16_t *A0, *A1, *B0, *B1; int M, N, K; };

struct StaticOrder {
    int nM, nN, nwg, G, c;
    __host__ __device__ __forceinline__ void init(int M, int N, int G_, int c_) { nM = M / BM; nN = N / BM; nwg = nM * nN; G = G_; c = c_; }
    __host__ __device__ __forceinline__ bool next(int i, Unit& u) const {
        const long L = (long)i * G + c; if (L >= nwg) return false;
        int wgid = (int)L; { const int q = nwg / NXCD, r = nwg % NXCD, xcd = wgid % NXCD, off = wgid / NXCD; wgid = (xcd < r ? xcd * (q + 1) : r * (q + 1) + (xcd - r) * q) + off; }
        const int nig = WGM * nN, gid = wgid / nig, fm = gid * WGM, gsz = (nM - fm) < WGM ? (nM - fm) : WGM;
        u.pm = fm + ((wgid % nig) % gsz); u.pn = (wgid % nig) / gsz; u.seg = 0; return true;
    }
    __device__ __forceinline__ void a_ready(const Unit&) const {}
    __device__ __forceinline__ void done(const Unit&) const {}
};

__device__ __forceinline__ unsigned cvt_pk_bf16(float lo, float hi) { unsigned r; asm volatile("v_cvt_pk_bf16_f32 %0, %1, %2" : "=v"(r) : "v"(lo), "v"(hi)); return r; }
typedef float f32x2 __attribute__((ext_vector_type(2)));
__device__ __forceinline__ f32x2 gelu_pk(f32x2 v) {
    const f32x2 av = __builtin_elementwise_abs(v), d = av * 0.2316418882f + 1.0f;
    f32x2 t; t.x = __builtin_amdgcn_rcpf(d.x); t.y = __builtin_amdgcn_rcpf(d.y);
    f32x2 q = t * 0.5307027145f + (-0.7265760135f); q = q * t + 0.7107068705f; q = q * t + (-0.142248368f); q = q * t + 0.127414796f; q = q * t;
    const f32x2 s = (v * v) * (-0.72134752044f);
    f32x2 e; e.x = __builtin_amdgcn_exp2f(s.x); e.y = __builtin_amdgcn_exp2f(s.y);
    const f32x2 m = v * (q * e), r = v - m;
    f32x2 o; o.x = v.x < 0.f ? m.x : r.x; o.y = v.y < 0.f ? m.y : r.y; return o;
}

template <int ACT  > struct EpiBf16 {
    static constexpr bool PERM = true, AFTER_DRAIN = false; static_assert(ACT == 0 || ACT == 1, "EpiBf16: ACT is 0 (none) or 1 (gelu_pk)");
    bf16_t* O; int ldc; const float* bias; int split_cols; size_t split_stride; float scale0;
    __device__ __forceinline__ void operator()(const f32x4 (&acc)[2][2][4][2], const Unit& u, int wr, int wc, int fr, int fq) const {
        const int row0 = u.pm * BM + wr * 64 + fr; int colt = u.pn * BM; bf16_t* base = O;
        float sc = 1.f; if (split_cols) { const int t = colt / split_cols; base += (size_t)t * split_stride; colt -= t * split_cols; if (t == 0) sc = scale0; }
        const int col0 = colt + wc * 32 + 8 * fq, bcol0 = u.pn * BM + wc * 32 + 8 * fq;
        f32x4 bv[2][2];
#pragma unroll
        for (int bj = 0; bj < 2; ++bj)
#pragma unroll
            for (int n = 0; n < 2; ++n) bv[bj][n] = bias ? *(const f32x4*)(bias + bcol0 + bj * HALF + 4 * n) : (f32x4){0.f, 0.f, 0.f, 0.f};
#pragma unroll
        for (int ai = 0; ai < 2; ++ai)
#pragma unroll
            for (int m = 0; m < 4; ++m) { bf16_t* rowp = base + (size_t)(row0 + ai * HALF + m * 16) * ldc + col0;
#pragma unroll
                for (int bj = 0; bj < 2; ++bj) { f32x4 v0 = acc[ai][bj][m][0] + bv[bj][0], v1 = acc[ai][bj][m][1] + bv[bj][1];
                    if (ACT == 1) { f32x2 a = gelu_pk((f32x2){v0[0], v0[1]}), b = gelu_pk((f32x2){v0[2], v0[3]}), c = gelu_pk((f32x2){v1[0], v1[1]}), d = gelu_pk((f32x2){v1[2], v1[3]});
                        v0 = (f32x4){a.x, a.y, b.x, b.y}; v1 = (f32x4){c.x, c.y, d.x, d.y}; }
                    v0 = v0 * sc; v1 = v1 * sc; u32x4 w; w.x = cvt_pk_bf16(v0[0], v0[1]); w.y = cvt_pk_bf16(v0[2], v0[3]); w.z = cvt_pk_bf16(v1[0], v1[1]); w.w = cvt_pk_bf16(v1[2], v1[3]);
                    *(u32x4*)(rowp + bj * HALF) = w; } }
    }
};

struct PanelStats {
    unsigned* xbuf;
    unsigned* cnt;
    unsigned* tmo;
    int ntn; float eps;
    unsigned code;
    __device__ __forceinline__ bool run(const f32x4 (&v)[2][2][4][2], const Unit& u, int wr, int wc, int fr, int fq, PG8_LAS unsigned char* lds, int wid, int lane) const {
        typedef float f32x2v __attribute__((ext_vector_type(2)));
        PG8_LAS f32x2v* P = (PG8_LAS f32x2v*)lds;
        PG8_LAS f32x2v* S = (PG8_LAS f32x2v*)(lds + 8192);
        PG8_LAS unsigned* flag = (PG8_LAS unsigned*)(lds + 8192 + 2048);
#pragma unroll
        for (int ai = 0; ai < 2; ++ai)
#pragma unroll
            for (int m = 0; m < 4; ++m) {
                float s = 0.f;
#pragma unroll
                for (int bj = 0; bj < 2; ++bj)
#pragma unroll
                    for (int n = 0; n < 2; ++n) { const f32x4 x = v[ai][bj][m][n]; s += (x[0] + x[1]) + (x[2] + x[3]); }
                s += __shfl_xor(s, 16); s += __shfl_xor(s, 32);
                const float mw = s * (1.0f / 64.0f); float q = 0.f;
#pragma unroll
                for (int bj = 0; bj < 2; ++bj)
#pragma unroll
                    for (int n = 0; n < 2; ++n) { const f32x4 d = v[ai][bj][m][n] - mw; q += (d[0] * d[0] + d[1] * d[1]) + (d[2] * d[2] + d[3] * d[3]); }
                q += __shfl_xor(q, 16); q += __shfl_xor(q, 32);
                if (fq == 0) P[(ai * HALF + wr * 64 + m * 16 + fr) * 4 + wc] = (f32x2v){mw, q};
            }
        asm volatile("s_waitcnt lgkmcnt(0)" ::: "memory"); __builtin_amdgcn_s_barrier(); asm volatile("" ::: "memory");
#if defined(BROKEN_EXCHANGE_NO_WAIT)
#warning BROKEN CONTROL BUILD: the row-statistics exchange does not wait; results are wrong by design
        if (blockIdx.x >= 64) { const long long t0_ = clock64(); while (clock64() - t0_ < 60000) __builtin_amdgcn_s_sleep(8); }
#endif
        const int row = wid * 32 + (lane & 31);
        if (lane < 32) {
            const f32x2v a = P[row * 4 + 0], b = P[row * 4 + 1], c = P[row * 4 + 2], d = P[row * 4 + 3];
            const float mt = (a.x + b.x + c.x + d.x) * 0.25f;
            const float da = a.x - mt, db = b.x - mt, dc = c.x - mt, dd = d.x - mt;
            const float m2 = (a.y + b.y) + (c.y + d.y) + 64.0f * ((da * da + db * db) + (dc * dc + dd * dd));
            unsigned long long* slot = (unsigned long long*)xbuf + ((size_t)(u.pm * BM + row) * 4 + u.pn);
            __hip_atomic_store(slot, ((unsigned long long)__float_as_uint(m2) << 32) | __float_as_uint(mt), __ATOMIC_RELAXED, __HIP_MEMORY_SCOPE_AGENT);
        }
        asm volatile("s_waitcnt vmcnt(0)" ::: "memory");
        if (lane == 0) __hip_atomic_fetch_add(cnt + 64 * u.pm, 1u, __ATOMIC_RELAXED, __HIP_MEMORY_SCOPE_AGENT);
        if (wid == 0) {
            bool dead = false; const unsigned long long t0 = __builtin_amdgcn_s_memrealtime(); const unsigned want = 8u * (unsigned)ntn;
            for (;;) {
#if defined(BROKEN_EXCHANGE_NO_WAIT)
                break;
#endif
                if ((unsigned)__builtin_amdgcn_readfirstlane(__hip_atomic_load(cnt + 64 * u.pm, __ATOMIC_RELAXED, __HIP_MEMORY_SCOPE_AGENT)) >= want) break;
                if (__builtin_amdgcn_s_memrealtime() - t0 > 2000000ull) {
                    if (lane == 0) { unsigned expect = 0u; __hip_atomic_compare_exchange_strong(tmo + 1, &expect, code | (unsigned)(u.pm & 0xff), __ATOMIC_RELAXED, __ATOMIC_RELAXED, __HIP_MEMORY_SCOPE_AGENT);
                                     __hip_atomic_store(tmo, 1u, __ATOMIC_RELAXED, __HIP_MEMORY_SCOPE_AGENT); }
                    dead = true; break; }
                __builtin_amdgcn_s_sleep(2);
            }
            __builtin_amdgcn_fence(__ATOMIC_ACQUIRE, "agent");
            if (lane == 0) flag[0] = dead ? 1u : 0u;
        }
        asm volatile("s_waitcnt vmcnt(0) lgkmcnt(0)" ::: "memory"); __builtin_amdgcn_s_barrier(); asm volatile("" ::: "memory");
        const bool bad = flag[0] != 0u;
        if (lane < 32) {
            const unsigned long long* slot = (const unsigned long long*)xbuf + (size_t)(u.pm * BM + row) * 4; float mt[4], m2[4]; float ms = 0.f;
#pragma unroll
            for (int t = 0; t < 4; ++t) { if (t < ntn) { const unsigned long long w = __hip_atomic_load(slot + t, __ATOMIC_RELAXED, __HIP_MEMORY_SCOPE_AGENT); mt[t] = __uint_as_float((unsigned)w); m2[t] = __uint_as_float((unsigned)(w >> 32)); } else { mt[t] = 0.f; m2[t] = 0.f; } ms += mt[t]; }
            const float mean = ms / (float)ntn; float q = 0.f;
#pragma unroll
            for (int t = 0; t < 4; ++t) if (t < ntn) { const float dm = mt[t] - mean; q += m2[t] + 256.0f * dm * dm; }
            S[row] = (f32x2v){mean, 1.0f / sqrtf(q / (256.0f * (float)ntn) + eps)};
        }
        asm volatile("s_waitcnt lgkmcnt(0)" ::: "memory"); __builtin_amdgcn_s_barrier(); asm volatile("" ::: "memory");
        return bad;
    }
};
struct EpiLnRes {
    static constexpr bool PERM = false, AFTER_DRAIN = true;
    const float* base; float* out; int ldc; const float* bias; PanelStats st; unsigned poison;
    __device__ __forceinline__ void fused(f32x4 (&acc)[2][2][4][2], const Unit& u, int wr, int wc, int fr, int fq, PG8_LAS unsigned char* lds, int wid, int lane) const {
        typedef float f32x2v __attribute__((ext_vector_type(2)));
        const PG8_LAS f32x2v* S = (const PG8_LAS f32x2v*)(lds + 8192);
        const int col0 = u.pn * BM + wc * 32 + 4 * fq;
#pragma unroll
        for (int bj = 0; bj < 2; ++bj)
#pragma unroll
            for (int n = 0; n < 2; ++n) { const f32x4 bv = bias ? *(const f32x4*)(bias + col0 + bj * HALF + n * 16) : (f32x4){0.f, 0.f, 0.f, 0.f};
#pragma unroll
                for (int ai = 0; ai < 2; ++ai)
#pragma unroll
                    for (int m = 0; m < 4; ++m) acc[ai][bj][m][n] += bv; }
        f32x4 pre[4][2][2];
#pragma unroll
        for (int m = 0; m < 4; ++m) { const size_t off = (size_t)(u.pm * BM + wr * 64 + m * 16 + fr) * ldc + col0;
#pragma unroll
            for (int bj = 0; bj < 2; ++bj)
#pragma unroll
                for (int n = 0; n < 2; ++n) pre[m][bj][n] = *(const f32x4*)(base + off + bj * HALF + n * 16); }
        const bool bad = st.run(acc, u, wr, wc, fr, fq, lds, wid, lane) || poison != 0u;
        const float qnan = __builtin_nanf("");
#pragma unroll
        for (int ai = 0; ai < 2; ++ai)
#pragma unroll
            for (int m = 0; m < 4; ++m) { const int r = ai * HALF + wr * 64 + m * 16 + fr; const f32x2v sr = S[r]; const size_t off = (size_t)(u.pm * BM + r) * ldc + col0;
#pragma unroll
                for (int bj = 0; bj < 2; ++bj)
#pragma unroll
                    for (int n = 0; n < 2; ++n) { const f32x4 bs = ai == 0 ? pre[m][bj][n] : *(const f32x4*)(base + off + bj * HALF + n * 16); f32x4 o = bs + (acc[ai][bj][m][n] - sr.x) * sr.y;
                        if (bad) o = (f32x4){qnan, qnan, qnan, qnan}; *(f32x4*)(out + off + bj * HALF + n * 16) = o; }
                if (m & 1) asm volatile("" ::: "memory"); }
    }
};
struct EpiLnResLn {
    static constexpr bool PERM = false, AFTER_DRAIN = true;
    const float* base; float* out; bf16_t* xn; int ldc; const float* bias; PanelStats st1, st2; unsigned poison;
    __device__ __forceinline__ void fused(f32x4 (&acc)[2][2][4][2], const Unit& u, int wr, int wc, int fr, int fq, PG8_LAS unsigned char* lds, int wid, int lane) const {
        typedef float f32x2v __attribute__((ext_vector_type(2))); typedef unsigned u32x2v __attribute__((ext_vector_type(2)));
        const PG8_LAS f32x2v* S = (const PG8_LAS f32x2v*)(lds + 8192);
        const int col0 = u.pn * BM + wc * 32 + 4 * fq;
#pragma unroll
        for (int bj = 0; bj < 2; ++bj)
#pragma unroll
            for (int n = 0; n < 2; ++n) { const f32x4 bv = bias ? *(const f32x4*)(bias + col0 + bj * HALF + n * 16) : (f32x4){0.f, 0.f, 0.f, 0.f};
#pragma unroll
                for (int ai = 0; ai < 2; ++ai)
#pragma unroll
                    for (int m = 0; m < 4; ++m) acc[ai][bj][m][n] += bv; }
        bool bad = st1.run(acc, u, wr, wc, fr, fq, lds, wid, lane) || poison != 0u;
        const float qnan = __builtin_nanf("");
#pragma unroll
        for (int ai = 0; ai < 2; ++ai)
#pragma unroll
            for (int m = 0; m < 4; ++m) { const int r = ai * HALF + wr * 64 + m * 16 + fr; const f32x2v sr = S[r]; const size_t off = (size_t)(u.pm * BM + r) * ldc + col0;
#pragma unroll
                for (int bj = 0; bj < 2; ++bj)
#pragma unroll
                    for (int n = 0; n < 2; ++n) { const f32x4 bs = *(const f32x4*)(base + off + bj * HALF + n * 16); acc[ai][bj][m][n] = bs + (acc[ai][bj][m][n] - sr.x) * sr.y; }
                asm volatile("" : "+v"(acc[ai][0][m][0]), "+v"(acc[ai][0][m][1]), "+v"(acc[ai][1][m][0]), "+v"(acc[ai][1][m][1]));
                if (m & 1) asm volatile("" ::: "memory"); }
        const bool bad1 = bad;
        bad = st2.run(acc, u, wr, wc, fr, fq, lds, wid, lane) || bad;
#pragma unroll
        for (int ai = 0; ai < 2; ++ai)
#pragma unroll
            for (int m = 0; m < 4; ++m) { const int r = ai * HALF + wr * 64 + m * 16 + fr; const f32x2v sr = S[r]; const size_t off = (size_t)(u.pm * BM + r) * ldc + col0;
#pragma unroll
                for (int bj = 0; bj < 2; ++bj)
#pragma unroll
                    for (int n = 0; n < 2; ++n) { const f32x4 x1 = acc[ai][bj][m][n]; *(f32x4*)(out + off + bj * HALF + n * 16) = bad1 ? (f32x4){qnan, qnan, qnan, qnan} : x1;
                        const f32x4 o = (x1 - sr.x) * sr.y; u32x2v w; w.x = cvt_pk_bf16(o[0], o[1]); w.y = cvt_pk_bf16(o[2], o[3]);
                        if (bad) { w.x = 0x7fc07fc0u; w.y = 0x7fc07fc0u; } *(u32x2v*)(xn + off + bj * HALF + n * 16) = w; }
                asm volatile("" ::: "memory"); }
    }
};

template <class Epi, class Sched, bool ALIGN_EPI = false, bool SP2 = false>
__device__ __forceinline__ void gemm_phase(PG8_LAS unsigned char* lds, const Gemm g, const Sched& S, const Epi& E) {
    const int tid = threadIdx.x, wid = __builtin_amdgcn_readfirstlane(tid >> 6), lane = tid & 63, wr = wid >> 2, wc = wid & 3, fr = lane & 15, fq = lane >> 4;
    const int K = g.K, nt = K / BK;
    unsigned voffA[2], voffB[2];
#pragma unroll
    for (int i = 0; i < 2; ++i) { int R, C; stage_rc(tid * 16 + i * 8192, R, C); const int Rb = Epi::PERM ? ((R & ~31) + perm32(R & 31)) : R;
        voffA[i] = (unsigned)(R * K + C) * 2u; voffB[i] = (unsigned)(Rb * K + C) * 2u; }
    const size_t kstep = (size_t)(BK * 2);
    const size_t hstep = (size_t)HALF * K * 2;
    const size_t tstep = 2 * hstep;
    const unsigned ldsw = (unsigned)wid * 1024u;
    const int aoff = lds_byte(wr * 64 + fr, fq * 8), boff = lds_byte(wc * 32 + fr, fq * 8);
#define PG8_SA(b, h) (((b) * 2 + (h)) * HTB)
#define PG8_SB(b, h) ((4 + (b) * 2 + (h)) * HTB)
#define PG8_STAGE(bufoff, gbase, voff) do { _Pragma("unroll") for (int _i = 0; _i < 2; ++_i) \
        __builtin_amdgcn_global_load_lds((const unsigned*)((const char*)(gbase) + (voff)[_i]), (PG8_LAS unsigned*)(lds + (bufoff) + ldsw + _i * 8192), 16, 0, 0); } while (0)
#define PG8_LDA(dst, b, h) do { _Pragma("unroll") for (int m = 0; m < 4; ++m) _Pragma("unroll") for (int k = 0; k < 2; ++k) dst[m][k] = *(const PG8_LAS bf16x8*)(lds + PG8_SA(b, h) + aoff + m * 2048 + k * 1024); } while (0)
#define PG8_LDB(dst, b, h) do { _Pragma("unroll") for (int n = 0; n < 2; ++n) _Pragma("unroll") for (int k = 0; k < 2; ++k) dst[n][k] = *(const PG8_LAS bf16x8*)(lds + PG8_SB(b, h) + boff + n * 2048 + k * 1024); } while (0)
#define PG8_MMA(ai, bj, At, Bt) do { __builtin_amdgcn_s_setprio(1); _Pragma("unroll") for (int m = 0; m < 4; ++m) _Pragma("unroll") for (int n = 0; n < 2; ++n) _Pragma("unroll") for (int k = 0; k < 2; ++k) \
        acc[ai][bj][m][n] = __builtin_amdgcn_mfma_f32_16x16x32_bf16(Bt[n][k], At[m][k], acc[ai][bj][m][n], 0, 0, 0); __builtin_amdgcn_s_setprio(0); } while (0)
#define PG8_WAIT_V(n) asm volatile("s_waitcnt vmcnt(" #n ")" ::: "memory")
#define PG8_WAIT_L(n) asm volatile("s_waitcnt lgkmcnt(" #n ")" ::: "memory")
#define PG8_BAR __builtin_amdgcn_s_barrier()
#define PG8_SCHED __builtin_amdgcn_sched_barrier(0)
    Unit cur, nxt; int ui = 0;
    if (!S.next(0, cur)) return;
    f32x4 acc[2][2][4][2];
#pragma unroll
    for (int a = 0; a < 2; ++a)
#pragma unroll
        for (int b = 0; b < 2; ++b)
#pragma unroll
            for (int m = 0; m < 4; ++m)
#pragma unroll
                for (int n = 0; n < 2; ++n) acc[a][b][m][n] = (f32x4){0.f, 0.f, 0.f, 0.f};
    bf16x8 At[4][2], B0[2][2], B1[2][2];
    const char* cA = (const char*)(cur.seg ? g.A1 : g.A0) + (size_t)cur.pm * tstep; const char* cB = (const char*)(cur.seg ? g.B1 : g.B0) + (size_t)cur.pn * tstep;
    S.a_ready(cur);
    if constexpr (SP2) {
        PG8_STAGE(PG8_SB(0, 0), cB, voffB); PG8_STAGE(PG8_SB(0, 1), cB + hstep, voffB); PG8_STAGE(PG8_SA(0, 0), cA, voffA); PG8_STAGE(PG8_SA(0, 1), cA + hstep, voffA);
        if (wr == 1) PG8_BAR;
        PG8_WAIT_V(2); PG8_BAR;
        PG8_STAGE(PG8_SB(1, 0), cB + kstep, voffB); PG8_STAGE(PG8_SA(1, 0), cA + kstep, voffA); PG8_STAGE(PG8_SB(1, 1), cB + hstep + kstep, voffB);
        PG8_WAIT_V(6); PG8_BAR;
    } else {
        PG8_STAGE(PG8_SB(0, 0), cB, voffB); PG8_STAGE(PG8_SA(0, 0), cA, voffA); PG8_STAGE(PG8_SB(0, 1), cB + hstep, voffB); PG8_STAGE(PG8_SA(0, 1), cA + hstep, voffA);
        if (wr == 1) PG8_BAR;
        PG8_WAIT_V(4); PG8_BAR;
        PG8_STAGE(PG8_SB(1, 0), cB + kstep, voffB); PG8_STAGE(PG8_SA(1, 0), cA + kstep, voffA); PG8_STAGE(PG8_SB(1, 1), cB + hstep + kstep, voffB);
        PG8_WAIT_V(6); PG8_BAR;
    }
    for (;;) {
        const bool has_next = S.next(ui + 1, nxt);
        const char* nA = has_next ? (const char*)(nxt.seg ? g.A1 : g.A0) + (size_t)nxt.pm * tstep : cA; const char* nB = has_next ? (const char*)(nxt.seg ? g.B1 : g.B0) + (size_t)nxt.pn * tstep : cB;
        for (int t = 0; t < nt; t += 2) {
            const bool last = (t == nt - 2);
            const char* a1 = cA + (size_t)(t + 1) * kstep;
            const char* a2 = last ? nA : cA + (size_t)(t + 2) * kstep; const char* b2 = last ? nB : cB + (size_t)(t + 2) * kstep;
            const char* a3 = a2 + kstep; const char* b3 = b2 + kstep;
            if (last && has_next) S.a_ready(nxt);
            if constexpr (SP2) {
            PG8_LDB(B0, 0, 0); PG8_LDB(B1, 0, 1); PG8_SCHED; PG8_LDA(At, 0, 0); PG8_STAGE(PG8_SA(1, 1), a1 + hstep, voffA);
            PG8_WAIT_V(8); PG8_WAIT_L(0); PG8_BAR; PG8_MMA(0, 0, At, B0); PG8_MMA(0, 1, At, B1); PG8_BAR; PG8_SCHED;
            PG8_LDA(At, 0, 1); PG8_STAGE(PG8_SB(0, 0), b2, voffB); PG8_STAGE(PG8_SB(0, 1), b2 + hstep, voffB); PG8_STAGE(PG8_SA(0, 0), a2, voffA);
            PG8_WAIT_V(8); PG8_WAIT_L(0); PG8_BAR; PG8_MMA(1, 0, At, B0); PG8_MMA(1, 1, At, B1); PG8_BAR; PG8_SCHED;
            PG8_LDB(B0, 1, 0); PG8_LDB(B1, 1, 1); PG8_SCHED; PG8_LDA(At, 1, 0); PG8_STAGE(PG8_SA(0, 1), a2 + hstep, voffA);
            PG8_WAIT_V(8); PG8_WAIT_L(0); PG8_BAR; PG8_MMA(0, 0, At, B0); PG8_MMA(0, 1, At, B1); PG8_BAR; PG8_SCHED;
            PG8_LDA(At, 1, 1); PG8_STAGE(PG8_SB(1, 0), b3, voffB); PG8_STAGE(PG8_SB(1, 1), b3 + hstep, voffB); PG8_STAGE(PG8_SA(1, 0), a3, voffA);
            PG8_WAIT_V(8); PG8_WAIT_L(0); PG8_BAR; PG8_MMA(1, 0, At, B0); PG8_MMA(1, 1, At, B1); PG8_BAR; PG8_SCHED;
            } else {
            PG8_LDB(B0, 0, 0); PG8_SCHED; PG8_LDA(At, 0, 0); PG8_STAGE(PG8_SA(1, 1), a1 + hstep, voffA);
            PG8_WAIT_L(8); PG8_BAR; PG8_WAIT_L(0); PG8_MMA(0, 0, At, B0); PG8_BAR; PG8_SCHED;
            PG8_LDB(B1, 0, 1); PG8_STAGE(PG8_SB(0, 0), b2, voffB);
            PG8_BAR; PG8_WAIT_L(0); PG8_MMA(0, 1, At, B1); PG8_BAR;
            PG8_LDA(At, 0, 1); PG8_STAGE(PG8_SA(0, 0), a2, voffA);
            PG8_BAR; PG8_WAIT_L(0); PG8_MMA(1, 0, At, B0); PG8_BAR; PG8_SCHED;
            PG8_STAGE(PG8_SB(0, 1), b2 + hstep, voffB);
            PG8_WAIT_V(6); PG8_BAR; PG8_MMA(1, 1, At, B1); PG8_BAR;
            PG8_LDB(B0, 1, 0); PG8_SCHED; PG8_LDA(At, 1, 0); PG8_STAGE(PG8_SA(0, 1), a2 + hstep, voffA);
            PG8_WAIT_L(8); PG8_BAR; PG8_WAIT_L(0); PG8_MMA(0, 0, At, B0); PG8_BAR; PG8_SCHED;
            PG8_LDB(B1, 1, 1); PG8_STAGE(PG8_SB(1, 0), b3, voffB);
            PG8_BAR; PG8_WAIT_L(0); PG8_MMA(0, 1, At, B1); PG8_BAR;
            PG8_LDA(At, 1, 1); PG8_STAGE(PG8_SA(1, 0), a3, voffA);
            PG8_BAR; PG8_WAIT_L(0); PG8_MMA(1, 0, At, B0); PG8_BAR; PG8_SCHED;
            PG8_STAGE(PG8_SB(1, 1), b3 + hstep, voffB);
            PG8_WAIT_V(6); PG8_BAR; PG8_MMA(1, 1, At, B1); PG8_BAR;
            }
        }
        if constexpr (ALIGN_EPI) { if (wr == 0) PG8_BAR; }
        if constexpr (!Epi::AFTER_DRAIN) { E(acc, cur, wr, wc, fr, fq); S.done(cur); }
        if (!has_next) break;
        if (nxt.seg == 0) {
#pragma unroll
        for (int a = 0; a < 2; ++a)
#pragma unroll
            for (int b = 0; b < 2; ++b)
#pragma unroll
                for (int m = 0; m < 4; ++m)
#pragma unroll
                    for (int n = 0; n < 2; ++n) acc[a][b][m][n] = (f32x4){0.f, 0.f, 0.f, 0.f};
        }
        cur = nxt; cA = nA; cB = nB; ++ui;
        if constexpr (ALIGN_EPI) { if (wr == 1) PG8_BAR; }
    }
    PG8_WAIT_V(0);
    if constexpr (!ALIGN_EPI) { if (wr == 0) PG8_BAR; }
    PG8_BAR;
    if constexpr (Epi::AFTER_DRAIN) { E.fused(acc, cur, wr, wc, fr, fq, lds, wid, lane); S.done(cur); }
#undef PG8_SA
#undef PG8_SB
#undef PG8_STAGE
#undef PG8_LDA
#undef PG8_LDB
#undef PG8_MMA
#undef PG8_WAIT_V
#undef PG8_WAIT_L
#undef PG8_BAR
#undef PG8_SCHED
}
}
namespace attn_body {
using bf16=__hip_bfloat16;
using bf16x8=__attribute__((ext_vector_type(8)))short;
using s16x4=__attribute__((ext_vector_type(4)))short;
using f32x16=__attribute__((ext_vector_type(16)))float;
using u32x4=__attribute__((ext_vector_type(4)))unsigned;
constexpr int BATCH=8,NHEAD=16,SEQ=4096,D=64,DM=NHEAD*D;
constexpr int NW=8,QBLK=32,QB=QBLK*NW,KVBLK=64,NQB=SEQ/QB;
constexpr int ATTN_PITCH=DM, ATTN_UNIT_ROWS=QB;
__device__ __forceinline__ int crow(int r,int hi){return (r&3)+8*(r>>2)+4*hi;}
#define SBAR() __builtin_amdgcn_sched_barrier(0)
__device__ __forceinline__ void cmask(f32x16&p0,f32x16&p1,int jb,int qrel,int hi){
  const float NEG=-INFINITY; int kb=64*jb+4*hi;
  #pragma unroll
  for(int r=0;r<16;++r){int kv=kb+(r&3)+8*(r>>2); if(kv>qrel)p0[r]=NEG; if(kv+32>qrel)p1[r]=NEG;}
}

constexpr int NSLOT=3, SLOTB=8192;
constexpr int LDS_K=0, LDS_V=NSLOT*SLOTB, LDS_WS=2*NSLOT*SLOTB, LDS_OST=LDS_WS+NW*64*4, LDS_CL=LDS_OST+NW*4096, LDS_BYTES=LDS_CL+SEQ*4;
constexpr float C2=0.125f*1.4426950408889634f;
__device__ __forceinline__ void glds16(const void*gsrc,unsigned lds_dst){unsigned keep;
  asm volatile("s_mov_b32 %0, m0\n\ts_mov_b32 m0, %2\n\ts_nop 0\n\tglobal_load_lds_dwordx4 %1, off\n\ts_mov_b32 m0, %0":"=&s"(keep):"v"(gsrc),"s"(lds_dst):"memory");}
__device__ __forceinline__ float max3f(float a,float b,float c){float r;asm("v_max3_f32 %0, %1, %2, %3":"=v"(r):"v"(a),"v"(b),"v"(c));return r;}
__device__ __forceinline__ float max2f(float a,float b){float r;asm("v_max_f32_e32 %0, %1, %2":"=v"(r):"v"(a),"v"(b));return r;}
__device__ __forceinline__ float fadd_s(float a,float b){float r;asm("v_add_f32_e32 %0, %1, %2":"=v"(r):"v"(a),"v"(b));return r;}
__device__ __forceinline__ float fsub_s(float a,float b){float r;asm("v_sub_f32_e32 %0, %1, %2":"=v"(r):"v"(a),"v"(b));return r;}
typedef float f32x2_t __attribute__((ext_vector_type(2))); typedef __bf16 bf16x2_t __attribute__((ext_vector_type(2)));
__device__ __forceinline__ unsigned cvtpk_s(float lo,float hi){f32x2_t v={lo,hi};bf16x2_t b=__builtin_convertvector(v,bf16x2_t);return __builtin_bit_cast(unsigned,b);}
#define WAIT_BAR(N) asm volatile("s_waitcnt vmcnt(" #N ") lgkmcnt(0)\n\ts_barrier":::"memory")

__device__ __forceinline__ void qkt(f32x16&p0,f32x16&p1,const char*Kslot,const bf16x8*qr,int r32,int hi){
  const char*kb=Kslot+hi*1024+r32*16;
  #pragma unroll
  for(int d0=0;d0<4;++d0){
    const bf16x8 b0=*reinterpret_cast<const bf16x8*>(kb+d0*2048);
    const bf16x8 b1=*reinterpret_cast<const bf16x8*>(kb+d0*2048+512);
    {p0=__builtin_amdgcn_mfma_f32_32x32x16_bf16(b0,qr[d0],p0,0,0,0);p1=__builtin_amdgcn_mfma_f32_32x32x16_bf16(b1,qr[d0],p1,0,0,0);}}
}
typedef __attribute__((address_space(3))) const char* lds_cptr;
typedef short v4i16_t __attribute__((ext_vector_type(4)));
__device__ __forceinline__ void kload8(bf16x8*kf,lds_cptr kp){
  kf[0]=*(const __attribute__((address_space(3))) bf16x8*)(kp);      kf[1]=*(const __attribute__((address_space(3))) bf16x8*)(kp+512);
  kf[2]=*(const __attribute__((address_space(3))) bf16x8*)(kp+2048); kf[3]=*(const __attribute__((address_space(3))) bf16x8*)(kp+2560);
  kf[4]=*(const __attribute__((address_space(3))) bf16x8*)(kp+4096); kf[5]=*(const __attribute__((address_space(3))) bf16x8*)(kp+4608);
  kf[6]=*(const __attribute__((address_space(3))) bf16x8*)(kp+6144); kf[7]=*(const __attribute__((address_space(3))) bf16x8*)(kp+6656);
}
__device__ __forceinline__ void kload2(bf16x8*kf,lds_cptr kp,int j){ kf[2*j]=*(const __attribute__((address_space(3))) bf16x8*)(kp+j*2048); kf[2*j+1]=*(const __attribute__((address_space(3))) bf16x8*)(kp+j*2048+512); }
__device__ __forceinline__ s16x4 vtr(lds_cptr p){ return __builtin_bit_cast(s16x4,__builtin_amdgcn_ds_read_tr16_b64_v4i16((__attribute__((address_space(3))) v4i16_t*)p)); }
__device__ __forceinline__ float rowmax(const f32x16&p0,const f32x16&p1){
  float a=max3f(p0[0],p0[1],p1[0]),b=max3f(p0[2],p0[3],p1[1]);a=max3f(a,p1[2],p1[3]);
  #pragma unroll
  for(int r=4;r<16;r+=4){a=max3f(a,p0[r],p0[r+1]);b=max3f(b,p0[r+2],p0[r+3]);a=max3f(a,p1[r],p1[r+1]);b=max3f(b,p1[r+2],p1[r+3]);}
  const float m=max2f(a,b);
  auto rr=__builtin_amdgcn_permlane32_swap(__float_as_uint(m),__float_as_uint(m),false,false);
  return max2f(__uint_as_float(rr[0]),__uint_as_float(rr[1]));
}
__device__ __forceinline__ void pv(f32x16*o,int vb,bf16x8 pa0,bf16x8 pa1,bf16x8 pa2,bf16x8 pa3){
  #pragma unroll
  for(int d0=0;d0<2;++d0){s16x4 lo[4],hi[4];
    #pragma unroll
    for(int ks=0;ks<4;++ks){
      asm volatile("ds_read_b64_tr_b16 %0,%1 offset:%c2":"=&v"(lo[ks]):"v"(vb),"i"(d0*4096+ks*1024):"memory");
      asm volatile("ds_read_b64_tr_b16 %0,%1 offset:%c2":"=&v"(hi[ks]):"v"(vb),"i"(d0*4096+ks*1024+512):"memory");}
    asm volatile("s_waitcnt lgkmcnt(0)":::"memory");SBAR();
    #define PK(k) (bf16x8){lo[k][0],lo[k][1],lo[k][2],lo[k][3],hi[k][0],hi[k][1],hi[k][2],hi[k][3]}
    o[d0]=__builtin_amdgcn_mfma_f32_32x32x16_bf16(pa0,PK(0),o[d0],0,0,0);
    o[d0]=__builtin_amdgcn_mfma_f32_32x32x16_bf16(pa1,PK(1),o[d0],0,0,0);
    o[d0]=__builtin_amdgcn_mfma_f32_32x32x16_bf16(pa2,PK(2),o[d0],0,0,0);
    o[d0]=__builtin_amdgcn_mfma_f32_32x32x16_bf16(pa3,PK(3),o[d0],0,0,0);
    #undef PK
  }
}

#ifndef ATTN_STORE16
#define ATTN_STORE16(p,v) (*(u32x4*)(p)=(v))
#endif
template<int THRL> __device__ __forceinline__ void attn_unit(int b,int h,int qb,int T0,const bf16*Q,const bf16*__restrict__ K,const bf16*__restrict__ V,bf16*O,const float*__restrict__ c2g,char*shm){
  const int tid=threadIdx.x,lane=tid&63,r32=lane&31,hi=lane>>5; const int wid=__builtin_amdgcn_readfirstlane(tid>>6);
  const long rowbase=(long)b*SEQ; const int q0=qb*QB;
  const bf16*Qw=Q+(rowbase+q0+wid*QBLK)*DM+h*D;
  const bf16*Kh=K+(rowbase+(long)T0*KVBLK)*DM+h*D,*Vh=V+(rowbase+(long)T0*KVBLK)*DM+h*D;
  const unsigned lds0=(unsigned)(uintptr_t)shm; const lds_cptr shm3=(lds_cptr)shm;
  float*wsf=(float*)(shm+LDS_WS)+wid*64;
  const bf16*ksrc=Kh+(long)lane*DM+wid*8;
  const bf16*vsrc=Vh+(long)(16*(wid&3)+(lane>>2))*DM+(wid>>2)*32+(lane&3)*8;
  const unsigned kdst=lds0+LDS_K+wid*1024, vdst=lds0+LDS_V+wid*1024;
  #define DMA_K(t,slot) glds16(ksrc+(long)(t)*KVBLK*DM,(unsigned)__builtin_amdgcn_readfirstlane(kdst+(slot)))
  #define DMA_V(t,slot) glds16(vsrc+(long)(t)*KVBLK*DM,(unsigned)__builtin_amdgcn_readfirstlane(vdst+(slot)))
  const int vb0=(int)(lds0+LDS_V)+((lane>>4)&1)*32+(lane&3)*8+(4*hi+((lane&15)>>2))*64;
  const char*Kbase=shm+LDS_K; bf16x8 kf[8];
  const lds_cptr kp0=shm3+LDS_K+hi*1024+r32*16; const lds_cptr vp0=shm3+LDS_V+((lane>>4)&1)*32+(lane&3)*8+(4*hi+((lane&15)>>2))*64;
  const int NT=(q0+QB)/KVBLK-T0;
  { typedef float f32x4g __attribute__((ext_vector_type(4))); __attribute__((address_space(3))) f32x4g* cl4=(__attribute__((address_space(3))) f32x4g*)(shm3+LDS_CL);
    for(int s4=16*T0+tid; s4<(q0+QB)/4; s4+=NW*64) cl4[s4]=*reinterpret_cast<const f32x4g*>(c2g+4*s4); }
  float nm=c2g[q0+wid*QBLK+r32];
  DMA_K(0,0);DMA_V(0,0);DMA_K(1,SLOTB);
  bf16x8 qr[4];
  #pragma unroll
  for(int d0=0;d0<4;++d0)qr[d0]=*reinterpret_cast<const bf16x8*>(&Qw[(long)r32*DM+d0*16+hi*8]);
  float l_reg=0.f;f32x16 o[2];o[0]=f32x16{};o[1]=f32x16{};
  typedef float f32x4l __attribute__((ext_vector_type(4)));
  #define CINIT(C0,C1,t) do{ const __attribute__((address_space(3))) f32x4l* cp_=(const __attribute__((address_space(3))) f32x4l*)(shm3+LDS_CL+(((t)+T0)*64+4*hi)*4); \
    _Pragma("unroll") for(int g_=0;g_<4;++g_){ const f32x4l a_=cp_[2*g_], b_=cp_[8+2*g_]; \
      C0[4*g_]=nm-a_[0];C0[4*g_+1]=nm-a_[1];C0[4*g_+2]=nm-a_[2];C0[4*g_+3]=nm-a_[3]; \
      C1[4*g_]=nm-b_[0];C1[4*g_+1]=nm-b_[1];C1[4*g_+2]=nm-b_[2];C1[4*g_+3]=nm-b_[3]; } }while(0)
  const int qrel=wid*QBLK+r32;
  #define CMASK(P0,P1,t) do{int jb_=(t)-(NT-4); if(jb_>=0)cmask(P0,P1,jb_,qrel,hi);}while(0)
  bool resc=false;
  #define START(P0,P1) do{ const float rm=rowmax(P0,P1); resc=false; \
    { const float dl=rm; nm=fsub_s(nm,dl); \
      _Pragma("unroll") for(int r=0;r<16;++r){P0[r]=fsub_s(P0[r],dl);P1[r]=fsub_s(P1[r],dl);} } \
    _Pragma("unroll") for(int r=0;r<16;++r)P0[r]=__builtin_amdgcn_exp2f(P0[r]); }while(0)
  #define RESC() do{ if(resc){ asm volatile("s_waitcnt lgkmcnt(0)":::"memory"); \
      _Pragma("unroll") for(int d_=0;d_<2;++d_) _Pragma("unroll") for(int r=0;r<16;++r)o[d_][r]*=wsf[crow(r,hi)]; } }while(0)
  f32x16 pA0,pA1,pB0,pB1;
  int sl_prev=0,sl_cur=0,sl_next=SLOTB;
  #define ROT() do{sl_prev=sl_cur;sl_cur=sl_next;sl_next=(sl_next==(NSLOT-1)*SLOTB)?0:sl_next+SLOTB;}while(0)
  DMA_K(2,2*SLOTB);
  WAIT_BAR(3);
  CINIT(pA0,pA1,0); qkt(pA0,pA1,Kbase,qr,r32,hi);asm volatile("s_nop 15\n\ts_nop 7":"+v"(pA0),"+v"(pA1));CMASK(pA0,pA1,0);
  START(pA0,pA1);
  _Pragma("unroll") for(int r=0;r<16;++r)pA1[r]=__builtin_amdgcn_exp2f(pA1[r]);
  WAIT_BAR(0);
  DMA_K(3,0);DMA_V(1,SLOTB);
  ROT();
  kload8(kf,kp0+sl_cur);
  WAIT_BAR(2);
  s16x4 vlo[8],vhi[8]; u32x4 pw0,pw1,pw2,pw3;
  #define PKW(P,B) cvtpk_s(P[B],P[B+1])
  #define PAF(k) __builtin_bit_cast(bf16x8,pw##k)
  #define VFR(i) (bf16x8){vlo[i][0],vlo[i][1],vlo[i][2],vlo[i][3],vhi[i][0],vhi[i][1],vhi[i][2],vhi[i][3]}
  #define PIN(x) asm volatile("":"+v"(x))
  #define MX3(a,b,c) __builtin_fmaxf(__builtin_fmaxf((a),(b)),(c))
  #define GAPA(MF,A0,A1,A2,A3,W0,W1,PW) do{ MF; sacc+=A0; sacc+=A1; sacc+=A2; sacc+=A3; PIN(sacc); W0; W1; PIN(PW); SBAR(); }while(0)
  #define EX(v) __builtin_amdgcn_exp2f(v)
  #define GAPB(MF,X,B) do{ MF; X[B]=EX(X[B]); X[B+1]=EX(X[B+1]); X[B+2]=EX(X[B+2]); X[B+3]=EX(X[B+3]); PIN(X); SBAR(); }while(0)
  #define VRD(i) do{ vlo[i]=vtr(vp_+(((i)>>2)*4096+((i)&3)*1024)); vhi[i]=vtr(vp_+(((i)>>2)*4096+((i)&3)*1024+512)); }while(0)
  #define KRD(G,j) do{ if(G){ kload2(kf,kp0+sl_next,j); SBAR(); } }while(0)
  #define STEP(C0,C1,P0,P1,t,GK,GV,GL) do{ SBAR(); CINIT(C0,C1,t); SBAR(); \
    const lds_cptr vp_=vp0+sl_prev; \
    VRD(0); SBAR(); float sacc=(P0[0]+P0[1]); \
    GAPA(C0=__builtin_amdgcn_mfma_f32_32x32x16_bf16(kf[0],qr[0],C0,0,0,0), P0[2],P0[3],P0[4],P0[5],     pw0[0]=PKW(P0,0), pw0[1]=PKW(P0,2), pw0); \
    VRD(4); SBAR(); GAPA(C1=__builtin_amdgcn_mfma_f32_32x32x16_bf16(kf[1],qr[0],C1,0,0,0), P0[6],P0[7],P0[8],P0[9],     pw0[2]=PKW(P0,4), pw0[3]=PKW(P0,6), pw0); \
    VRD(1); SBAR(); GAPA(C0=__builtin_amdgcn_mfma_f32_32x32x16_bf16(kf[2],qr[1],C0,0,0,0),   P0[10],P0[11],P0[12],P0[13], pw1[0]=PKW(P0,8), pw1[1]=PKW(P0,10), pw1); \
    VRD(5); SBAR(); GAPA(C1=__builtin_amdgcn_mfma_f32_32x32x16_bf16(kf[3],qr[1],C1,0,0,0),   P0[14],P0[15],P1[0],P1[1],   pw1[2]=PKW(P0,12),pw1[3]=PKW(P0,14), pw1); \
    VRD(2); SBAR(); GAPA(C0=__builtin_amdgcn_mfma_f32_32x32x16_bf16(kf[4],qr[2],C0,0,0,0),   P1[2],P1[3],P1[4],P1[5],     pw2[0]=PKW(P1,0), pw2[1]=PKW(P1,2), pw2); \
    VRD(6); SBAR(); GAPA(C1=__builtin_amdgcn_mfma_f32_32x32x16_bf16(kf[5],qr[2],C1,0,0,0),   P1[6],P1[7],P1[8],P1[9],     pw2[2]=PKW(P1,4), pw2[3]=PKW(P1,6), pw2); \
    VRD(3); SBAR(); GAPA(C0=__builtin_amdgcn_mfma_f32_32x32x16_bf16(kf[6],qr[3],C0,0,0,0),   P1[10],P1[11],P1[12],P1[13], pw3[0]=PKW(P1,8), pw3[1]=PKW(P1,10), pw3); \
    VRD(7); SBAR(); GAPA(C1=__builtin_amdgcn_mfma_f32_32x32x16_bf16(kf[7],qr[3],C1,0,0,0),   P1[14],P1[15],0.f,0.f,       pw3[2]=PKW(P1,12),pw3[3]=PKW(P1,14), pw3); \
    l_reg+=sacc; \
    if(GK){DMA_K((t)+3,sl_cur);} if(GV){DMA_V((t)+1,sl_next);} \
    CMASK(C0,C1,t); \
    { float a=MX3(C0[0],C0[1],C1[0]),b=MX3(C0[2],C0[3],C1[1]); a=MX3(a,C1[2],C1[3]); \
      _Pragma("unroll") for(int r=4;r<16;r+=4){a=MX3(a,C0[r],C0[r+1]);b=MX3(b,C0[r+2],C0[r+3]);a=MX3(a,C1[r],C1[r+1]);b=MX3(b,C1[r+2],C1[r+3]);} \
      float rm=__builtin_fmaxf(a,b); { auto rr=__builtin_amdgcn_permlane32_swap(__float_as_uint(rm),__float_as_uint(rm),false,false); rm=__builtin_fmaxf(__uint_as_float(rr[0]),__uint_as_float(rr[1])); } \
      resc=false; \
      if(__builtin_expect(__any(rm>(float)THRL),0)){ const float dl=__builtin_fmaxf(rm,0.f); nm-=dl; \
        _Pragma("unroll") for(int r=0;r<16;++r){C0[r]-=dl;C1[r]-=dl;} \
        const float f=__builtin_amdgcn_exp2f(-dl); l_reg*=f; if(hi==0)wsf[r32]=f; resc=true; } } \
    SBAR(); \
    GAPB(o[0]=__builtin_amdgcn_mfma_f32_32x32x16_bf16(PAF(0),VFR(0),o[0],0,0,0), C0,0); \
    GAPB(o[1]=__builtin_amdgcn_mfma_f32_32x32x16_bf16(PAF(0),VFR(4),o[1],0,0,0), C0,4); \
    KRD(GL,0); GAPB(o[0]=__builtin_amdgcn_mfma_f32_32x32x16_bf16(PAF(1),VFR(1),o[0],0,0,0), C0,8); \
    KRD(GL,1); GAPB(o[1]=__builtin_amdgcn_mfma_f32_32x32x16_bf16(PAF(1),VFR(5),o[1],0,0,0), C0,12); \
    KRD(GL,2); GAPB(o[0]=__builtin_amdgcn_mfma_f32_32x32x16_bf16(PAF(2),VFR(2),o[0],0,0,0), C1,0); \
    KRD(GL,3); GAPB(o[1]=__builtin_amdgcn_mfma_f32_32x32x16_bf16(PAF(2),VFR(6),o[1],0,0,0), C1,4); \
    GAPB(o[0]=__builtin_amdgcn_mfma_f32_32x32x16_bf16(PAF(3),VFR(3),o[0],0,0,0), C1,8); \
    GAPB(o[1]=__builtin_amdgcn_mfma_f32_32x32x16_bf16(PAF(3),VFR(7),o[1],0,0,0), C1,12); \
    }while(0)
  int t=1;
  #undef CMASK
  #define CMASK(P0,P1,t) do{}while(0)
  for(;t+5<NT;t+=2){
    STEP(pB0,pB1,pA0,pA1,t,true,true,true);     WAIT_BAR(2); RESC(); ROT();
    STEP(pA0,pA1,pB0,pB1,t+1,true,true,true);   WAIT_BAR(2); RESC(); ROT();
  }
  #undef CMASK
  #define CMASK(P0,P1,t) do{int jb_=(t)-(NT-4); if(jb_>=0)cmask(P0,P1,jb_,qrel,hi);}while(0)
  #define ENDW(tt) do{ if((tt)+3<NT){WAIT_BAR(2);} else if((tt)+2<NT){WAIT_BAR(1);} else {WAIT_BAR(0);} }while(0)
  for(;t+1<NT;t+=2){
    STEP(pB0,pB1,pA0,pA1,t,(t+3<NT),(t+1<NT),(t+1<NT));       ENDW(t);   RESC(); ROT();
    STEP(pA0,pA1,pB0,pB1,t+1,(t+4<NT),(t+2<NT),(t+2<NT));     ENDW(t+1); RESC(); ROT();
  }
  STEP(pB0,pB1,pA0,pA1,NT-1,false,false,false); RESC();
  { float sacc=pB0[0]+pB0[1]; _Pragma("unroll") for(int r=2;r<16;++r)sacc+=pB0[r]; _Pragma("unroll") for(int r=0;r<16;++r)sacc+=pB1[r]; l_reg+=sacc;
    pw0=(u32x4){PKW(pB0,0),PKW(pB0,2),PKW(pB0,4),PKW(pB0,6)};pw1=(u32x4){PKW(pB0,8),PKW(pB0,10),PKW(pB0,12),PKW(pB0,14)};pw2=(u32x4){PKW(pB1,0),PKW(pB1,2),PKW(pB1,4),PKW(pB1,6)};pw3=(u32x4){PKW(pB1,8),PKW(pB1,10),PKW(pB1,12),PKW(pB1,14)};
    SBAR(); pv(o,vb0+sl_cur,PAF(0),PAF(1),PAF(2),PAF(3)); }
  #undef PKW
  #undef PAF
  #undef VFR
  #undef PIN
  #undef MX3
  #undef GAPA
  #undef GAPB
  #undef EX
  #undef VRD
  #undef KRD
  #undef STEP
  #undef ENDW
  {auto rr=__builtin_amdgcn_permlane32_swap(__float_as_uint(l_reg),__float_as_uint(l_reg),false,false);l_reg=__uint_as_float(rr[0])+__uint_as_float(rr[1]);}
  if(hi==0)wsf[32+r32]=l_reg;asm volatile("s_waitcnt lgkmcnt(0)":::"memory");
  float rli[16];
  #pragma unroll
  for(int r=0;r<16;++r)rli[r]=__builtin_amdgcn_rcpf(wsf[32+crow(r,hi)]);
  bf16*Ow=O+(rowbase+q0+wid*QBLK)*DM+h*D;
  { bf16*stg=(bf16*)(shm+LDS_OST)+wid*2048;
    #pragma unroll
    for(int r=0;r<16;++r){const int orow=crow(r,hi);
      #pragma unroll
      for(int d0=0;d0<2;++d0)stg[orow*64+d0*32+r32]=__float2bfloat16(o[d0][r]*rli[r]);}
    asm volatile("s_waitcnt lgkmcnt(0)":::"memory");
    #pragma unroll
    for(int i=0;i<4;++i){const int row=i*8+(lane>>3),ch=lane&7; const u32x4 v=*(const u32x4*)(stg+row*64+ch*8); ATTN_STORE16(Ow+(long)row*DM+ch*8,v);} }
  asm volatile("s_waitcnt lgkmcnt(0)\n\ts_barrier":::"memory");
  #undef DMA_K
  #undef DMA_V
  #undef CMASK
  #undef CINIT
  #undef START
  #undef RESC
  #undef ROT
}
constexpr int ATTN_LDS_BYTES=LDS_BYTES;
struct AttnTensors { const bf16* Q; const bf16* K; const bf16* V; bf16* O; const float* C2; };
struct AttnUnit { int bh; int qb; int t0; };
struct StaticOrder {
  int vcu, G;
  __device__ __forceinline__ explicit StaticOrder(int grid,int block):vcu((grid%8==0)?(block%8)*(grid/8)+block/8:block),G(grid){}
  __device__ __forceinline__ bool next(int i,AttnUnit&u)const{
    if(G==256){ if(i>=8)return false; const int s=vcu&1, base=4*(i>>1); u.bh=vcu>>1; u.qb=(i&1)?base+3-s:base+s; u.t0=0; return true; }
    const int L=i*G+vcu; if(L>=BATCH*NHEAD*NQB)return false; u.bh=L/NQB; u.qb=L%NQB; u.t0=0; return true; }
  __device__ __forceinline__ void a_ready(const AttnUnit&)const{}
  __device__ __forceinline__ void done(const AttnUnit&)const{}
};
template<class Sched,int THRL=8> __device__ __forceinline__ void attn_phase(char*lds,const AttnTensors&T,const Sched&S){
  AttnUnit u;
  for(int i=0;S.next(i,u);++i){ S.a_ready(u); attn_unit<THRL>(u.bh/NHEAD,u.bh%NHEAD,u.qb,u.t0,T.Q,T.K,T.V,T.O,T.C2+(size_t)u.bh*SEQ,lds); S.done(u); }
}
constexpr float SKIP_THR=40.f;
template<int THRL=8> __device__ __forceinline__ void attn_phase_queue(char*lds,const AttnTensors&T,unsigned*ctr,const float*STAT,int ctl_off){
  const int tid=threadIdx.x,lane=tid&63;
  volatile __attribute__((address_space(3))) unsigned* slot=(volatile __attribute__((address_space(3))) unsigned*)((__attribute__((address_space(3))) char*)lds+ctl_off);
  for(;;){
    if(tid==0) slot[0]=__hip_atomic_fetch_add(ctr,1u,__ATOMIC_RELAXED,__HIP_MEMORY_SCOPE_AGENT);
    __syncthreads();
    const unsigned un=slot[0];
    __syncthreads();
    if(un>=(unsigned)(BATCH*NHEAD*NQB))break;
    const int qb=NQB-1-(int)(un>>7), bh=(int)(un&127), q0=qb*QB;
    const float*c2g=T.C2+(size_t)bh*SEQ;
    const float qq=STAT[bh*4+0]+STAT[bh*4+1], kk=STAT[bh*4+2]+STAT[bh*4+3];
    const float lim=c2g[q0]+2.04f*sqrtf(qq*kk)+SKIP_THR;
    bool ok=false; if(lane<32){ const int t0c=2*lane; ok=(t0c==0)||(t0c<=4*qb && c2g[64*t0c-1]>=lim); }
    const unsigned long long mk=__ballot(ok);
    const int t0=2*(31-__builtin_clz((unsigned)(mk&0xffffffffull)));
    attn_unit<THRL>(bh/NHEAD,bh%NHEAD,qb,t0,T.Q,T.K,T.V,T.O,c2g,lds);
  }
}
#undef SBAR
#undef WAIT_BAR
}
#define GAS __attribute__((address_space(1)))
#define LAS __attribute__((address_space(3)))
typedef unsigned short bf16;
typedef unsigned v4u __attribute__((ext_vector_type(4)));
typedef float f32x4 __attribute__((ext_vector_type(4)));
typedef short bf16x8 __attribute__((ext_vector_type(8)));
typedef GAS unsigned gu32;
typedef GAS unsigned long long gu64;
#define RLX_AGENT __ATOMIC_RELAXED, __HIP_MEMORY_SCOPE_AGENT
#define LDS_WAIT() asm volatile("s_waitcnt lgkmcnt(0)" ::: "memory")
#define VM_WAIT() asm volatile("s_waitcnt vmcnt(0)" ::: "memory")
__device__ __forceinline__ unsigned long long rt() { return __builtin_amdgcn_s_memrealtime(); }
__device__ __forceinline__ unsigned f2bf(float f) { unsigned u = __builtin_bit_cast(unsigned, f); return (u + 0x7fffu + ((u >> 16) & 1u)) >> 16; }
__device__ __forceinline__ unsigned pk2(float lo, float hi) { return f2bf(lo) | (f2bf(hi) << 16); }

#define XB_TMO      128
#define XB_XCNT(j)  (256  + 64 * (j))
#define XB_XSUB(j)  (1280 + 64 * (j))
#define XB_XGEN(j)  (2304 + 64 * (j))
#define XB_TOP      3328
#define XB_TOPGEN   3392
#define XCD_BAR_WORDS 3456
#define XB_SPIN_CAP (1u << 18)

__device__ __forceinline__ unsigned xb_ld(unsigned* p)              { return __hip_atomic_load(p, __ATOMIC_RELAXED, __HIP_MEMORY_SCOPE_AGENT); }
__device__ __forceinline__ unsigned xb_add(unsigned* p, unsigned v) { return __hip_atomic_fetch_add(p, v, __ATOMIC_RELAXED, __HIP_MEMORY_SCOPE_AGENT); }
__device__ __forceinline__ unsigned xb_xcc_id() { return (unsigned)__builtin_amdgcn_s_getreg((3 << 11) | 20) & 0xFu; }
#define XB_SPIN(cond, bar) do { unsigned _sp = 0; while (cond) { __builtin_amdgcn_s_sleep(1); \
    if ((++_sp & 255u) == 0u) { if (xb_ld(&(bar)[XB_TMO])) break; if (_sp > XB_SPIN_CAP) { atomicAdd(&(bar)[XB_TMO], 1u); break; } } } } while (0)

struct XcdBarrier {
    unsigned* bar; unsigned x;
    volatile LAS unsigned* st;
};

__device__ __forceinline__ XcdBarrier xcd_barrier_post(unsigned* bar, volatile LAS unsigned* st) {
    XcdBarrier b; b.bar = bar; b.x = xb_xcc_id(); b.st = st;
    if (threadIdx.x == 0) (void)xb_add(&bar[XB_XCNT(b.x)], 1u);
    return b;
}
__device__ __forceinline__ void xcd_barrier_complete(unsigned* bar, unsigned x, unsigned& nloc, unsigned& nx) {
    const unsigned G = gridDim.x * gridDim.y * gridDim.z;
    unsigned sum, cnt, mine, sp = 0u;
    for (;;) {
        sum = 0u; cnt = 0u; mine = 0u;
#pragma unroll
        for (unsigned j = 0; j < 16; ++j) { const unsigned c = xb_ld(&bar[XB_XCNT(j)]); sum += c; cnt += (c > 0u) ? 1u : 0u; mine = (j == x) ? c : mine; }
        if (sum == G) break;
        __builtin_amdgcn_s_sleep(1);
        if ((++sp & 255u) == 0u) { if (xb_ld(&bar[XB_TMO])) break; if (sp > XB_SPIN_CAP) { atomicAdd(&bar[XB_TMO], 1u); break; } }
    }
    nloc = mine > 0u ? mine : 1u; nx = cnt > 0u ? cnt : 1u;
}

__device__ __forceinline__ void xcd_barrier(const XcdBarrier& b) {
    asm volatile("s_waitcnt vmcnt(0)" ::: "memory");
    __syncthreads();
    if (threadIdx.x == 0) {
        unsigned* bar = b.bar;
        __builtin_amdgcn_s_waitcnt(0);
        unsigned nloc = b.st[0], nx = b.st[1];
        if (nloc == 0u) { xcd_barrier_complete(bar, b.x, nloc, nx); b.st[0] = nloc; b.st[1] = nx; }
        const unsigned old = xb_add(&bar[XB_XSUB(b.x)], 1u);
        const unsigned gen = old / nloc;
        if (old + 1u == (gen + 1u) * nloc) {
            __builtin_amdgcn_fence(__ATOMIC_RELEASE, "agent");
            asm volatile("s_waitcnt vmcnt(0)" ::: "memory");
            const unsigned og = xb_add(&bar[XB_TOP], 1u);
            const unsigned tg = og / nx;
            if (og + 1u == (tg + 1u) * nx) xb_add(&bar[XB_TOPGEN], 1u);
            else XB_SPIN(xb_ld(&bar[XB_TOPGEN]) == tg, bar);
            __builtin_amdgcn_fence(__ATOMIC_ACQUIRE, "agent");
            xb_add(&bar[XB_XGEN(b.x)], 1u);
            asm volatile("s_waitcnt vmcnt(0)" ::: "memory");
        } else {
            XB_SPIN(xb_ld(&bar[XB_XGEN(b.x)]) == gen, bar);
            __builtin_amdgcn_fence(__ATOMIC_ACQUIRE, "agent");
            asm volatile("s_waitcnt vmcnt(0)" ::: "memory");
        }
    }
    __syncthreads();
}

constexpr int BATCH = 8, SEQ = 4096, D = 1024, M = BATCH * SEQ, NHEADS = 16, HDIM = 64;
constexpr int INC = 7184, N1 = 7168;
constexpr int PHEADS = 8, PNK = 128, PDK = 256, PTOPK = 16, NQP = PHEADS * PDK, NEXP = PNK * PNK, NSEL = PHEADS * PTOPK;
constexpr float EPS = 1e-6f, LOG2E = 1.4426950408889634f;
constexpr float U_SCALE = 800.f, V_SCALE = 16.f, A_SCALE = 32.f;
constexpr int NWAVES = 8;

constexpr size_t MiB = 1u << 20;
constexpr size_t WS_CTL = 0, CTL_ZERO_BYTES = 1 * MiB;
constexpr size_t WS_LOGF = 1 * MiB;
constexpr size_t WS_C2 = 3 * MiB;
constexpr size_t WS_K1 = 5 * MiB, WS_K2 = 5 * MiB + 256 * 1024;
constexpr size_t WS_WIN = 8 * MiB;
constexpr size_t WS_WC = 22 * MiB, WS_WF = 24 * MiB, WS_WO = 26 * MiB, WS_WQ = 28 * MiB;
constexpr size_t WS_U = 32 * MiB, WS_VT = 64 * MiB;
constexpr size_t WS_XN = 96 * MiB;
constexpr size_t WS_GLU = 160 * MiB;
constexpr size_t WS_QO = 224 * MiB, WS_K = 288 * MiB, WS_V = 352 * MiB;
constexpr size_t WS_QP = 96 * MiB;
constexpr size_t WS_IDX = 352 * MiB;
constexpr size_t WS_GATE = 360 * MiB;
constexpr size_t WS_ACT = 376 * MiB;
constexpr size_t WS_HHI = 224 * MiB, WS_HLO = 256 * MiB;
constexpr size_t WS_PART = 96 * MiB;
#ifndef PEER_SLICED
#define PEER_SLICED 1
#endif
constexpr size_t WS_END = 416 * MiB;

constexpr int CW_BAR = 4096, CW_ATTQ = 8192 + 64, CW_STAT = 16384, CW_RSS = 32768;

constexpr int RING_OFF = 0, RING_BYTES = 131072;
constexpr int LDS_BYTES = 155648, LDSCTL_OFF = 154624, MISC_OFF = LDSCTL_OFF + 320;
static_assert(MISC_OFF + 128 <= LDS_BYTES, "LDS map");

__device__ __forceinline__ float wave_sum(float v) {
#pragma unroll
    for (int o = 1; o < 64; o <<= 1) v += __shfl_xor(v, o);
    return v;
}
__device__ __forceinline__ float sigmoidf_(float x) { return __builtin_amdgcn_rcpf(1.f + __builtin_amdgcn_exp2f(-x * LOG2E)); }
__device__ __forceinline__ float bf_lo(unsigned v) { return __uint_as_float(v << 16); }
__device__ __forceinline__ float bf_hi(unsigned v) { return __uint_as_float(v & 0xffff0000u); }
typedef unsigned u32x2 __attribute__((ext_vector_type(2)));

__device__ __forceinline__ void p0_transpose_item(const float* W, int ldw, int col0, bf16* WT, int K, int drow0, LAS float* scr, int kb, int lane, const float* kscale = nullptr) {
    const int k0 = 64 * kb;
    float tv[32];
#pragma unroll
    for (int i = 0; i < 32; ++i) tv[i] = W[(size_t)(k0 + 2 * i + (lane >> 5)) * ldw + col0 + (lane & 31)];
    if (kscale) {
#pragma unroll
        for (int i = 0; i < 32; ++i) tv[i] *= kscale[k0 + 2 * i + (lane >> 5)]; }
#pragma unroll
    for (int i = 0; i < 32; ++i) scr[(2 * i + (lane >> 5)) * 33 + (lane & 31)] = tv[i];
    LDS_WAIT(); asm volatile("" ::: "memory");
    const int c = lane & 7;
#pragma unroll
    for (int j = 0; j < 4; ++j) { const int n = (lane >> 3) + 8 * j; const LAS float* s = scr + (8 * c) * 33 + n;
        v4u o; o.x = pk2(s[0 * 33], s[1 * 33]); o.y = pk2(s[2 * 33], s[3 * 33]); o.z = pk2(s[4 * 33], s[5 * 33]); o.w = pk2(s[6 * 33], s[7 * 33]);
        *(GAS v4u*)(WT + (size_t)(drow0 + n) * K + k0 + 8 * c) = o; }
    LDS_WAIT(); asm volatile("" ::: "memory");
}
__device__ __forceinline__ float log_sigmoid_(float z) { return fminf(z, 0.f) - log1pf(expf(-fabsf(z))); }

struct P0Args { const float *g2; const float *x, *g1, *w_in, *w_conv_out, *w_fox_out, *w_out, *peer_wq, *k1, *k2, *u, *v, *fox_bf;
                bf16 *WIN, *WC, *WF, *WO, *WQ, *K1b, *K2b; unsigned char *Uq, *Vq; bf16* XN; float* LOGF; };
constexpr int P0_I_U = NEXP * D / 4096;
__device__ __forceinline__ void p0_table_iter(const P0Args& a, int it, int lane) {
    f32x4 gq[4];
#pragma unroll
    for (int j = 0; j < 4; ++j) gq[j] = *(const GAS f32x4*)(a.g2 + 4 * lane + 256 * j);
    const bool isv = it >= P0_I_U; const int r = isv ? it - P0_I_U : it;
    const float* src = isv ? a.v : a.u; unsigned char* dst = isv ? a.Vq : a.Uq; const float sc = isv ? V_SCALE : U_SCALE;
    const size_t e0 = (size_t)r * 4096 + 4 * lane; f32x4 p[16];
#pragma unroll
    for (int k = 0; k < 16; ++k) p[k] = *(const GAS f32x4*)(src + e0 + 256 * k);
#pragma unroll
    for (int k = 0; k < 16; ++k) { f32x4 t = p[k] * sc; if (PEER_SLICED && !isv) t = t * gq[k & 3]; int w = __builtin_amdgcn_cvt_pk_fp8_f32(t.x, t.y, 0, false); w = __builtin_amdgcn_cvt_pk_fp8_f32(t.z, t.w, w, true);
        if (PEER_SLICED && !isv) {
            const int q0 = (int)__builtin_rintf(fminf(fmaxf(t.x, -127.f), 127.f)), q1 = (int)__builtin_rintf(fminf(fmaxf(t.y, -127.f), 127.f)), q2 = (int)__builtin_rintf(fminf(fmaxf(t.z, -127.f), 127.f)), q3 = (int)__builtin_rintf(fminf(fmaxf(t.w, -127.f), 127.f));
            w = (q0 & 0xff) | ((q1 & 0xff) << 8) | ((q2 & 0xff) << 16) | (q3 << 24); }
        const size_t ee = e0 + 256 * k;
        if (PEER_SLICED) { const size_t erow = ee >> 10; const int dcol = (int)(ee & 1023); *(GAS unsigned*)(dst + (size_t)(dcol >> 7) * ((size_t)NEXP * 128) + erow * 128 + (dcol & 127)) = (unsigned)w; }
        else *(GAS unsigned*)(dst + ee) = (unsigned)w; }
}
struct TableOrder {
    pg8::StaticOrder S; P0Args a; int gw, ngw, lane, slot; mutable int cnt = 0;
    __device__ __forceinline__ bool next(int i, pg8::Unit& u) const { return S.next(i, u); }
    __device__ __forceinline__ void a_ready(const pg8::Unit&) const {}
    __device__ __forceinline__ void done(const pg8::Unit&) const { const int d = cnt++ - slot;
        if (d >= 0 && d < 12 && d % 3 == 0) { const int it = gw + (d / 3) * ngw; if (it < 2 * P0_I_U) p0_table_iter(a, it, lane); } }
};
__device__ __forceinline__ void p0_prologue(LAS unsigned char* lds, const P0Args& a, int vcu, int G, int tid, int parts = 15) {
    const int lane = tid & 63, wave = __builtin_amdgcn_readfirstlane(tid >> 6);
    LAS float* scr = (LAS float*)(lds + wave * 8704);
    LAS float* wfT = (LAS float*)(lds + 69632);
    const int gw = vcu * NWAVES + wave, NGW = G * NWAVES;
#pragma unroll
    for (int c = tid; c < 4096; c += NWAVES * 64) { const int d = c >> 2, q4 = c & 3; const f32x4 t = *(const GAS f32x4*)(a.w_in + (size_t)d * INC + 5120 + 4 * q4);
        wfT[(4 * q4 + 0) * 1024 + d] = t.x; wfT[(4 * q4 + 1) * 1024 + d] = t.y; wfT[(4 * q4 + 2) * 1024 + d] = t.z; wfT[(4 * q4 + 3) * 1024 + d] = t.w; }
    __syncthreads();
    if (parts & 1) {
        const GAS f32x4* gp = (const GAS f32x4*)a.g1 + lane; f32x4 gv[4];
#pragma unroll
        for (int j = 0; j < 4; ++j) gv[j] = gp[64 * j];
        const float fb = a.fox_bf[(lane >> 2) & 15];
        for (int m0 = gw * 4; m0 < M; m0 += NGW * 4) {
            f32x4 va[4][4];
#pragma unroll
            for (int rr = 0; rr < 4; ++rr) { const GAS f32x4* xr = (const GAS f32x4*)(a.x + (size_t)(m0 + rr) * D) + lane;
#pragma unroll
                for (int j = 0; j < 4; ++j) va[rr][j] = xr[64 * j]; }
#pragma unroll
            for (int rr = 0; rr < 4; ++rr) {
            const int m = m0 + rr;
            f32x4 v[4]; float s = 0.f;
#pragma unroll
            for (int j = 0; j < 4; ++j) { v[j] = va[rr][j]; s += (v[j].x * v[j].x + v[j].y * v[j].y) + (v[j].z * v[j].z + v[j].w * v[j].w); }
            const float rstd = 1.0f / sqrtf(wave_sum(s) * (1.f / D) + EPS);
#pragma unroll
            for (int j = 0; j < 4; ++j) v[j] = v[j] * rstd * gv[j];
            GAS unsigned long long* o8 = (GAS unsigned long long*)(a.XN + (size_t)m * D) + lane;
#pragma unroll
            for (int j = 0; j < 4; ++j) o8[64 * j] = (unsigned long long)pk2(v[j].x, v[j].y) | ((unsigned long long)pk2(v[j].z, v[j].w) << 32);
            float fp[16];
#pragma unroll
            for (int jj = 0; jj < 16; ++jj) { float t = 0.f;
#pragma unroll
                for (int j = 0; j < 4; ++j) { const f32x4 w = *(const LAS f32x4*)(wfT + jj * 1024 + 256 * j + 4 * lane); t += (v[j].x * w.x + v[j].y * w.y) + (v[j].z * w.z + v[j].w * w.w); }
                fp[jj] = t; if (jj & 1) __builtin_amdgcn_sched_barrier(0); }
#pragma unroll
            for (int st = 0; st < 4; ++st) { const int msk = 32 >> st, n = 8 >> st; const bool up = (lane & msk) != 0;
#pragma unroll
                for (int i = 0; i < n; ++i) { float a_ = fp[i], b_ = fp[i + n]; asm volatile("" : "+v"(a_), "+v"(b_));
                    const float mine = up ? b_ : a_, theirs = up ? a_ : b_; fp[i] = mine + __shfl_xor(theirs, msk); } }
            float ft = fp[0]; ft += __shfl_xor(ft, 1); ft += __shfl_xor(ft, 2);
            if ((lane & 3) == 0) a.LOGF[(size_t)m * 16 + ((lane >> 2) & 15)] = log_sigmoid_(ft + fb);
            }
        }
    }
    if (parts & 2) for (int it = gw; it < 6144; it += NGW) {
        int r = it;
        if (r < 512)  { const int nb = r & 31, kb = r >> 5; p0_transpose_item(a.w_in, INC, 32 * nb, a.WIN, D, (nb >> 2) * 256 + (nb & 3) * 32, scr, kb, lane); continue; } r -= 512;
        if (r < 512)  { const int nb = r & 31, kb = r >> 5; p0_transpose_item(a.w_in, INC, 1024 + 32 * nb, a.WIN, D, (nb >> 2) * 256 + 128 + (nb & 3) * 32, scr, kb, lane); continue; } r -= 512;
        if (r < 1536) { const int nb = r % 96, kb = r / 96; p0_transpose_item(a.w_in, INC, 2048 + 32 * nb, a.WIN, D, 2048 + 32 * nb, scr, kb, lane); continue; } r -= 1536;
        if (r < 1024) { const int nb = r & 63, kb = r >> 6; p0_transpose_item(a.w_in, INC, 5136 + 32 * nb, a.WIN, D, 5120 + 32 * nb, scr, kb, lane); continue; } r -= 1024;
        if (r < 512)  { const int nb = r & 31, kb = r >> 5; p0_transpose_item(a.w_conv_out, D, 32 * nb, a.WC, D, 32 * nb, scr, kb, lane); continue; } r -= 512;
        if (r < 512)  { const int nb = r & 31, kb = r >> 5; p0_transpose_item(a.w_fox_out, D, 32 * nb, a.WF, D, 32 * nb, scr, kb, lane); continue; } r -= 512;
        if (r < 512)  { const int nb = r & 31, kb = r >> 5; p0_transpose_item(a.w_out, D, 32 * nb, a.WO, D, 32 * nb, scr, kb, lane); continue; } r -= 512;
        { const int nb = r & 63, kb = r >> 6; p0_transpose_item(a.peer_wq, NQP, 32 * nb, a.WQ, D, 32 * nb, scr, kb, lane, a.g2); }
    }
    constexpr int I_K = PHEADS * PNK * 128 / 512;
    if (parts & 4) for (int it = gw; it < 2 * I_K; it += NGW) {
        int r = it; const float* src; bf16* dst;
        if (r < I_K) { src = a.k1; dst = a.K1b; } else { r -= I_K; src = a.k2; dst = a.K2b; }
        const size_t e0 = (size_t)r * 512 + 8 * lane;
        const f32x4 p = *(const GAS f32x4*)(src + e0), q = *(const GAS f32x4*)(src + e0 + 4);
        v4u o; o.x = pk2(p.x, p.y); o.y = pk2(p.z, p.w); o.z = pk2(q.x, q.y); o.w = pk2(q.z, q.w);
        *(GAS v4u*)(dst + e0) = o;
    }
    if (parts & 8) for (int it = gw; it < 2 * P0_I_U; it += NGW) p0_table_iter(a, it, lane);
}

namespace pg8 {
struct EpiP1 {
    static constexpr bool PERM = true, AFTER_DRAIN = false;
    bf16_t *GLU, *Q, *K, *V, *GA, *GB; float qscale; unsigned* STAT;
    __device__ __forceinline__ void operator()(const f32x4 (&acc)[2][2][4][2], const Unit& u, int wr, int wc, int fr, int fq) const {
        const int row0 = u.pm * BM + wr * 64 + fr;
        if (u.pn < 8) {
            const int col = 128 * u.pn + wc * 32 + 8 * fq;
#pragma unroll
            for (int ai = 0; ai < 2; ++ai)
#pragma unroll
                for (int m = 0; m < 4; ++m) {
                    const f32x4 v0 = acc[ai][0][m][0], v1 = acc[ai][0][m][1], g0 = acc[ai][1][m][0], g1 = acc[ai][1][m][1];
                    u32x4 w;
                    w.x = cvt_pk_bf16(v0[0] * sigmoidf_(g0[0]), v0[1] * sigmoidf_(g0[1])); w.y = cvt_pk_bf16(v0[2] * sigmoidf_(g0[2]), v0[3] * sigmoidf_(g0[3]));
                    w.z = cvt_pk_bf16(v1[0] * sigmoidf_(g1[0]), v1[1] * sigmoidf_(g1[1])); w.w = cvt_pk_bf16(v1[2] * sigmoidf_(g1[2]), v1[3] * sigmoidf_(g1[3]));
                    *(u32x4*)(GLU + (size_t)(row0 + ai * HALF + m * 16) * 1024 + col) = w;
                }
        } else {
            const int t = (u.pn - 8) >> 2, colt = ((u.pn - 8) & 3) * 256 + wc * 32 + 8 * fq;
            bf16_t* base = t == 0 ? Q : t == 1 ? K : t == 2 ? V : t == 3 ? GA : GB;
            const float sc = t == 0 ? qscale : 1.f;
#pragma unroll
            for (int ai = 0; ai < 2; ++ai)
#pragma unroll
                for (int m = 0; m < 4; ++m) { bf16_t* rowp = base + (size_t)(row0 + ai * HALF + m * 16) * 1024 + colt;
#pragma unroll
                    for (int bj = 0; bj < 2; ++bj) { f32x4 v0 = acc[ai][bj][m][0], v1 = acc[ai][bj][m][1];
                        if (t >= 3) {
#pragma unroll
                            for (int i = 0; i < 4; ++i) { v0[i] = sigmoidf_(v0[i]); v1[i] = sigmoidf_(v1[i]); }
                        } else { v0 = v0 * sc; v1 = v1 * sc; }
                        u32x4 w; w.x = cvt_pk_bf16(v0[0], v0[1]); w.y = cvt_pk_bf16(v0[2], v0[3]); w.z = cvt_pk_bf16(v1[0], v1[1]); w.w = cvt_pk_bf16(v1[2], v1[3]);
                        *(u32x4*)(rowp + bj * HALF) = w; } }
            if (t <= 1) {
                float mx[2] = {0.f, 0.f};
#pragma unroll
                for (int ai = 0; ai < 2; ++ai)
#pragma unroll
                    for (int m = 0; m < 4; ++m)
#pragma unroll
                        for (int bj = 0; bj < 2; ++bj) { const f32x4 v0 = acc[ai][bj][m][0] * sc, v1 = acc[ai][bj][m][1] * sc;
                            float s = (v0[0] * v0[0] + v0[1] * v0[1]) + (v0[2] * v0[2] + v0[3] * v0[3]) + (v1[0] * v1[0] + v1[1] * v1[1]) + (v1[2] * v1[2] + v1[3] * v1[3]);
                            s += __shfl_xor(s, 16); s += __shfl_xor(s, 32); mx[bj] = fmaxf(mx[bj], s); }
#pragma unroll
                for (int bj = 0; bj < 2; ++bj) { float v = mx[bj];
#pragma unroll
                    for (int o = 1; o < 16; o <<= 1) v = fmaxf(v, __shfl_xor(v, o));
                    if ((fr | fq) == 0) atomicMax(STAT + ((u.pm >> 4) * 16 + ((u.pn - 8) & 3) * 4 + bj * 2 + (wc >> 1)) * 4 + 2 * t + (wc & 1), __float_as_uint(v)); }
            }
        }
    }
};
struct EpiDual {
    static constexpr bool PERM = true, AFTER_DRAIN = false;
    const bf16_t *GA, *GB; bf16_t* O;
    __device__ __forceinline__ void operator()(f32x4 (&acc)[2][2][4][2], const Unit& u, int wr, int wc, int fr, int fq) const {
        const int row0 = u.pm * BM + wr * 64 + fr, col0 = u.pn * BM + wc * 32 + 8 * fq;
#pragma unroll
        for (int ai = 0; ai < 2; ++ai)
#pragma unroll
            for (int m = 0; m < 4; ++m)
#pragma unroll
                for (int bj = 0; bj < 2; ++bj) {
                    const size_t off = (size_t)(row0 + ai * HALF + m * 16) * 1024 + col0 + bj * HALF;
                    const u32x4 gb = *(const u32x4*)(GB + off);
                    if (u.seg == 0) {
                        const u32x4 ga = *(const u32x4*)(GA + off);
#pragma unroll
                        for (int i = 0; i < 4; ++i) { const unsigned a_ = ga[i], b_ = gb[i]; const int n = i >> 1, e = (i & 1) * 2;
                            acc[ai][bj][m][n][e]     *= bf_lo(a_) * __builtin_amdgcn_rcpf(fmaxf(bf_lo(b_), 1e-30f));
                            acc[ai][bj][m][n][e + 1] *= bf_hi(a_) * __builtin_amdgcn_rcpf(fmaxf(bf_hi(b_), 1e-30f)); }
                    } else {
                        u32x4 w;
#pragma unroll
                        for (int i = 0; i < 4; ++i) { const unsigned b_ = gb[i]; const int n = i >> 1, e = (i & 1) * 2;
                            w[i] = cvt_pk_bf16(acc[ai][bj][m][n][e] * bf_lo(b_), acc[ai][bj][m][n][e + 1] * bf_hi(b_)); }
                        *(u32x4*)(O + off) = w;
                    }
                }
    }
};
struct DualOrder {
    StaticOrder S; int ntile, G, c;
    __device__ __forceinline__ void init(int M_, int N_, int G_, int c_) { S.init(M_, N_, G_, c_); ntile = S.nwg; G = G_; c = c_; }
    __device__ __forceinline__ bool next(int i, Unit& u) const { if (!S.next(i >> 1, u)) return false; u.seg = i & 1; return true; }
    __device__ __forceinline__ void a_ready(const Unit&) const {}
    __device__ __forceinline__ void done(const Unit&) const {}
};
typedef float pf32x2 __attribute__((ext_vector_type(2))); typedef unsigned pu32x2 __attribute__((ext_vector_type(2)));
struct EpiResNorm {
    static constexpr bool PERM = true, AFTER_DRAIN = false;
    const float* base; bf16_t* X1b; float* RSS; const float* g2; unsigned char *HHI, *HLO;
    __device__ __forceinline__ void operator()(const f32x4 (&acc)[2][2][4][2], const Unit& u, int wr, int wc, int fr, int fq) const {
        const int row0 = u.pm * BM + wr * 64 + fr, col0 = u.pn * BM + wc * 32 + 8 * fq;
#pragma unroll
        for (int ai = 0; ai < 2; ++ai)
#pragma unroll
            for (int m = 0; m < 4; ++m) { float ss = 0.f; const int row = row0 + ai * HALF + m * 16;
#pragma unroll
                for (int bj = 0; bj < 2; ++bj) {
                    const size_t off = (size_t)row * 1024 + col0 + bj * HALF;
                    const f32x4 x0 = *(const f32x4*)(base + off) + acc[ai][bj][m][0], x1 = *(const f32x4*)(base + off + 4) + acc[ai][bj][m][1];
                    ss += (x0[0] * x0[0] + x0[1] * x0[1]) + (x0[2] * x0[2] + x0[3] * x0[3]) + (x1[0] * x1[0] + x1[1] * x1[1]) + (x1[2] * x1[2] + x1[3] * x1[3]);
                    u32x4 w; w.x = cvt_pk_bf16(x0[0], x0[1]); w.y = cvt_pk_bf16(x0[2], x0[3]); w.z = cvt_pk_bf16(x1[0], x1[1]); w.w = cvt_pk_bf16(x1[2], x1[3]);
                    *(u32x4*)(X1b + off) = w;
                    if (HHI) {
                        const int cc = col0 + bj * HALF;
                        const f32x4 s0 = x0 * *(const f32x4*)(g2 + cc) * 16.f, s1 = x1 * *(const f32x4*)(g2 + cc + 4) * 16.f;
                        int a0 = __builtin_amdgcn_cvt_pk_fp8_f32(s0[0], s0[1], 0, false); a0 = __builtin_amdgcn_cvt_pk_fp8_f32(s0[2], s0[3], a0, true);
                        int a1 = __builtin_amdgcn_cvt_pk_fp8_f32(s1[0], s1[1], 0, false); a1 = __builtin_amdgcn_cvt_pk_fp8_f32(s1[2], s1[3], a1, true);
                        const pf32x2 d0 = __builtin_amdgcn_cvt_pk_f32_fp8(a0, false), d1 = __builtin_amdgcn_cvt_pk_f32_fp8(a0, true), d2 = __builtin_amdgcn_cvt_pk_f32_fp8(a1, false), d3 = __builtin_amdgcn_cvt_pk_f32_fp8(a1, true);
                        int b0 = __builtin_amdgcn_cvt_pk_fp8_f32((s0[0] - d0.x) * 16.f, (s0[1] - d0.y) * 16.f, 0, false); b0 = __builtin_amdgcn_cvt_pk_fp8_f32((s0[2] - d1.x) * 16.f, (s0[3] - d1.y) * 16.f, b0, true);
                        int b1 = __builtin_amdgcn_cvt_pk_fp8_f32((s1[0] - d2.x) * 16.f, (s1[1] - d2.y) * 16.f, 0, false); b1 = __builtin_amdgcn_cvt_pk_fp8_f32((s1[2] - d3.x) * 16.f, (s1[3] - d3.y) * 16.f, b1, true);
                        const size_t hoff = (size_t)(cc >> 7) * ((size_t)32768 * 128) + (size_t)row * 128 + (cc & 127);
                        *(pu32x2*)(HHI + hoff) = (pu32x2){(unsigned)a0, (unsigned)a1}; *(pu32x2*)(HLO + hoff) = (pu32x2){(unsigned)b0, (unsigned)b1};
                    }
                }
                ss += __shfl_xor(ss, 16); ss += __shfl_xor(ss, 32);
                if (fq == 0) unsafeAtomicAdd(RSS + row, ss);
            }
    }
};
struct EpiScaleRow {
    static constexpr bool PERM = true, AFTER_DRAIN = false;
    bf16_t* O; int ldc; const float* RSS;
    __device__ __forceinline__ void operator()(const f32x4 (&acc)[2][2][4][2], const Unit& u, int wr, int wc, int fr, int fq) const {
        const int row0 = u.pm * BM + wr * 64 + fr, col0 = u.pn * BM + wc * 32 + 8 * fq;
#pragma unroll
        for (int ai = 0; ai < 2; ++ai)
#pragma unroll
            for (int m = 0; m < 4; ++m) { const int row = row0 + ai * HALF + m * 16; const float rs = 1.0f / sqrtf(RSS[row] * (1.f / 1024.f) + 1e-6f);
#pragma unroll
                for (int bj = 0; bj < 2; ++bj) { const f32x4 v0 = acc[ai][bj][m][0] * rs, v1 = acc[ai][bj][m][1] * rs;
                    u32x4 w; w.x = cvt_pk_bf16(v0[0], v0[1]); w.y = cvt_pk_bf16(v0[2], v0[3]); w.z = cvt_pk_bf16(v1[0], v1[1]); w.w = cvt_pk_bf16(v1[2], v1[3]);
                    *(u32x4*)(O + (size_t)row * ldc + col0 + bj * HALF) = w; } }
    }
};
}

__device__ __forceinline__ void scan_unit(LAS unsigned char* lds, const float* LOGF, float* C2, int bh, int tid) {
    const int b = bh >> 4, h = bh & 15, lane = tid & 63, wave = tid >> 6;
    LAS float* wtot = (LAS float*)lds;
    float v[8]; float run = 0.f;
#pragma unroll
    for (int i = 0; i < 8; ++i) { run += LOGF[((size_t)b * SEQ + 8 * tid + i) * 16 + h]; v[i] = run; }
    float inc = run;
#pragma unroll
    for (int o = 1; o < 64; o <<= 1) { const float t = __shfl_up(inc, o); if (lane >= o) inc += t; }
    if (lane == 63) wtot[wave] = inc;
    __syncthreads();
    float base = inc - run;
    for (int w = 0; w < wave; ++w) base += wtot[w];
    f32x4 o0, o1;
    o0.x = (base + v[0]) * LOG2E; o0.y = (base + v[1]) * LOG2E; o0.z = (base + v[2]) * LOG2E; o0.w = (base + v[3]) * LOG2E;
    o1.x = (base + v[4]) * LOG2E; o1.y = (base + v[5]) * LOG2E; o1.z = (base + v[6]) * LOG2E; o1.w = (base + v[7]) * LOG2E;
    *(f32x4*)(C2 + (size_t)bh * SEQ + 8 * tid) = o0; *(f32x4*)(C2 + (size_t)bh * SEQ + 8 * tid + 4) = o1;
    __syncthreads();
}
__device__ __forceinline__ void conv_phase(LAS unsigned char* lds, const bf16* GLU, const float* conv_w, const float* conv_b, const float* ln_g, const float* ln_b, bf16* CZ, int vcu, int G, int tid) {
    typedef float f32x2 __attribute__((ext_vector_type(2)));
    LAS float* red = (LAS float*)lds;
    LAS float* fin = (LAS float*)(lds + 65536);
    const int lane = tid & 63;
    float w0[31], w1[31];
#pragma unroll
    for (int j = 0; j < 31; ++j) { const f32x2 t = *(const f32x2*)(conv_w + j * 1024 + 2 * tid); w0[j] = t.x; w1[j] = t.y; }
    const f32x2 cb = *(const f32x2*)(conv_b + 2 * tid), lg = *(const f32x2*)(ln_g + 2 * tid), lb = *(const f32x2*)(ln_b + 2 * tid);
    const unsigned* Gd = (const unsigned*)GLU; unsigned* Cd = (unsigned*)CZ;
    for (int tile = vcu; tile < M / 32; tile += G) {
        const int t0 = tile * 32, sloc = t0 & (SEQ - 1);
        unsigned in[62];
#pragma unroll
        for (int r = 0; r < 62; ++r) in[r] = (sloc - 30 + r >= 0) ? Gd[(size_t)(t0 - 30 + r) * 512 + tid] : 0u;
#pragma unroll
        for (int ch = 0; ch < 2; ++ch) {
            float o0[16], o1[16];
#pragma unroll
            for (int tt = 0; tt < 16; ++tt) { float a0 = cb.x, a1 = cb.y;
#pragma unroll
                for (int j = 0; j < 31; ++j) { const unsigned v = in[16 * ch + tt + j]; a0 += w0[j] * bf_lo(v); a1 += w1[j] * bf_hi(v); }
                o0[tt] = a0; o1[tt] = a1; red[tt * 512 + tid] = a0 + a1; red[(16 + tt) * 512 + tid] = a0 * a0 + a1 * a1; }
            __syncthreads();
            { const int st = tid >> 4, sg = tid & 15; float s = 0.f;
#pragma unroll
              for (int i = 0; i < 8; ++i) { const f32x4 t = *(const LAS f32x4*)(red + st * 512 + sg * 32 + 4 * i); s += (t.x + t.y) + (t.z + t.w); }
              s += __shfl_xor(s, 1); s += __shfl_xor(s, 2); s += __shfl_xor(s, 4); s += __shfl_xor(s, 8);
              if (sg == 0) fin[st] = s; }
            __syncthreads();
#pragma unroll
            for (int tt = 0; tt < 16; ++tt) {
                const float mean = fin[tt] * (1.f / 1024.f), var = fin[16 + tt] * (1.f / 1024.f) - mean * mean, rstd = 1.0f / sqrtf(fmaxf(var, 0.f) + EPS);
                const float y0 = (o0[tt] - mean) * rstd * lg.x + lb.x, y1 = (o1[tt] - mean) * rstd * lg.y + lb.y;
                Cd[(size_t)(t0 + 16 * ch + tt) * 512 + tid] = pk2(y0 * sigmoidf_(y0), y1 * sigmoidf_(y1));
            }
        }
    }
    (void)lane;
}

__device__ __forceinline__ void norm2_phase(const float* X1, const float* g2, bf16* H2, int gw, int NGW, int lane) {
    const GAS f32x4* gp = (const GAS f32x4*)g2 + lane; f32x4 gv[4];
#pragma unroll
    for (int j = 0; j < 4; ++j) gv[j] = gp[64 * j];
    for (int m = gw; m < M; m += NGW) {
        const GAS f32x4* xr = (const GAS f32x4*)(X1 + (size_t)m * D) + lane;
        f32x4 v[4]; float s = 0.f;
#pragma unroll
        for (int j = 0; j < 4; ++j) { v[j] = xr[64 * j]; s += (v[j].x * v[j].x + v[j].y * v[j].y) + (v[j].z * v[j].z + v[j].w * v[j].w); }
        const float rstd = 1.0f / sqrtf(wave_sum(s) * (1.f / D) + EPS);
        GAS unsigned long long* o8 = (GAS unsigned long long*)(H2 + (size_t)m * D) + lane;
#pragma unroll
        for (int j = 0; j < 4; ++j) { const f32x4 t = v[j] * rstd * gv[j]; o8[64 * j] = (unsigned long long)pk2(t.x, t.y) | ((unsigned long long)pk2(t.z, t.w) << 32); }
    }
}

typedef float f32x16 __attribute__((ext_vector_type(16)));
__device__ __forceinline__ unsigned f_ord(float f) { const unsigned b = __float_as_uint(f); return b ^ ((unsigned)((int)b >> 31) | 0x80000000u); }
__device__ __forceinline__ float f_unord(unsigned k) { return __uint_as_float((k & 0x80000000u) ? (k ^ 0x80000000u) : ~k); }
#define CE_DESC(a, b) do { const unsigned hi_ = (a) > (b) ? (a) : (b), lo_ = (a) > (b) ? (b) : (a); (a) = hi_; (b) = lo_; } while (0)
#define CE_ASC(a, b)  do { const unsigned hi_ = (a) > (b) ? (a) : (b), lo_ = (a) > (b) ? (b) : (a); (a) = lo_; (b) = hi_; } while (0)
__device__ __forceinline__ void sort16_desc(unsigned (&v)[16]) {
#pragma unroll
    for (int k = 2; k <= 16; k <<= 1)
#pragma unroll
        for (int j = k >> 1; j > 0; j >>= 1)
#pragma unroll
            for (int i = 0; i < 16; ++i) { const int l = i ^ j; if (l > i) { if ((i & k) == 0) CE_DESC(v[i], v[l]); else CE_ASC(v[i], v[l]); } }
}
__device__ __forceinline__ void merge16_desc(unsigned (&a)[16], const unsigned (&b)[16]) {
#pragma unroll
    for (int i = 0; i < 16; ++i) a[i] = a[i] > b[15 - i] ? a[i] : b[15 - i];
#pragma unroll
    for (int j = 8; j > 0; j >>= 1)
#pragma unroll
        for (int i = 0; i < 16; ++i) { const int l = i ^ j; if (l > i) CE_DESC(a[i], a[l]); }
}
__device__ __forceinline__ void xchg_merge16(unsigned (&a)[16]) {
    unsigned b[16];
#pragma unroll
    for (int i = 0; i < 16; ++i) { auto rr = __builtin_amdgcn_permlane32_swap(a[i], a[i], false, false); b[i] = (threadIdx.x & 32) ? rr[0] : rr[1]; }
    merge16_desc(a, b);
}
constexpr int RK_OFF = 8192, RK_ROWB = 272, RK_HALFB = 128 * RK_ROWB;
__device__ __forceinline__ void route_unit(LAS unsigned char* tabw, const LAS unsigned char* keys, const bf16* QP, unsigned short* IDX, float* GATE, int tok0, int head, int lane) {
    const int r = lane & 31, hi = lane >> 5;
    unsigned L[2][16];
    bf16x8 bqa[2][8];
#pragma unroll
    for (int half = 0; half < 2; ++half) { const bf16* qrow = QP + (size_t)(tok0 + r) * NQP + head * PDK + half * 128 + 8 * hi;
#pragma unroll
        for (int s = 0; s < 8; ++s) bqa[half][s] = *(const bf16x8*)(qrow + 16 * s); }
#pragma unroll
    for (int half = 0; half < 2; ++half) {
        const LAS unsigned char* kb = keys + half * RK_HALFB + r * RK_ROWB + 16 * hi;
        bf16x8 bq[8];
#pragma unroll
        for (int s = 0; s < 8; ++s) bq[s] = bqa[half][s];
        unsigned R[16];
#pragma unroll
        for (int i = 0; i < 16; ++i) R[i] = 0u;
#pragma unroll 1
        for (int nb = 0; nb < 4; ++nb) {
            f32x16 acc = f32x16{};
#pragma unroll
            for (int s = 0; s < 8; ++s) { const bf16x8 ak = *(const LAS bf16x8*)(kb + nb * 32 * RK_ROWB + 32 * s); acc = __builtin_amdgcn_mfma_f32_32x32x16_bf16(ak, bq[s], acc, 0, 0, 0); }
            unsigned g[16];
#pragma unroll
            for (int q = 0; q < 16; ++q) { const int n = 32 * nb + (q & 3) + 8 * (q >> 2) + 4 * hi; g[q] = (f_ord(acc[q]) & ~127u) | (unsigned)(127 - n); }
            sort16_desc(g);
            merge16_desc(R, g);
        }
        xchg_merge16(R);
#pragma unroll
        for (int i = 0; i < 16; ++i) L[half][i] = R[i];
    }
    {
        LAS unsigned* tp = (LAS unsigned*)(tabw + r * 32 + hi * 16);
#pragma unroll
        for (int d = 0; d < 4; ++d) { unsigned w = 0;
#pragma unroll
            for (int b = 0; b < 4; ++b) { const unsigned k1 = L[0][4 * d + b], k2 = L[1][4 * d + b]; const unsigned n = 127u - ((hi ? k2 : k1) & 127u); w |= n << (8 * b); }
            tp[d] = w; }
    }
    float F1[16], F2[16];
#pragma unroll
    for (int i = 0; i < 16; ++i) { F1[i] = f_unord(L[0][i] & ~127u); F2[i] = f_unord(L[1][i] & ~127u); }
    unsigned c0[16], c1[16];
#define CAND(dst, ai, aj, bi, bj) do { const float f1_ = hi ? F1[bi] : F1[ai], f2_ = hi ? F2[bj] : F2[aj]; \
        dst = (f_ord(f1_ + f2_) & ~255u) | (hi ? (unsigned)(255 - ((bi) * 16 + (bj))) : (unsigned)(255 - ((ai) * 16 + (aj)))); } while (0)
    CAND(c0[0], 0, 0, 1, 0);  CAND(c0[1], 0, 1, 1, 1);  CAND(c0[2], 0, 2, 1, 2);  CAND(c0[3], 0, 3, 1, 3);
    CAND(c0[4], 0, 4, 1, 4);  CAND(c0[5], 0, 5, 1, 5);  CAND(c0[6], 0, 6, 1, 6);  CAND(c0[7], 0, 7, 1, 7);
    CAND(c0[8], 0, 8, 2, 0);  CAND(c0[9], 0, 9, 2, 1);  CAND(c0[10], 0, 10, 2, 2); CAND(c0[11], 0, 11, 2, 3);
    CAND(c0[12], 0, 12, 2, 4); CAND(c0[13], 0, 13, 3, 0); CAND(c0[14], 0, 14, 3, 1); CAND(c0[15], 0, 15, 3, 2);
    CAND(c1[0], 8, 0, 3, 3);  CAND(c1[1], 9, 0, 4, 1);  CAND(c1[2], 10, 0, 4, 2); CAND(c1[3], 11, 0, 5, 0);
    CAND(c1[4], 12, 0, 5, 1); CAND(c1[5], 13, 0, 6, 0); CAND(c1[6], 14, 0, 6, 1); CAND(c1[7], 15, 0, 7, 0);
    CAND(c1[8], 4, 0, 7, 1);
#undef CAND
#pragma unroll
    for (int s = 9; s < 16; ++s) c1[s] = 0u;
    sort16_desc(c0); sort16_desc(c1); merge16_desc(c0, c1); xchg_merge16(c0);
    float sc[16]; float ssum = 0.f;
#pragma unroll
    for (int k = 0; k < 16; ++k) { sc[k] = __builtin_amdgcn_exp2f((f_unord(c0[k] & ~255u) - f_unord(c0[0] & ~255u)) * LOG2E); ssum += sc[k]; }
    const float rs = 1.0f / ssum;
    const LAS unsigned char* tb = (const LAS unsigned char*)(tabw + r * 32);
    unsigned ew[4]; f32x4 g0, g1;
#pragma unroll
    for (int kk = 0; kk < 8; ++kk) {
        unsigned ka_ = c0[kk], kb_ = c0[8 + kk]; float sa_ = sc[kk], sb_ = sc[8 + kk];
        asm volatile("" : "+v"(ka_), "+v"(kb_), "+v"(sa_), "+v"(sb_));
        const unsigned key = hi ? kb_ : ka_; const float gt = (hi ? sb_ : sa_) * rs;
        const unsigned code = 255u - (key & 255u); const unsigned e1 = tb[code >> 4], e2 = tb[16 + (code & 15u)];
        const unsigned e = e1 * 128u + e2;
        if (kk & 1) ew[kk >> 1] |= e << 16; else ew[kk >> 1] = e;
        if (kk < 4) g0[kk] = gt; else g1[kk - 4] = gt;
    }
    const size_t o = (size_t)(tok0 + r) * NSEL + head * PTOPK + 8 * hi;
    *(v4u*)(IDX + o) = (v4u){ew[0], ew[1], ew[2], ew[3]};
    *(f32x4*)(GATE + o) = g0; *(f32x4*)(GATE + o + 4) = g1;
}

__device__ __forceinline__ float gelu_tanh(float x) {
    const float y = 0.7978845608028654f * (x + 0.044715f * x * x * x);
    const float t = 1.f - 2.f * __builtin_amdgcn_rcpf(1.f + __builtin_amdgcn_exp2f(2.f * LOG2E * y));
    return 0.5f * x * (1.f + t);
}
__device__ __forceinline__ float dot8(v4u a, v4u b, float acc) {
#pragma unroll
    for (int i = 0; i < 4; ++i) { acc += bf_lo(a[i]) * bf_lo(b[i]); acc += bf_hi(a[i]) * bf_hi(b[i]); }
    return acc;
}
typedef float f32x2 __attribute__((ext_vector_type(2)));
template <int MODE = 0> __device__ __forceinline__ void peer_phase(LAS unsigned char* wl, const bf16* H2, const unsigned char* Uq, const unsigned char* Vq, const unsigned short* IDX, const float* GATE, const float* RSS, const float* g2, float* XO, const float* gf, int gw, int NGW, int lane, unsigned emask = 0xffffu, unsigned eor = 0u, float* ACTg = nullptr) {
    LAS unsigned* lid = (LAS unsigned*)wl; LAS float* la = (LAS float*)(wl + 512);
    float g2v[16];
#pragma unroll
    for (int i = 0; i < 16; ++i) g2v[i] = g2[16 * lane + i];
    for (int tok = gw; tok < M; tok += NGW) {
        const float rs_u = (1.f / U_SCALE) / sqrtf(RSS[tok] * (1.f / D) + EPS);
        float h[16], x1v[16];
        { const v4u hA = *(const v4u*)(H2 + (size_t)tok * D + 16 * lane), hB = *(const v4u*)(H2 + (size_t)tok * D + 16 * lane + 8);
#pragma unroll
          for (int i = 0; i < 4; ++i) { x1v[2 * i] = bf_lo(hA[i]); x1v[2 * i + 1] = bf_hi(hA[i]); x1v[8 + 2 * i] = bf_lo(hB[i]); x1v[8 + 2 * i + 1] = bf_hi(hB[i]); }
#pragma unroll
          for (int i = 0; i < 16; ++i) h[i] = x1v[i] * g2v[i]; }
        lid[lane] = (IDX[(size_t)tok * NSEL + lane] & emask) | eor; lid[64 + lane] = (IDX[(size_t)tok * NSEL + 64 + lane] & emask) | eor;
#pragma unroll 1
        for (int b = 0; b < ((MODE == 1 || MODE == 4) ? 0 : 8); ++b) {
            const float gate = GATE[(size_t)tok * NSEL + 16 * b + ((lane >> 2) & 15)];
            float p[16];
#pragma unroll
            for (int e = 0; e < 16; ++e) {
                const unsigned eid = (unsigned)__builtin_amdgcn_readfirstlane((int)lid[16 * b + e]);
                const v4u w = *(const v4u*)(Uq + (size_t)eid * D + 16 * lane);
                float s = 0.f;
#pragma unroll
                for (int j = 0; j < 4; ++j) { const f32x2 lo = __builtin_amdgcn_cvt_pk_f32_fp8((int)w[j], false), hi2 = __builtin_amdgcn_cvt_pk_f32_fp8((int)w[j], true);
                    s += lo.x * h[4 * j] + lo.y * h[4 * j + 1] + hi2.x * h[4 * j + 2] + hi2.y * h[4 * j + 3]; }
                p[e] = s;
            }
#pragma unroll
            for (int st = 0; st < 4; ++st) { const int msk = 32 >> st, n = 8 >> st; const bool up = (lane & msk) != 0;
#pragma unroll
                for (int i = 0; i < n; ++i) { const float mine = up ? p[i + n] : p[i], theirs = up ? p[i] : p[i + n]; p[i] = mine + __shfl_xor(theirs, msk); } }
            float d = p[0]; d += __shfl_xor(d, 1); d += __shfl_xor(d, 2);
            if ((lane & 3) == 0) la[16 * b + ((lane >> 2) & 15)] = gelu_tanh(d * rs_u) * gate * (1.f / V_SCALE);
        }
        if (MODE == 3) { ACTg[(size_t)tok * NSEL + lane] = la[lane]; ACTg[(size_t)tok * NSEL + 64 + lane] = la[64 + lane]; continue; }
        if (MODE == 4) { la[lane] = ACTg[(size_t)tok * NSEL + lane]; la[64 + lane] = ACTg[(size_t)tok * NSEL + 64 + lane]; }
        float o[16];
#pragma unroll
        for (int i = 0; i < 16; ++i) o[i] = 0.f;
#pragma unroll 1
        for (int b = 0; b < (MODE == 2 ? 0 : 16); ++b) {
#pragma unroll
            for (int e = 0; e < 8; ++e) {
                const unsigned eid = (unsigned)__builtin_amdgcn_readfirstlane((int)lid[8 * b + e]);
                const float a = la[8 * b + e];
                const v4u w = *(const v4u*)(Vq + (size_t)eid * D + 16 * lane);
#pragma unroll
                for (int j = 0; j < 4; ++j) { const f32x2 lo = __builtin_amdgcn_cvt_pk_f32_fp8((int)w[j], false), hi2 = __builtin_amdgcn_cvt_pk_f32_fp8((int)w[j], true);
                    o[4 * j] += a * lo.x; o[4 * j + 1] += a * lo.y; o[4 * j + 2] += a * hi2.x; o[4 * j + 3] += a * hi2.y; }
            }
        }
        float* xr = XO + (size_t)tok * D + 16 * lane; const float* gp = gf + 16 * lane;
        f32x4 xv[4]; float s = 0.f;
#pragma unroll
        for (int j = 0; j < 4; ++j) { xv[j] = (f32x4){x1v[4 * j], x1v[4 * j + 1], x1v[4 * j + 2], x1v[4 * j + 3]} + (f32x4){o[4 * j], o[4 * j + 1], o[4 * j + 2], o[4 * j + 3]}; s += (xv[j].x * xv[j].x + xv[j].y * xv[j].y) + (xv[j].z * xv[j].z + xv[j].w * xv[j].w); }
        const float rstd = 1.0f / sqrtf(wave_sum(s) * (1.f / D) + EPS);
#pragma unroll
        for (int j = 0; j < 4; ++j) *(f32x4*)(xr + 4 * j) = xv[j] * rstd * *(const f32x4*)(gp + 4 * j);
    }
}

template <int UVAR = 0> __device__ __forceinline__ void peer_u_phase(const unsigned char* Uq, const bf16* X1b, const float* g2, const unsigned short* IDX, bf16* PART, LAS unsigned char* wl, LAS unsigned char* obuf, int x, int wrank, int nwv, int lane) {
    const int ip = lane >> 3, jd = lane & 7;
    const unsigned char* usl = Uq + (size_t)x * ((size_t)NEXP * 128); const unsigned voff0 = 16u * (unsigned)jd;
    const int tpw = (M + nwv - 1) / nwv, tbeg = wrank * tpw, tend = (tbeg + tpw < M) ? tbeg + tpw : M;
    if (tbeg >= tend || (UVAR & 8)) return;
    LAS float* ob = (LAS float*)obuf;
    (void)g2;
#define PU_STAGE(t0) do { const int t0_ = (t0); v4u si_[4], sx_[4]; \
        _Pragma("unroll") for (int j_ = 0; j_ < 4; ++j_) { si_[j_] = *(const v4u*)((const unsigned char*)IDX + (size_t)t0_ * 256 + 1024 * j_ + 16 * lane); \
            const int ta_ = (t0_ + 4 * j_ + (lane >> 4) < M) ? t0_ + 4 * j_ + (lane >> 4) : M - 1; sx_[j_] = *(const v4u*)(X1b + (size_t)ta_ * D + 128 * x + 8 * (lane & 15)); } \
        _Pragma("unroll") for (int j_ = 0; j_ < 4; ++j_) { *(LAS v4u*)(wl + 1024 * j_ + 16 * lane) = si_[j_]; \
              \
            float hf_[8]; _Pragma("unroll") for (int i_ = 0; i_ < 4; ++i_) { hf_[2 * i_] = bf_lo(sx_[j_][i_]); hf_[2 * i_ + 1] = bf_hi(sx_[j_][i_]); } \
            float am_ = fmaxf(fmaxf(fmaxf(fabsf(hf_[0]), fabsf(hf_[1])), fmaxf(fabsf(hf_[2]), fabsf(hf_[3]))), fmaxf(fmaxf(fabsf(hf_[4]), fabsf(hf_[5])), fmaxf(fabsf(hf_[6]), fabsf(hf_[7])))); \
            _Pragma("unroll") for (int m_ = 1; m_ < 16; m_ <<= 1) am_ = fmaxf(am_, __shfl_xor(am_, m_)); \
            am_ = fmaxf(am_, 1e-20f); const float qs_ = 127.f / am_; \
            int q_[8]; _Pragma("unroll") for (int i_ = 0; i_ < 8; ++i_) q_[i_] = (int)__builtin_rintf(hf_[i_] * qs_); \
            const unsigned w0_ = (unsigned)((q_[0] & 0xff) | ((q_[1] & 0xff) << 8) | ((q_[2] & 0xff) << 16) | (q_[3] << 24)), w1_ = (unsigned)((q_[4] & 0xff) | ((q_[5] & 0xff) << 8) | ((q_[6] & 0xff) << 16) | (q_[7] << 24)); \
            *(LAS u32x2*)(wl + 4096 + (4 * j_ + (lane >> 4)) * 128 + 8 * (lane & 15)) = (u32x2){w0_, w1_}; \
            *(LAS float*)(wl + 6144 + 4 * (4 * j_ + (lane >> 4))) = am_ * (1.f / 127.f); } } while (0)
#define PU_EID(i0, i1, ld) (((ld) < 8) ? (((ld) & 1) ? (i0[((ld) & 7) >> 1] >> 16) : (i0[((ld) & 7) >> 1] & 0xffffu)) : (((ld) & 1) ? (i1[((ld) & 7) >> 1] >> 16) : (i1[((ld) & 7) >> 1] & 0xffffu)))
#define PU_ROWS(sl, wv) do { const v4u i0_ = *(const LAS v4u*)(wl + (sl) * 256 + 32 * ip), i1_ = *(const LAS v4u*)(wl + (sl) * 256 + 32 * ip + 16); \
        _Pragma("unroll") for (int ld = 0; ld < 16; ++ld) wv[ld] = *(const v4u*)(usl + (PU_EID(i0_, i1_, ld) * 128u + voff0)); \
        __builtin_amdgcn_sched_barrier(0); } while (0)
#define PU_COMPUTE(wv, sl) do { \
        const v4u hq_ = *(const LAS v4u*)(wl + 4096 + (sl) * 128 + 16 * jd); const float hs_ = *(const LAS float*)(wl + 6144 + 4 * (sl)); \
        int p[16]; \
        _Pragma("unroll") for (int ld = 0; ld < 16; ++ld) { const v4u w = wv[ld]; int a_ = 0; \
            _Pragma("unroll") for (int j = 0; j < 4; ++j) a_ = __builtin_amdgcn_sdot4((int)w[j], (int)hq_[j], a_, false); \
            p[ld] = a_; } \
          \
        _Pragma("unroll") for (int st = 0; st < 3; ++st) { const int msk = 4 >> st, n = 8 >> st; const bool up = (lane & msk) != 0; \
            _Pragma("unroll") for (int j = 0; j < n; ++j) { int a_ = p[j], b_ = p[j + n]; asm volatile("" : "+v"(a_), "+v"(b_)); const int mine = up ? b_ : a_, theirs = up ? a_ : b_; p[j] = mine + __shfl_xor(theirs, msk); } } \
        *(LAS f32x2*)(ob + (sl) * 128 + 16 * ip + 8 * ((jd >> 2) & 1) + 4 * ((jd >> 1) & 1) + 2 * (jd & 1)) = (f32x2){(float)p[0] * hs_, (float)p[1] * hs_}; \
        __builtin_amdgcn_sched_barrier(0); \
    } while (0)
    for (int t0 = tbeg; t0 < tend; t0 += 16) {
        const int nb = (tend - t0 < 16) ? tend - t0 : 16;
        PU_STAGE(t0);
        v4u wA[16], wB[16];
        PU_ROWS(0, wA);
        if (nb == 16) {
#pragma unroll
            for (int s = 0; s < 16; s += 2) {
                PU_ROWS(s + 1, wB);
                PU_COMPUTE(wA, s);
                if (s + 2 < 16) PU_ROWS(s + 2, wA);
                PU_COMPUTE(wB, s + 1);
            }
        } else {
#pragma unroll 1
            for (int s = 0; s < nb; ++s) { PU_ROWS(s, wA); PU_COMPUTE(wA, s); }
        }
        { bf16* dst_ = PART + ((size_t)x * M + t0) * NSEL; const int n8_ = nb * 16;
#pragma unroll
          for (int j = 0; j < 4; ++j) { const int c_ = j * 64 + lane; if (c_ < n8_) { const f32x4 a_ = *(const LAS f32x4*)(ob + 8 * c_), b_ = *(const LAS f32x4*)(ob + 8 * c_ + 4);
              *(v4u*)(dst_ + 8 * c_) = (v4u){pk2(a_.x, a_.y), pk2(a_.z, a_.w), pk2(b_.x, b_.y), pk2(b_.z, b_.w)}; } } }
    }
#undef PU_STAGE
#undef PU_EID
#undef PU_ROWS
#undef PU_COMPUTE
}
__device__ __forceinline__ void peer_c_phase(const bf16* PART, const float* GATE, const float* RSS, bf16* ACT, int gtid, int ngt) {
    constexpr int NIT = M * (NSEL / 8);
    for (int it0 = gtid; it0 < NIT; it0 += 2 * ngt) {
        v4u pv[2][8]; f32x4 g0[2], g1[2]; float rss[2];
#pragma unroll
        for (int u = 0; u < 2; ++u) { const int it = (it0 + u * ngt < NIT) ? it0 + u * ngt : it0, tok = it >> 4, k8 = (it & 15) * 8;
#pragma unroll
            for (int xx = 0; xx < 8; ++xx) pv[u][xx] = *(const v4u*)(PART + ((size_t)xx * M + tok) * NSEL + k8);
            g0[u] = *(const f32x4*)(GATE + (size_t)tok * NSEL + k8); g1[u] = *(const f32x4*)(GATE + (size_t)tok * NSEL + k8 + 4); rss[u] = RSS[tok]; }
#pragma unroll
        for (int u = 0; u < 2; ++u) { const int it = (it0 + u * ngt < NIT) ? it0 + u * ngt : it0, tok = it >> 4, k8 = (it & 15) * 8;
            const float rs = (1.f / U_SCALE) / sqrtf(rss[u] * (1.f / D) + EPS);
            float s[8];
#pragma unroll
            for (int i = 0; i < 8; ++i) s[i] = 0.f;
#pragma unroll
            for (int xx = 0; xx < 8; ++xx)
#pragma unroll
                for (int i = 0; i < 4; ++i) { s[2 * i] += bf_lo(pv[u][xx][i]); s[2 * i + 1] += bf_hi(pv[u][xx][i]); }
            float o[8];
#pragma unroll
            for (int i = 0; i < 4; ++i) { o[i] = fminf(gelu_tanh(s[i] * rs) * g0[u][i] * A_SCALE, 440.f); o[4 + i] = fminf(gelu_tanh(s[4 + i] * rs) * g1[u][i] * A_SCALE, 440.f); }
            int w0 = __builtin_amdgcn_cvt_pk_fp8_f32(o[0], o[1], 0, false); w0 = __builtin_amdgcn_cvt_pk_fp8_f32(o[2], o[3], w0, true);
            int w1 = __builtin_amdgcn_cvt_pk_fp8_f32(o[4], o[5], 0, false); w1 = __builtin_amdgcn_cvt_pk_fp8_f32(o[6], o[7], w1, true);
            *(u32x2*)((unsigned char*)ACT + (size_t)tok * NSEL + k8) = (u32x2){(unsigned)w0, (unsigned)w1}; }
    }
}
__device__ __forceinline__ void peer_v_phase(const unsigned char* Vq, const unsigned short* IDX, const bf16* ACT, bf16* PO, LAS unsigned char* wl, LAS unsigned char* obuf, int x, int wrank, int nwv, int lane) {
    const int ip = lane >> 3, jd = lane & 7;
    const unsigned char* vsl = Vq + (size_t)x * ((size_t)NEXP * 128); const unsigned voff0 = 16u * (unsigned)jd;
    const int tpw = (M + nwv - 1) / nwv, tbeg = wrank * tpw, tend = (tbeg + tpw < M) ? tbeg + tpw : M;
    if (tbeg >= tend) return;
    LAS float* ob = (LAS float*)obuf;
#define PV_STAGE(t0) do { const int t0_ = (t0); \
        const v4u s0_ = *(const v4u*)((const unsigned char*)IDX + (size_t)t0_ * 256 + 16 * lane), s1_ = *(const v4u*)((const unsigned char*)IDX + (size_t)t0_ * 256 + 1024 + 16 * lane); \
        const v4u s2a_ = *(const v4u*)((const unsigned char*)IDX + (size_t)t0_ * 256 + 2048 + 16 * lane), s3a_ = *(const v4u*)((const unsigned char*)IDX + (size_t)t0_ * 256 + 3072 + 16 * lane); \
        const v4u a0_ = *(const v4u*)((const unsigned char*)ACT + (size_t)t0_ * 128 + 16 * lane), a1_ = *(const v4u*)((const unsigned char*)ACT + (size_t)t0_ * 128 + 1024 + 16 * lane); \
        *(LAS v4u*)(wl + 16 * lane) = s0_; *(LAS v4u*)(wl + 1024 + 16 * lane) = s1_; *(LAS v4u*)(wl + 2048 + 16 * lane) = s2a_; *(LAS v4u*)(wl + 3072 + 16 * lane) = s3a_; \
        *(LAS v4u*)(wl + 4096 + 16 * lane) = a0_; *(LAS v4u*)(wl + 5120 + 16 * lane) = a1_; } while (0)
#define PV_EID(i0, i1, ld) (((ld) < 8) ? (((ld) & 1) ? (i0[((ld) & 7) >> 1] >> 16) : (i0[((ld) & 7) >> 1] & 0xffffu)) : (((ld) & 1) ? (i1[((ld) & 7) >> 1] >> 16) : (i1[((ld) & 7) >> 1] & 0xffffu)))
#define PV_ROWS(sl, wv) do { const v4u i0_ = *(const LAS v4u*)(wl + (sl) * 256 + 32 * ip), i1_ = *(const LAS v4u*)(wl + (sl) * 256 + 32 * ip + 16); \
        _Pragma("unroll") for (int ld = 0; ld < 16; ++ld) wv[ld] = *(const v4u*)(vsl + (PV_EID(i0_, i1_, ld) * 128u + voff0)); \
        __builtin_amdgcn_sched_barrier(0); } while (0)
#define PV_COMPUTE(wv, sl) do { \
          \
        const v4u ab_ = *(const LAS v4u*)(wl + 4096 + (sl) * 128 + 16 * ip); \
        f32x4 c1_ = (f32x4){0.f, 0.f, 0.f, 0.f}, c2_ = (f32x4){0.f, 0.f, 0.f, 0.f}; \
        _Pragma("unroll") for (int ld = 0; ld < 16; ++ld) { const unsigned sft_ = ((ab_[ld >> 2] >> (8 * (ld & 3))) & 0xffu) << sh8; \
            const unsigned alo_ = jhi ? 0u : sft_, ahi_ = jhi ? sft_ : 0u; \
            const long A_ = (long)(((unsigned long long)ahi_ << 32) | alo_); const v4u w = wv[ld]; \
            c1_ = __builtin_amdgcn_mfma_f32_16x16x32_fp8_fp8(A_, (long)(((unsigned long long)w.y << 32) | w.x), c1_, 0, 0, 0); \
            c2_ = __builtin_amdgcn_mfma_f32_16x16x32_fp8_fp8(A_, (long)(((unsigned long long)w.w << 32) | w.z), c2_, 0, 0, 0); } \
        float r_[8] = {c1_[0], c1_[1], c1_[2], c1_[3], c2_[0], c2_[1], c2_[2], c2_[3]}; \
        _Pragma("unroll") for (int i = 0; i < 8; ++i) r_[i] = (r_[i] + __shfl(r_[i], plane)) * (1.f / (A_SCALE * V_SCALE)); \
        { LAS unsigned char* op_ = obase + (sl) * ostride; *(LAS f32x4*)op_ = (f32x4){r_[0], r_[1], r_[2], r_[3]}; *(LAS f32x4*)(op_ + 32) = (f32x4){r_[4], r_[5], r_[6], r_[7]}; } \
        __builtin_amdgcn_sched_barrier(0); \
    } while (0)
    const unsigned sh8 = 8u * (unsigned)(jd & 3); const bool jhi = (jd & 4) != 0; const int plane = (lane + 40) & 63;
    const bool ovalid = ((lane & 15) < 8) && (lane < 32);
    LAS unsigned char* obase = ovalid ? obuf + 4 * (16 * (lane & 15) + 4 * (lane >> 4)) : wl + 6144 + 16 * lane; const int ostride = ovalid ? 512 : 0;
    for (int t0 = tbeg; t0 < tend; t0 += 16) {
        const int nb = (tend - t0 < 16) ? tend - t0 : 16;
        PV_STAGE(t0);
        v4u wA[16], wB[16];
        PV_ROWS(0, wA);
        if (nb == 16) {
#pragma unroll
            for (int s = 0; s < 16; s += 2) {
                PV_ROWS(s + 1, wB);
                PV_COMPUTE(wA, s);
                if (s + 2 < 16) PV_ROWS(s + 2, wA);
                PV_COMPUTE(wB, s + 1);
            }
        } else {
#pragma unroll 1
            for (int s = 0; s < nb; ++s) { PV_ROWS(s, wA); PV_COMPUTE(wA, s); }
        }
        { bf16* dst_ = PO + ((size_t)x * M + t0) * 128; const int n8_ = nb * 16;
#pragma unroll
          for (int j = 0; j < 4; ++j) { const int c_ = j * 64 + lane; if (c_ < n8_) { const f32x4 a_ = *(const LAS f32x4*)(ob + 8 * c_), b_ = *(const LAS f32x4*)(ob + 8 * c_ + 4);
              *(v4u*)(dst_ + 8 * c_) = (v4u){pk2(a_.x, a_.y), pk2(a_.z, a_.w), pk2(b_.x, b_.y), pk2(b_.z, b_.w)}; } } }
    }
#undef PV_STAGE
#undef PV_EID
#undef PV_ROWS
#undef PV_COMPUTE
}
__device__ __forceinline__ void peer_f_phase(const bf16* X1b, const bf16* PO, float* XO, const float* gf, int gw, int NGW, int lane) {
    const GAS f32x4* gp = (const GAS f32x4*)gf + lane; f32x4 gv[4];
#pragma unroll
    for (int j = 0; j < 4; ++j) gv[j] = gp[64 * j];
    for (int m = gw; m < M; m += NGW) {
        GAS f32x4* xr = (GAS f32x4*)(XO + (size_t)m * D) + lane;
        f32x4 v[4]; float s = 0.f;
#pragma unroll
        for (int j = 0; j < 4; ++j) { const int dd = 4 * lane + 256 * j; const u32x2 xb = *(const u32x2*)(X1b + (size_t)m * D + dd);
            const u32x2 pb = *(const u32x2*)(PO + ((size_t)(dd >> 7) * M + m) * 128 + (dd & 127));
            v[j] = (f32x4){bf_lo(xb.x), bf_hi(xb.x), bf_lo(xb.y), bf_hi(xb.y)} + (f32x4){bf_lo(pb.x), bf_hi(pb.x), bf_lo(pb.y), bf_hi(pb.y)};
            s += (v[j].x * v[j].x + v[j].y * v[j].y) + (v[j].z * v[j].z + v[j].w * v[j].w); }
        const float rstd = 1.0f / sqrtf(wave_sum(s) * (1.f / D) + EPS);
#pragma unroll
        for (int j = 0; j < 4; ++j) xr[64 * j] = v[j] * rstd * gv[j];
    }
}

#ifndef PEER_SPLIT
#define PEER_SPLIT 0
#endif
constexpr int N_PHASES = PEER_SLICED ? 12 : (PEER_SPLIT ? 10 : 9);
#ifndef MK_FUSED
#define MK_FUSED 1
#endif
struct Args { const float* in[18]; float* out; unsigned char* ws; int ph_lo, ph_hi; };
__global__ void __launch_bounds__(NWAVES * 64, 2) hyb_fwd(Args args) {
    extern __shared__ __attribute__((aligned(16))) unsigned char lds[];
    LAS unsigned char* L = (LAS unsigned char*)lds;
    volatile LAS unsigned* MISC = (volatile LAS unsigned*)(L + MISC_OFF);
    const int tid = threadIdx.x, lane = tid & 63, wave = __builtin_amdgcn_readfirstlane(tid >> 6);
    const int G = gridDim.x; const int bx = blockIdx.x; const int vcu = (G % 8 == 0) ? (bx % 8) * (G / 8) + bx / 8 : bx;
    const int gw = vcu * NWAVES + wave, NGW = G * NWAVES;
    unsigned char* ws = args.ws;
    gu32* ctl = (gu32*)(ws + WS_CTL);
    const float* x = args.in[0]; float* out = args.out;
    bf16 *WIN = (bf16*)(ws + WS_WIN), *WC = (bf16*)(ws + WS_WC), *WF = (bf16*)(ws + WS_WF), *WO = (bf16*)(ws + WS_WO), *WQ = (bf16*)(ws + WS_WQ);
    bf16 *K1b = (bf16*)(ws + WS_K1), *K2b = (bf16*)(ws + WS_K2); unsigned char *Uq = ws + WS_U, *Vq = ws + WS_VT;
    bf16 *XN = (bf16*)(ws + WS_XN), *CZ = XN, *GLU = (bf16*)(ws + WS_GLU), *MM = GLU, *QO = (bf16*)(ws + WS_QO), *KB = (bf16*)(ws + WS_K), *H2 = KB, *VB = (bf16*)(ws + WS_V);
    bf16 *QP = (bf16*)(ws + WS_QP), *GA = (bf16*)out, *GB = (bf16*)out + (size_t)M * D;
    float *LOGF = (float*)(ws + WS_LOGF), *C2 = (float*)(ws + WS_C2), *GATE = (float*)(ws + WS_GATE);
    unsigned short* IDX = (unsigned short*)(ws + WS_IDX);
    for (int u = tid; u < (LDS_BYTES - LDSCTL_OFF) / 4; u += NWAVES * 64) ((LAS unsigned*)(L + LDSCTL_OFF))[u] = 0u;
    __syncthreads();
#if MK_FUSED
    XcdBarrier bar = xcd_barrier_post((unsigned*)(ctl + CW_BAR), MISC + 8);
#define GRID_BAR() xcd_barrier(bar)
#else
#define GRID_BAR() do {} while (0)
    (void)MISC; (void)ctl;
#endif
    const int lo = args.ph_lo, hi = args.ph_hi;
#ifdef ONLY_PHASE
#define IN(k) ((k) == ONLY_PHASE)
#else
#define IN(k) (lo <= (k) && (k) < hi)
#endif
#define BOTH(k) (IN(k) && IN((k) + 1))
#ifdef REP_PHASE
#define REPS(k) for (int rep_ = ((k) == REP_PHASE) ? 0 : 1; rep_ < 2; ++rep_)
#define REP_BAR() do { if (rep_ == 0) GRID_BAR(); } while (0)
#else
#define REPS(k)
#define REP_BAR() do {} while (0)
constexpr int rep_ = 1;
#endif
#ifndef P0_PARTS
#define P0_PARTS 15
#endif
#ifndef TABLES_IN_GEMM1
#define TABLES_IN_GEMM1 1
#endif
#ifndef REP_EMASK
#define REP_EMASK 0xffffu
#define REP_ESTRIDE 0u
#endif

    if (IN(0)) REPS(0) {
        P0Args a{args.in[11], x, args.in[1], args.in[2], args.in[7], args.in[9], args.in[10], args.in[12], args.in[13], args.in[14], args.in[15], args.in[16], args.in[8],
                 WIN, WC, WF, WO, WQ, K1b, K2b, Uq, Vq, XN, LOGF};
        p0_prologue(L, a, vcu, G, tid, rep_ ? (TABLES_IN_GEMM1 ? 7 : 15) : P0_PARTS); REP_BAR();
        if (rep_ && BOTH(0)) GRID_BAR();
    }
    if (IN(1)) REPS(1) {
        pg8::Gemm g{XN, XN, WIN, WIN, M, N1, D}; pg8::StaticOrder S; S.init(M, N1, G, bx);
        pg8::EpiP1 E{GLU, QO, KB, VB, GA, GB, attn_body::C2, (unsigned*)(ctl + CW_STAT)};
#if TABLES_IN_GEMM1
        TableOrder TS{S, P0Args{args.in[11], x, args.in[1], args.in[2], args.in[7], args.in[9], args.in[10], args.in[12], args.in[13], args.in[14], args.in[15], args.in[16], args.in[8],
                                WIN, WC, WF, WO, WQ, K1b, K2b, Uq, Vq, XN, LOGF}, vcu * NWAVES + wave, G * NWAVES, lane, (vcu >> 3) % 3};
        pg8::gemm_phase<pg8::EpiP1, TableOrder, true, true>(L + RING_OFF, g, TS, E); REP_BAR();
#else
        pg8::gemm_phase<pg8::EpiP1, pg8::StaticOrder, true, true>(L + RING_OFF, g, S, E); REP_BAR();
#endif
        if (rep_ && BOTH(1)) GRID_BAR();
    }
    if (IN(2)) REPS(2) {
        for (int bh = vcu; bh < BATCH * NHEADS; bh += G) scan_unit(L, LOGF, C2, bh, tid);
        conv_phase(L, GLU, args.in[3], args.in[4], args.in[5], args.in[6], CZ, vcu, G, tid); REP_BAR();
        if (rep_ && BOTH(2)) GRID_BAR();
    }
    if (IN(3)) REPS(3) {
        const attn_body::AttnTensors AT{(const attn_body::bf16*)QO, (const attn_body::bf16*)KB, (const attn_body::bf16*)VB, (attn_body::bf16*)(rep_ ? QO : GLU), C2};
#if MK_FUSED
        attn_body::attn_phase_queue<8>((char*)lds + RING_OFF, AT, (unsigned*)(ctl + CW_ATTQ) + (rep_ ? 0 : 64), (const float*)(ctl + CW_STAT), LDSCTL_OFF + 64); REP_BAR();
#else
        const attn_body::StaticOrder S(G, bx);
        attn_body::attn_phase<attn_body::StaticOrder>((char*)lds + RING_OFF, AT, S); REP_BAR();
#endif
        if (rep_ && BOTH(3)) GRID_BAR();
    }
    if (IN(4)) REPS(4) {
        pg8::Gemm g{CZ, QO, WC, WF, M, D, D}; pg8::DualOrder S; S.init(M, D, G, bx);
        pg8::EpiDual E{GA, GB, MM};
        pg8::gemm_phase<pg8::EpiDual, pg8::DualOrder, true, true>(L + RING_OFF, g, S, E); REP_BAR();
        if (rep_ && BOTH(4)) GRID_BAR();
    }
    if (IN(5)) REPS(5) {
        pg8::Gemm g{MM, MM, WO, WO, M, D, D}; pg8::StaticOrder S; S.init(M, D, G, bx);
        pg8::EpiResNorm E{x, H2, (float*)(ctl + CW_RSS), args.in[11], nullptr, nullptr};
        pg8::gemm_phase<pg8::EpiResNorm, pg8::StaticOrder, true, true>(L + RING_OFF, g, S, E); REP_BAR();
        if (rep_ && BOTH(5)) GRID_BAR();
    }
    if (IN(6)) REPS(6) {
        pg8::Gemm g{H2, H2, WQ, WQ, M, NQP, D}; pg8::StaticOrder S; S.init(M, NQP, G, bx);
        pg8::EpiScaleRow E{QP, NQP, (const float*)(ctl + CW_RSS)};
        pg8::gemm_phase<pg8::EpiScaleRow, pg8::StaticOrder, true, true>(L + RING_OFF, g, S, E); REP_BAR();
        if (rep_ && BOTH(6)) GRID_BAR();
    }
    if (IN(7)) REPS(7) {
        const int head = bx & 7, nwg_h = (G - head + 7) >> 3;
        for (int ci = tid; ci < 4096; ci += NWAVES * 64) { const int half = ci >> 11, row = (ci >> 4) & 127, c16 = ci & 15;
            *(LAS v4u*)(L + RK_OFF + half * RK_HALFB + row * RK_ROWB + c16 * 16) = *(const v4u*)((half ? K2b : K1b) + (size_t)(head * PNK + row) * 128 + c16 * 8); }
        __syncthreads();
        for (int tg = (bx >> 3) * NWAVES + wave; tg < M / 32; tg += nwg_h * NWAVES) route_unit(L + wave * 1024, L + RK_OFF, QP, IDX, GATE, tg * 32, head, lane);
        __syncthreads(); REP_BAR();
        if (rep_ && BOTH(7)) GRID_BAR();
    }
#if PEER_SLICED
    {
        const int xs = bx & 7, nwg_x = (G - xs + 7) >> 3, wrank = (bx >> 3) * NWAVES + wave, nwv = nwg_x * NWAVES;
        bf16 *PART = (bf16*)(ws + WS_PART), *PO = (bf16*)(ws + WS_PART), *ACT = (bf16*)(ws + WS_ACT);
        if (IN(8)) REPS(8) {
#ifdef PROBE_UVAR
            if (!rep_) { peer_u_phase<PROBE_UVAR>(Uq, H2, args.in[11], IDX, PART, L + wave * 8192, L + 65536 + wave * 8192, xs, wrank, nwv, lane); REP_BAR(); continue; }
#endif
            peer_u_phase(Uq, H2, args.in[11], IDX, PART, L + wave * 8192, L + 65536 + wave * 8192, xs, wrank, nwv, lane); REP_BAR(); if (rep_ && BOTH(8)) GRID_BAR(); }
        if (IN(9)) REPS(9) { peer_c_phase(PART, GATE, (const float*)(ctl + CW_RSS), ACT, gw * 64 + lane, NGW * 64); REP_BAR(); if (rep_ && BOTH(9)) GRID_BAR(); }
        if (IN(10)) REPS(10) { peer_v_phase(Vq, IDX, ACT, PO, L + wave * 8192, L + 65536 + wave * 8192, xs, wrank, nwv, lane); REP_BAR(); if (rep_ && BOTH(10)) GRID_BAR(); }
        if (IN(11)) REPS(11) { peer_f_phase(H2, PO, out, args.in[17], gw, NGW, lane); REP_BAR(); }
    }
#elif PEER_SPLIT
    if (IN(8)) { peer_phase<3>(L + wave * 1024, H2, Uq, Vq, IDX, GATE, (const float*)(ctl + CW_RSS), args.in[11], out, args.in[17], gw, NGW, lane, 0xffffu, 0u, (float*)(ws + WS_ACT)); if (BOTH(8)) GRID_BAR(); }
    if (IN(9)) peer_phase<4>(L + wave * 1024, H2, Uq, Vq, IDX, GATE, (const float*)(ctl + CW_RSS), args.in[11], out, args.in[17], gw, NGW, lane, 0xffffu, 0u, (float*)(ws + WS_ACT));
#else
    if (IN(8)) REPS(8) {
#ifdef PROBE_MODE
        if (!rep_) { peer_phase<PROBE_MODE>(L + wave * 1024, H2, Uq, Vq, IDX, GATE, (const float*)(ctl + CW_RSS), args.in[11], (float*)QP, args.in[17], gw, NGW, lane, REP_EMASK, (unsigned)(bx & 7) * REP_ESTRIDE); REP_BAR(); continue; }
#endif
        peer_phase(L + wave * 1024, H2, Uq, Vq, IDX, GATE, (const float*)(ctl + CW_RSS), args.in[11], rep_ ? out : (float*)QP, args.in[17], gw, NGW, lane, rep_ ? 0xffffu : REP_EMASK, rep_ ? 0u : (unsigned)(bx & 7) * REP_ESTRIDE); REP_BAR(); }
#endif
#undef IN
#undef BOTH
}

extern "C" void kernel_launch(void* const* d_in, const int* in_sizes, int n_in, void* d_out, int out_size, void* d_ws, size_t ws_size, hipStream_t stream) {
    static int grid = 0;
    if (grid == 0) {
        if (n_in != 18 || in_sizes[0] != M * D || out_size != M * D || ws_size < WS_END) { fprintf(stderr, "kernel_launch: unexpected shapes (n_in %d, ws %zu)\n", n_in, ws_size); grid = -1; return; }
        int dev = 0, cus = 0, per_cu = 0;
        if (hipGetDevice(&dev) != hipSuccess || hipDeviceGetAttribute(&cus, hipDeviceAttributeMultiprocessorCount, dev) != hipSuccess) { grid = -1; return; }
        if (hipFuncSetAttribute((const void*)hyb_fwd, hipFuncAttributeMaxDynamicSharedMemorySize, LDS_BYTES) != hipSuccess) { fprintf(stderr, "kernel_launch: hipFuncSetAttribute failed\n"); grid = -1; return; }
        if (hipOccupancyMaxActiveBlocksPerMultiprocessor(&per_cu, (const void*)hyb_fwd, NWAVES * 64, LDS_BYTES) != hipSuccess || per_cu < 1) { fprintf(stderr, "kernel_launch: occupancy query says %d\n", per_cu); per_cu = 1; }
        (void)hipGetLastError();
        grid = cus;
    }
    if (grid < 0) return;
    Args a{};
    for (int i = 0; i < 18; ++i) a.in[i] = (const float*)d_in[i];
    a.out = (float*)d_out; a.ws = (unsigned char*)d_ws;
    (void)hipMemsetAsync((char*)d_ws + WS_CTL, 0, CTL_ZERO_BYTES, stream);
#if MK_FUSED
    a.ph_lo = 0; a.ph_hi = N_PHASES;
    void* kargs[] = {&a};
    hipError_t e = hipLaunchCooperativeKernel((const void*)hyb_fwd, dim3(grid), dim3(NWAVES * 64), kargs, LDS_BYTES, stream);
    if (e != hipSuccess) fprintf(stderr, "kernel_launch: cooperative launch failed: %s\n", hipGetErrorString(e));
#else
    for (int p = 0; p < N_PHASES; ++p) { a.ph_lo = p; a.ph_hi = p + 1; hipLaunchKernelGGL(hyb_fwd, dim3(grid), dim3(NWAVES * 64), LDS_BYTES, stream, a); }
#endif
}
```

```cpp
#include <hip/hip_runtime.h>
#include <hip/hip_bf16.h>
#include <cstdio>
#include <cstdint>
#include <cmath>
#define C2E_DELTA_FLOATS (3 * 1024 * 1024 / 4)
namespace pg8 {
#define PG8_LAS __attribute__((address_space(3)))
typedef unsigned short bf16_t;
typedef short bf16x8 __attribute__((ext_vector_type(8)));
typedef float f32x4 __attribute__((ext_vector_type(4)));
typedef unsigned u32x4 __attribute__((ext_vector_type(4)));
constexpr int BM = 256, BK = 64, HALF = 128, HTB = HALF * BK * 2  , STAGE_BYTES = 8 * HTB, NXCD = 8, WGM = 8;

__host__ __device__ __forceinline__ int lds_byte(int r, int c) { const int st = (r >> 4) * 2 + (c >> 5), rr = r & 15, cc = c & 31, ob = rr * 64 + cc * 2; return st * 1024 + (ob ^ (((ob >> 9) & 1) << 5)); }
__host__ __device__ __forceinline__ void stage_rc(int b, int& R, int& C) { const int st = b / 1024, sb = b % 1024, swz = sb ^ (((sb >> 9) & 1) << 5); R = (st >> 1) * 16 + swz / 64; C = (st & 1) * 32 + (swz % 64) / 2; }
__host__ __device__ __forceinline__ int perm32(int rho) { const int n = rho >> 4, i = rho & 15; return 8 * (i >> 2) + 4 * n + (i & 3); }

struct Unit { int pm, pn, seg; };
struct Gemm { const bf16_t *A0, *A1, *B0, *B1; int M, N, K; };

struct StaticOrder {
    int nM, nN, nwg, G, c;
    __host__ __device__ __forceinline__ void init(int M, int N, int G_, int c_) { nM = M / BM; nN = N / BM; nwg = nM * nN; G = G_; c = c_; }
    __host__ __device__ __forceinline__ bool next(int i, Unit& u) const {
        const long L = (long)i * G + c; if (L >= nwg) return false;
        int wgid = (int)L; { const int q = nwg / NXCD, r = nwg % NXCD, xcd = wgid % NXCD, off = wgid / NXCD; wgid = (xcd < r ? xcd * (q + 1) : r * (q + 1) + (xcd - r) * q) + off; }
        const int nig = WGM * nN, gid = wgid / nig, fm = gid * WGM, gsz = (nM - fm) < WGM ? (nM - fm) : WGM;
        u.pm = fm + ((wgid % nig) % gsz); u.pn = (wgid % nig) / gsz; u.seg = 0; return true;
    }
    __device__ __forceinline__ void a_ready(const Unit&) const {}
    __device__ __forceinline__ void done(const Unit&) const {}
};

__device__ __forceinline__ unsigned cvt_pk_bf16(float lo, float hi) { unsigned r; asm volatile("v_cvt_pk_bf16_f32 %0, %1, %2" : "=v"(r) : "v"(lo), "v"(hi)); return r; }
typedef float f32x2 __attribute__((ext_vector_type(2)));
__device__ __forceinline__ f32x2 gelu_pk(f32x2 v) {
    const f32x2 av = __builtin_elementwise_abs(v), d = av * 0.2316418882f + 1.0f;
    f32x2 t; t.x = __builtin_amdgcn_rcpf(d.x); t.y = __builtin_amdgcn_rcpf(d.y);
    f32x2 q = t * 0.5307027145f + (-0.7265760135f); q = q * t + 0.7107068705f; q = q * t + (-0.142248368f); q = q * t + 0.127414796f; q = q * t;
    const f32x2 s = (v * v) * (-0.72134752044f);
    f32x2 e; e.x = __builtin_amdgcn_exp2f(s.x); e.y = __builtin_amdgcn_exp2f(s.y);
    const f32x2 m = v * (q * e), r = v - m;
    f32x2 o; o.x = v.x < 0.f ? m.x : r.x; o.y = v.y < 0.f ? m.y : r.y; return o;
}

template <int ACT  > struct EpiBf16 {
    static constexpr bool PERM = true, AFTER_DRAIN = false; static_assert(ACT == 0 || ACT == 1, "EpiBf16: ACT is 0 (none) or 1 (gelu_pk)");
    bf16_t* O; int ldc; const float* bias; int split_cols; size_t split_stride; float scale0;
    __device__ __forceinline__ void operator()(const f32x4 (&acc)[2][2][4][2], const Unit& u, int wr, int wc, int fr, int fq) const {
        const int row0 = u.pm * BM + wr * 64 + fr; int colt = u.pn * BM; bf16_t* base = O;
        float sc = 1.f; if (split_cols) { const int t = colt / split_cols; base += (size_t)t * split_stride; colt -= t * split_cols; if (t == 0) sc = scale0; }
        const int col0 = colt + wc * 32 + 8 * fq, bcol0 = u.pn * BM + wc * 32 + 8 * fq;
        f32x4 bv[2][2];
#pragma unroll
        for (int bj = 0; bj < 2; ++bj)
#pragma unroll
            for (int n = 0; n < 2; ++n) bv[bj][n] = bias ? *(const f32x4*)(bias + bcol0 + bj * HALF + 4 * n) : (f32x4){0.f, 0.f, 0.f, 0.f};
#pragma unroll
        for (int ai = 0; ai < 2; ++ai)
#pragma unroll
            for (int m = 0; m < 4; ++m) { bf16_t* rowp = base + (size_t)(row0 + ai * HALF + m * 16) * ldc + col0;
#pragma unroll
                for (int bj = 0; bj < 2; ++bj) { f32x4 v0 = acc[ai][bj][m][0] + bv[bj][0], v1 = acc[ai][bj][m][1] + bv[bj][1];
                    if (ACT == 1) { f32x2 a = gelu_pk((f32x2){v0[0], v0[1]}), b = gelu_pk((f32x2){v0[2], v0[3]}), c = gelu_pk((f32x2){v1[0], v1[1]}), d = gelu_pk((f32x2){v1[2], v1[3]});
                        v0 = (f32x4){a.x, a.y, b.x, b.y}; v1 = (f32x4){c.x, c.y, d.x, d.y}; }
                    v0 = v0 * sc; v1 = v1 * sc; u32x4 w; w.x = cvt_pk_bf16(v0[0], v0[1]); w.y = cvt_pk_bf16(v0[2], v0[3]); w.z = cvt_pk_bf16(v1[0], v1[1]); w.w = cvt_pk_bf16(v1[2], v1[3]);
                    *(u32x4*)(rowp + bj * HALF) = w; } }
    }
};

struct PanelStats {
    unsigned* xbuf;
    unsigned* cnt;
    unsigned* tmo;
    int ntn; float eps;
    unsigned code;
    __device__ __forceinline__ bool run(const f32x4 (&v)[2][2][4][2], const Unit& u, int wr, int wc, int fr, int fq, PG8_LAS unsigned char* lds, int wid, int lane) const {
        typedef float f32x2v __attribute__((ext_vector_type(2)));
        PG8_LAS f32x2v* P = (PG8_LAS f32x2v*)lds;
        PG8_LAS f32x2v* S = (PG8_LAS f32x2v*)(lds + 8192);
        PG8_LAS unsigned* flag = (PG8_LAS unsigned*)(lds + 8192 + 2048);
#pragma unroll
        for (int ai = 0; ai < 2; ++ai)
#pragma unroll
            for (int m = 0; m < 4; ++m) {
                float s = 0.f;
#pragma unroll
                for (int bj = 0; bj < 2; ++bj)
#pragma unroll
                    for (int n = 0; n < 2; ++n) { const f32x4 x = v[ai][bj][m][n]; s += (x[0] + x[1]) + (x[2] + x[3]); }
                s += __shfl_xor(s, 16); s += __shfl_xor(s, 32);
                const float mw = s * (1.0f / 64.0f); float q = 0.f;
#pragma unroll
                for (int bj = 0; bj < 2; ++bj)
#pragma unroll
                    for (int n = 0; n < 2; ++n) { const f32x4 d = v[ai][bj][m][n] - mw; q += (d[0] * d[0] + d[1] * d[1]) + (d[2] * d[2] + d[3] * d[3]); }
                q += __shfl_xor(q, 16); q += __shfl_xor(q, 32);
                if (fq == 0) P[(ai * HALF + wr * 64 + m * 16 + fr) * 4 + wc] = (f32x2v){mw, q};
            }
        asm volatile("s_waitcnt lgkmcnt(0)" ::: "memory"); __builtin_amdgcn_s_barrier(); asm volatile("" ::: "memory");
#if defined(BROKEN_EXCHANGE_NO_WAIT)
#warning BROKEN CONTROL BUILD: the row-statistics exchange does not wait; results are wrong by design
        if (blockIdx.x >= 64) { const long long t0_ = clock64(); while (clock64() - t0_ < 60000) __builtin_amdgcn_s_sleep(8); }
#endif
        const int row = wid * 32 + (lane & 31);
        if (lane < 32) {
            const f32x2v a = P[row * 4 + 0], b = P[row * 4 + 1], c = P[row * 4 + 2], d = P[row * 4 + 3];
            const float mt = (a.x + b.x + c.x + d.x) * 0.25f;
            const float da = a.x - mt, db = b.x - mt, dc = c.x - mt, dd = d.x - mt;
            const float m2 = (a.y + b.y) + (c.y + d.y) + 64.0f * ((da * da + db * db) + (dc * dc + dd * dd));
            unsigned long long* slot = (unsigned long long*)xbuf + ((size_t)(u.pm * BM + row) * 4 + u.pn);
            __hip_atomic_store(slot, ((unsigned long long)__float_as_uint(m2) << 32) | __float_as_uint(mt), __ATOMIC_RELAXED, __HIP_MEMORY_SCOPE_AGENT);
        }
        asm volatile("s_waitcnt vmcnt(0)" ::: "memory");
        if (lane == 0) __hip_atomic_fetch_add(cnt + 64 * u.pm, 1u, __ATOMIC_RELAXED, __HIP_MEMORY_SCOPE_AGENT);
        if (wid == 0) {
            bool dead = false; const unsigned long long t0 = __builtin_amdgcn_s_memrealtime(); const unsigned want = 8u * (unsigned)ntn;
            for (;;) {
#if defined(BROKEN_EXCHANGE_NO_WAIT)
                break;
#endif
                if ((unsigned)__builtin_amdgcn_readfirstlane(__hip_atomic_load(cnt + 64 * u.pm, __ATOMIC_RELAXED, __HIP_MEMORY_SCOPE_AGENT)) >= want) break;
                if (__builtin_amdgcn_s_memrealtime() - t0 > 2000000ull) {
                    if (lane == 0) { unsigned expect = 0u; __hip_atomic_compare_exchange_strong(tmo + 1, &expect, code | (unsigned)(u.pm & 0xff), __ATOMIC_RELAXED, __ATOMIC_RELAXED, __HIP_MEMORY_SCOPE_AGENT);
                                     __hip_atomic_store(tmo, 1u, __ATOMIC_RELAXED, __HIP_MEMORY_SCOPE_AGENT); }
                    dead = true; break; }
                __builtin_amdgcn_s_sleep(2);
            }
            __builtin_amdgcn_fence(__ATOMIC_ACQUIRE, "agent");
            if (lane == 0) flag[0] = dead ? 1u : 0u;
        }
        asm volatile("s_waitcnt vmcnt(0) lgkmcnt(0)" ::: "memory"); __builtin_amdgcn_s_barrier(); asm volatile("" ::: "memory");
        const bool bad = flag[0] != 0u;
        if (lane < 32) {
            const unsigned long long* slot = (const unsigned long long*)xbuf + (size_t)(u.pm * BM + row) * 4; float mt[4], m2[4]; float ms = 0.f;
#pragma unroll
            for (int t = 0; t < 4; ++t) { if (t < ntn) { const unsigned long long w = __hip_atomic_load(slot + t, __ATOMIC_RELAXED, __HIP_MEMORY_SCOPE_AGENT); mt[t] = __uint_as_float((unsigned)w); m2[t] = __uint_as_float((unsigned)(w >> 32)); } else { mt[t] = 0.f; m2[t] = 0.f; } ms += mt[t]; }
            const float mean = ms / (float)ntn; float q = 0.f;
#pragma unroll
            for (int t = 0; t < 4; ++t) if (t < ntn) { const float dm = mt[t] - mean; q += m2[t] + 256.0f * dm * dm; }
            S[row] = (f32x2v){mean, 1.0f / sqrtf(q / (256.0f * (float)ntn) + eps)};
        }
        asm volatile("s_waitcnt lgkmcnt(0)" ::: "memory"); __builtin_amdgcn_s_barrier(); asm volatile("" ::: "memory");
        return bad;
    }
};
struct EpiLnRes {
    static constexpr bool PERM = false, AFTER_DRAIN = true;
    const float* base; float* out; int ldc; const float* bias; PanelStats st; unsigned poison;
    __device__ __forceinline__ void fused(f32x4 (&acc)[2][2][4][2], const Unit& u, int wr, int wc, int fr, int fq, PG8_LAS unsigned char* lds, int wid, int lane) const {
        typedef float f32x2v __attribute__((ext_vector_type(2)));
        const PG8_LAS f32x2v* S = (const PG8_LAS f32x2v*)(lds + 8192);
        const int col0 = u.pn * BM + wc * 32 + 4 * fq;
#pragma unroll
        for (int bj = 0; bj < 2; ++bj)
#pragma unroll
            for (int n = 0; n < 2; ++n) { const f32x4 bv = bias ? *(const f32x4*)(bias + col0 + bj * HALF + n * 16) : (f32x4){0.f, 0.f, 0.f, 0.f};
#pragma unroll
                for (int ai = 0; ai < 2; ++ai)
#pragma unroll
                    for (int m = 0; m < 4; ++m) acc[ai][bj][m][n] += bv; }
        f32x4 pre[4][2][2];
#pragma unroll
        for (int m = 0; m < 4; ++m) { const size_t off = (size_t)(u.pm * BM + wr * 64 + m * 16 + fr) * ldc + col0;
#pragma unroll
            for (int bj = 0; bj < 2; ++bj)
#pragma unroll
                for (int n = 0; n < 2; ++n) pre[m][bj][n] = *(const f32x4*)(base + off + bj * HALF + n * 16); }
        const bool bad = st.run(acc, u, wr, wc, fr, fq, lds, wid, lane) || poison != 0u;
        const float qnan = __builtin_nanf("");
#pragma unroll
        for (int ai = 0; ai < 2; ++ai)
#pragma unroll
            for (int m = 0; m < 4; ++m) { const int r = ai * HALF + wr * 64 + m * 16 + fr; const f32x2v sr = S[r]; const size_t off = (size_t)(u.pm * BM + r) * ldc + col0;
#pragma unroll
                for (int bj = 0; bj < 2; ++bj)
#pragma unroll
                    for (int n = 0; n < 2; ++n) { const f32x4 bs = ai == 0 ? pre[m][bj][n] : *(const f32x4*)(base + off + bj * HALF + n * 16); f32x4 o = bs + (acc[ai][bj][m][n] - sr.x) * sr.y;
                        if (bad) o = (f32x4){qnan, qnan, qnan, qnan}; *(f32x4*)(out + off + bj * HALF + n * 16) = o; }
                if (m & 1) asm volatile("" ::: "memory"); }
    }
};
struct EpiLnResLn {
    static constexpr bool PERM = false, AFTER_DRAIN = true;
    const float* base; float* out; bf16_t* xn; int ldc; const float* bias; PanelStats st1, st2; unsigned poison;
    __device__ __forceinline__ void fused(f32x4 (&acc)[2][2][4][2], const Unit& u, int wr, int wc, int fr, int fq, PG8_LAS unsigned char* lds, int wid, int lane) const {
        typedef float f32x2v __attribute__((ext_vector_type(2))); typedef unsigned u32x2v __attribute__((ext_vector_type(2)));
        const PG8_LAS f32x2v* S = (const PG8_LAS f32x2v*)(lds + 8192);
        const int col0 = u.pn * BM + wc * 32 + 4 * fq;
#pragma unroll
        for (int bj = 0; bj < 2; ++bj)
#pragma unroll
            for (int n = 0; n < 2; ++n) { const f32x4 bv = bias ? *(const f32x4*)(bias + col0 + bj * HALF + n * 16) : (f32x4){0.f, 0.f, 0.f, 0.f};
#pragma unroll
                for (int ai = 0; ai < 2; ++ai)
#pragma unroll
                    for (int m = 0; m < 4; ++m) acc[ai][bj][m][n] += bv; }
        bool bad = st1.run(acc, u, wr, wc, fr, fq, lds, wid, lane) || poison != 0u;
        const float qnan = __builtin_nanf("");
#pragma unroll
        for (int ai = 0; ai < 2; ++ai)
#pragma unroll
            for (int m = 0; m < 4; ++m) { const int r = ai * HALF + wr * 64 + m * 16 + fr; const f32x2v sr = S[r]; const size_t off = (size_t)(u.pm * BM + r) * ldc + col0;
#pragma unroll
                for (int bj = 0; bj < 2; ++bj)
#pragma unroll
                    for (int n = 0; n < 2; ++n) { const f32x4 bs = *(const f32x4*)(base + off + bj * HALF + n * 16); acc[ai][bj][m][n] = bs + (acc[ai][bj][m][n] - sr.x) * sr.y; }
                asm volatile("" : "+v"(acc[ai][0][m][0]), "+v"(acc[ai][0][m][1]), "+v"(acc[ai][1][m][0]), "+v"(acc[ai][1][m][1]));
                if (m & 1) asm volatile("" ::: "memory"); }
        const bool bad1 = bad;
        bad = st2.run(acc, u, wr, wc, fr, fq, lds, wid, lane) || bad;
#pragma unroll
        for (int ai = 0; ai < 2; ++ai)
#pragma unroll
            for (int m = 0; m < 4; ++m) { const int r = ai * HALF + wr * 64 + m * 16 + fr; const f32x2v sr = S[r]; const size_t off = (size_t)(u.pm * BM + r) * ldc + col0;
#pragma unroll
                for (int bj = 0; bj < 2; ++bj)
#pragma unroll
                    for (int n = 0; n < 2; ++n) { const f32x4 x1 = acc[ai][bj][m][n]; *(f32x4*)(out + off + bj * HALF + n * 16) = bad1 ? (f32x4){qnan, qnan, qnan, qnan} : x1;
                        const f32x4 o = (x1 - sr.x) * sr.y; u32x2v w; w.x = cvt_pk_bf16(o[0], o[1]); w.y = cvt_pk_bf16(o[2], o[3]);
                        if (bad) { w.x = 0x7fc07fc0u; w.y = 0x7fc07fc0u; } *(u32x2v*)(xn + off + bj * HALF + n * 16) = w; }
                asm volatile("" ::: "memory"); }
    }
};

template <class Epi, class Sched, bool ALIGN_EPI = false, bool SP2 = false>
__device__ __forceinline__ void gemm_phase(PG8_LAS unsigned char* lds, const Gemm g, const Sched& S, const Epi& E) {
    const int tid = threadIdx.x, wid = __builtin_amdgcn_readfirstlane(tid >> 6), lane = tid & 63, wr = wid >> 2, wc = wid & 3, fr = lane & 15, fq = lane >> 4;
    const int K = g.K, nt = K / BK;
    unsigned voffA[2], voffB[2];
#pragma unroll
    for (int i = 0; i < 2; ++i) { int R, C; stage_rc(tid * 16 + i * 8192, R, C); const int Rb = Epi::PERM ? ((R & ~31) + perm32(R & 31)) : R;
        voffA[i] = (unsigned)(R * K + C) * 2u; voffB[i] = (unsigned)(Rb * K + C) * 2u; }
    const size_t kstep = (size_t)(BK * 2);
    const size_t hstep = (size_t)HALF * K * 2;
    const size_t tstep = 2 * hstep;
    const unsigned ldsw = (unsigned)wid * 1024u;
    const int aoff = lds_byte(wr * 64 + fr, fq * 8), boff = lds_byte(wc * 32 + fr, fq * 8);
#define PG8_SA(b, h) (((b) * 2 + (h)) * HTB)
#define PG8_SB(b, h) ((4 + (b) * 2 + (h)) * HTB)
#define PG8_STAGE(bufoff, gbase, voff) do { _Pragma("unroll") for (int _i = 0; _i < 2; ++_i) \
        __builtin_amdgcn_global_load_lds((const unsigned*)((const char*)(gbase) + (voff)[_i]), (PG8_LAS unsigned*)(lds + (bufoff) + ldsw + _i * 8192), 16, 0, 0); } while (0)
#define PG8_LDA(dst, b, h) do { _Pragma("unroll") for (int m = 0; m < 4; ++m) _Pragma("unroll") for (int k = 0; k < 2; ++k) dst[m][k] = *(const PG8_LAS bf16x8*)(lds + PG8_SA(b, h) + aoff + m * 2048 + k * 1024); } while (0)
#define PG8_LDB(dst, b, h) do { _Pragma("unroll") for (int n = 0; n < 2; ++n) _Pragma("unroll") for (int k = 0; k < 2; ++k) dst[n][k] = *(const PG8_LAS bf16x8*)(lds + PG8_SB(b, h) + boff + n * 2048 + k * 1024); } while (0)
#define PG8_MMA(ai, bj, At, Bt) do { __builtin_amdgcn_s_setprio(1); _Pragma("unroll") for (int m = 0; m < 4; ++m) _Pragma("unroll") for (int n = 0; n < 2; ++n) _Pragma("unroll") for (int k = 0; k < 2; ++k) \
        acc[ai][bj][m][n] = __builtin_amdgcn_mfma_f32_16x16x32_bf16(Bt[n][k], At[m][k], acc[ai][bj][m][n], 0, 0, 0); __builtin_amdgcn_s_setprio(0); } while (0)
#define PG8_WAIT_V(n) asm volatile("s_waitcnt vmcnt(" #n ")" ::: "memory")
#define PG8_WAIT_L(n) asm volatile("s_waitcnt lgkmcnt(" #n ")" ::: "memory")
#define PG8_BAR __builtin_amdgcn_s_barrier()
#define PG8_SCHED __builtin_amdgcn_sched_barrier(0)
    Unit cur, nxt; int ui = 0;
    if (!S.next(0, cur)) return;
    f32x4 acc[2][2][4][2];
#pragma unroll
    for (int a = 0; a < 2; ++a)
#pragma unroll
        for (int b = 0; b < 2; ++b)
#pragma unroll
            for (int m = 0; m < 4; ++m)
#pragma unroll
                for (int n = 0; n < 2; ++n) acc[a][b][m][n] = (f32x4){0.f, 0.f, 0.f, 0.f};
    bf16x8 At[4][2], B0[2][2], B1[2][2];
    const char* cA = (const char*)(cur.seg ? g.A1 : g.A0) + (size_t)cur.pm * tstep; const char* cB = (const char*)(cur.seg ? g.B1 : g.B0) + (size_t)cur.pn * tstep;
    S.a_ready(cur);
    if constexpr (SP2) {
        PG8_STAGE(PG8_SB(0, 0), cB, voffB); PG8_STAGE(PG8_SB(0, 1), cB + hstep, voffB); PG8_STAGE(PG8_SA(0, 0), cA, voffA); PG8_STAGE(PG8_SA(0, 1), cA + hstep, voffA);
        if (wr == 1) PG8_BAR;
        PG8_WAIT_V(2); PG8_BAR;
        PG8_STAGE(PG8_SB(1, 0), cB + kstep, voffB); PG8_STAGE(PG8_SA(1, 0), cA + kstep, voffA); PG8_STAGE(PG8_SB(1, 1), cB + hstep + kstep, voffB);
        PG8_WAIT_V(6); PG8_BAR;
    } else {
        PG8_STAGE(PG8_SB(0, 0), cB, voffB); PG8_STAGE(PG8_SA(0, 0), cA, voffA); PG8_STAGE(PG8_SB(0, 1), cB + hstep, voffB); PG8_STAGE(PG8_SA(0, 1), cA + hstep, voffA);
        if (wr == 1) PG8_BAR;
        PG8_WAIT_V(4); PG8_BAR;
        PG8_STAGE(PG8_SB(1, 0), cB + kstep, voffB); PG8_STAGE(PG8_SA(1, 0), cA + kstep, voffA); PG8_STAGE(PG8_SB(1, 1), cB + hstep + kstep, voffB);
        PG8_WAIT_V(6); PG8_BAR;
    }
    for (;;) {
        const bool has_next = S.next(ui + 1, nxt);
        const char* nA = has_next ? (const char*)(nxt.seg ? g.A1 : g.A0) + (size_t)nxt.pm * tstep : cA; const char* nB = has_next ? (const char*)(nxt.seg ? g.B1 : g.B0) + (size_t)nxt.pn * tstep : cB;
        for (int t = 0; t < nt; t += 2) {
            const bool last = (t == nt - 2);
            const char* a1 = cA + (size_t)(t + 1) * kstep;
            const char* a2 = last ? nA : cA + (size_t)(t + 2) * kstep; const char* b2 = last ? nB : cB + (size_t)(t + 2) * kstep;
            const char* a3 = a2 + kstep; const char* b3 = b2 + kstep;
            if (last && has_next) S.a_ready(nxt);
            if constexpr (SP2) {
            PG8_LDB(B0, 0, 0); PG8_LDB(B1, 0, 1); PG8_SCHED; PG8_LDA(At, 0, 0); PG8_STAGE(PG8_SA(1, 1), a1 + hstep, voffA);
            PG8_WAIT_V(8); PG8_WAIT_L(0); PG8_BAR; PG8_MMA(0, 0, At, B0); PG8_MMA(0, 1, At, B1); PG8_BAR; PG8_SCHED;
            PG8_LDA(At, 0, 1); PG8_STAGE(PG8_SB(0, 0), b2, voffB); PG8_STAGE(PG8_SB(0, 1), b2 + hstep, voffB); PG8_STAGE(PG8_SA(0, 0), a2, voffA);
            PG8_WAIT_V(8); PG8_WAIT_L(0); PG8_BAR; PG8_MMA(1, 0, At, B0); PG8_MMA(1, 1, At, B1); PG8_BAR; PG8_SCHED;
            PG8_LDB(B0, 1, 0); PG8_LDB(B1, 1, 1); PG8_SCHED; PG8_LDA(At, 1, 0); PG8_STAGE(PG8_SA(0, 1), a2 + hstep, voffA);
            PG8_WAIT_V(8); PG8_WAIT_L(0); PG8_BAR; PG8_MMA(0, 0, At, B0); PG8_MMA(0, 1, At, B1); PG8_BAR; PG8_SCHED;
            PG8_LDA(At, 1, 1); PG8_STAGE(PG8_SB(1, 0), b3, voffB); PG8_STAGE(PG8_SB(1, 1), b3 + hstep, voffB); PG8_STAGE(PG8_SA(1, 0), a3, voffA);
            PG8_WAIT_V(8); PG8_WAIT_L(0); PG8_BAR; PG8_MMA(1, 0, At, B0); PG8_MMA(1, 1, At, B1); PG8_BAR; PG8_SCHED;
            } else {
            PG8_LDB(B0, 0, 0); PG8_SCHED; PG8_LDA(At, 0, 0); PG8_STAGE(PG8_SA(1, 1), a1 + hstep, voffA);
            PG8_WAIT_L(8); PG8_BAR; PG8_WAIT_L(0); PG8_MMA(0, 0, At, B0); PG8_BAR; PG8_SCHED;
            PG8_LDB(B1, 0, 1); PG8_STAGE(PG8_SB(0, 0), b2, voffB);
            PG8_BAR; PG8_WAIT_L(0); PG8_MMA(0, 1, At, B1); PG8_BAR;
            PG8_LDA(At, 0, 1); PG8_STAGE(PG8_SA(0, 0), a2, voffA);
            PG8_BAR; PG8_WAIT_L(0); PG8_MMA(1, 0, At, B0); PG8_BAR; PG8_SCHED;
            PG8_STAGE(PG8_SB(0, 1), b2 + hstep, voffB);
            PG8_WAIT_V(6); PG8_BAR; PG8_MMA(1, 1, At, B1); PG8_BAR;
            PG8_LDB(B0, 1, 0); PG8_SCHED; PG8_LDA(At, 1, 0); PG8_STAGE(PG8_SA(0, 1), a2 + hstep, voffA);
            PG8_WAIT_L(8); PG8_BAR; PG8_WAIT_L(0); PG8_MMA(0, 0, At, B0); PG8_BAR; PG8_SCHED;
            PG8_LDB(B1, 1, 1); PG8_STAGE(PG8_SB(1, 0), b3, voffB);
            PG8_BAR; PG8_WAIT_L(0); PG8_MMA(0, 1, At, B1); PG8_BAR;
            PG8_LDA(At, 1, 1); PG8_STAGE(PG8_SA(1, 0), a3, voffA);
            PG8_BAR; PG8_WAIT_L(0); PG8_MMA(1, 0, At, B0); PG8_BAR; PG8_SCHED;
            PG8_STAGE(PG8_SB(1, 1), b3 + hstep, voffB);
            PG8_WAIT_V(6); PG8_BAR; PG8_MMA(1, 1, At, B1); PG8_BAR;
            }
        }
        if constexpr (ALIGN_EPI) { if (wr == 0) PG8_BAR; }
        if constexpr (!Epi::AFTER_DRAIN) { E(acc, cur, wr, wc, fr, fq); S.done(cur); }
        if (!has_next) break;
        if (nxt.seg == 0) {
#pragma unroll
        for (int a = 0; a < 2; ++a)
#pragma unroll
            for (int b = 0; b < 2; ++b)
#pragma unroll
                for (int m = 0; m < 4; ++m)
#pragma unroll
                    for (int n = 0; n < 2; ++n) acc[a][b][m][n] = (f32x4){0.f, 0.f, 0.f, 0.f};
        }
        cur = nxt; cA = nA; cB = nB; ++ui;
        if constexpr (ALIGN_EPI) { if (wr == 1) PG8_BAR; }
    }
    PG8_WAIT_V(0);
    if constexpr (!ALIGN_EPI) { if (wr == 0) PG8_BAR; }
    PG8_BAR;
    if constexpr (Epi::AFTER_DRAIN) { E.fused(acc, cur, wr, wc, fr, fq, lds, wid, lane); S.done(cur); }
#undef PG8_SA
#undef PG8_SB
#undef PG8_STAGE
#undef PG8_LDA
#undef PG8_LDB
#undef PG8_MMA
#undef PG8_WAIT_V
#undef PG8_WAIT_L
#undef PG8_BAR
#undef PG8_SCHED
}
}
namespace attn_body {
using bf16=__hip_bfloat16;
using bf16x8=__attribute__((ext_vector_type(8)))short;
using s16x4=__attribute__((ext_vector_type(4)))short;
using f32x16=__attribute__((ext_vector_type(16)))float;
using u32x4=__attribute__((ext_vector_type(4)))unsigned;
constexpr int BATCH=8,NHEAD=16,SEQ=4096,D=64,DM=NHEAD*D;
constexpr int NW=8,QBLK=32,QB=QBLK*NW,KVBLK=64,NQB=SEQ/QB;
constexpr int ATTN_PITCH=DM, ATTN_UNIT_ROWS=QB;
__device__ __forceinline__ int crow(int r,int hi){return (r&3)+8*(r>>2)+4*hi;}
#define SBAR() __builtin_amdgcn_sched_barrier(0)
__device__ __forceinline__ void cmask(f32x16&p0,f32x16&p1,int jb,int qrel,int hi){
  const float NEG=-INFINITY; int kb=64*jb+4*hi;
  #pragma unroll
  for(int r=0;r<16;++r){int kv=kb+(r&3)+8*(r>>2); if(kv>qrel)p0[r]=NEG; if(kv+32>qrel)p1[r]=NEG;}
}

constexpr int NSLOT=3, SLOTB=8192;
constexpr int LDS_K=0, LDS_V=NSLOT*SLOTB, LDS_WS=2*NSLOT*SLOTB, LDS_OST=LDS_WS+NW*64*4, LDS_CL=LDS_OST+NW*4096, LDS_VF=LDS_CL+SEQ*16, LDS_BYTES=LDS_VF+192;
constexpr float C2=0.125f*1.4426950408889634f;
__device__ __forceinline__ void glds16(const void*gsrc,unsigned lds_dst){unsigned keep;
  asm volatile("s_mov_b32 %0, m0\n\ts_mov_b32 m0, %2\n\ts_nop 0\n\tglobal_load_lds_dwordx4 %1, off\n\ts_mov_b32 m0, %0":"=&s"(keep):"v"(gsrc),"s"(lds_dst):"memory");}
__device__ __forceinline__ float max3f(float a,float b,float c){float r;asm("v_max3_f32 %0, %1, %2, %3":"=v"(r):"v"(a),"v"(b),"v"(c));return r;}
__device__ __forceinline__ float max2f(float a,float b){float r;asm("v_max_f32_e32 %0, %1, %2":"=v"(r):"v"(a),"v"(b));return r;}
__device__ __forceinline__ float fadd_s(float a,float b){float r;asm("v_add_f32_e32 %0, %1, %2":"=v"(r):"v"(a),"v"(b));return r;}
__device__ __forceinline__ float fsub_s(float a,float b){float r;asm("v_sub_f32_e32 %0, %1, %2":"=v"(r):"v"(a),"v"(b));return r;}
typedef float f32x2_t __attribute__((ext_vector_type(2))); typedef __bf16 bf16x2_t __attribute__((ext_vector_type(2)));
__device__ __forceinline__ unsigned cvtpk_s(float lo,float hi){f32x2_t v={lo,hi};bf16x2_t b=__builtin_convertvector(v,bf16x2_t);return __builtin_bit_cast(unsigned,b);}
#define WAIT_BAR(N) asm volatile("s_waitcnt vmcnt(" #N ") lgkmcnt(0)\n\ts_barrier":::"memory")

__device__ __forceinline__ void qkt(f32x16&p0,f32x16&p1,const char*Kslot,const bf16x8*qr,int r32,int hi){
  const char*kb=Kslot+hi*1024+r32*16;
  #pragma unroll
  for(int d0=0;d0<4;++d0){
    const bf16x8 b0=*reinterpret_cast<const bf16x8*>(kb+d0*2048);
    const bf16x8 b1=*reinterpret_cast<const bf16x8*>(kb+d0*2048+512);
    {p0=__builtin_amdgcn_mfma_f32_32x32x16_bf16(b0,qr[d0],p0,0,0,0);p1=__builtin_amdgcn_mfma_f32_32x32x16_bf16(b1,qr[d0],p1,0,0,0);}}
}
typedef __attribute__((address_space(3))) const char* lds_cptr;
typedef short v4i16_t __attribute__((ext_vector_type(4)));
__device__ __forceinline__ void kload8(bf16x8*kf,lds_cptr kp){
  kf[0]=*(const __attribute__((address_space(3))) bf16x8*)(kp);      kf[1]=*(const __attribute__((address_space(3))) bf16x8*)(kp+512);
  kf[2]=*(const __attribute__((address_space(3))) bf16x8*)(kp+2048); kf[3]=*(const __attribute__((address_space(3))) bf16x8*)(kp+2560);
  kf[4]=*(const __attribute__((address_space(3))) bf16x8*)(kp+4096); kf[5]=*(const __attribute__((address_space(3))) bf16x8*)(kp+4608);
  kf[6]=*(const __attribute__((address_space(3))) bf16x8*)(kp+6144); kf[7]=*(const __attribute__((address_space(3))) bf16x8*)(kp+6656);
}
__device__ __forceinline__ void kload2(bf16x8*kf,lds_cptr kp,int j){ kf[2*j]=*(const __attribute__((address_space(3))) bf16x8*)(kp+j*2048); kf[2*j+1]=*(const __attribute__((address_space(3))) bf16x8*)(kp+j*2048+512); }
__device__ __forceinline__ s16x4 vtr(lds_cptr p){ return __builtin_bit_cast(s16x4,__builtin_amdgcn_ds_read_tr16_b64_v4i16((__attribute__((address_space(3))) v4i16_t*)p)); }
__device__ __forceinline__ float rowmax(const f32x16&p0,const f32x16&p1){
  float a=max3f(p0[0],p0[1],p1[0]),b=max3f(p0[2],p0[3],p1[1]);a=max3f(a,p1[2],p1[3]);
  #pragma unroll
  for(int r=4;r<16;r+=4){a=max3f(a,p0[r],p0[r+1]);b=max3f(b,p0[r+2],p0[r+3]);a=max3f(a,p1[r],p1[r+1]);b=max3f(b,p1[r+2],p1[r+3]);}
  const float m=max2f(a,b);
  auto rr=__builtin_amdgcn_permlane32_swap(__float_as_uint(m),__float_as_uint(m),false,false);
  return max2f(__uint_as_float(rr[0]),__uint_as_float(rr[1]));
}
__device__ __forceinline__ void pv(f32x16*o,int vb,bf16x8 pa0,bf16x8 pa1,bf16x8 pa2,bf16x8 pa3){
  #pragma unroll
  for(int d0=0;d0<2;++d0){s16x4 lo[4],hi[4];
    #pragma unroll
    for(int ks=0;ks<4;++ks){
      asm volatile("ds_read_b64_tr_b16 %0,%1 offset:%c2":"=&v"(lo[ks]):"v"(vb),"i"(d0*4096+ks*1024):"memory");
      asm volatile("ds_read_b64_tr_b16 %0,%1 offset:%c2":"=&v"(hi[ks]):"v"(vb),"i"(d0*4096+ks*1024+512):"memory");}
    asm volatile("s_waitcnt lgkmcnt(0)":::"memory");SBAR();
    #define PK(k) (bf16x8){lo[k][0],lo[k][1],lo[k][2],lo[k][3],hi[k][0],hi[k][1],hi[k][2],hi[k][3]}
    o[d0]=__builtin_amdgcn_mfma_f32_32x32x16_bf16(pa0,PK(0),o[d0],0,0,0);
    o[d0]=__builtin_amdgcn_mfma_f32_32x32x16_bf16(pa1,PK(1),o[d0],0,0,0);
    o[d0]=__builtin_amdgcn_mfma_f32_32x32x16_bf16(pa2,PK(2),o[d0],0,0,0);
    o[d0]=__builtin_amdgcn_mfma_f32_32x32x16_bf16(pa3,PK(3),o[d0],0,0,0);
    #undef PK
  }
}

#ifndef ATTN_STORE16
#define ATTN_STORE16(p,v) (*(u32x4*)(p)=(v))
#endif
template<int THRL,bool VERIFY=false> __device__ __forceinline__ int attn_unit(int b,int h,int qb,int T0,const bf16*Q,const bf16*__restrict__ K,const bf16*__restrict__ V,bf16*O,const float*__restrict__ c2g,char*shm){
  const int tid=threadIdx.x,lane=tid&63,r32=lane&31,hi=lane>>5; const int wid=__builtin_amdgcn_readfirstlane(tid>>6);
  const long rowbase=(long)b*SEQ; const int q0=qb*QB;
  const bf16*Qw=Q+(rowbase+q0+wid*QBLK)*DM+h*D;
  const bf16*Kh=K+(rowbase+(long)T0*KVBLK)*DM+h*D,*Vh=V+(rowbase+(long)T0*KVBLK)*DM+h*D;
  const unsigned lds0=(unsigned)(uintptr_t)shm; const lds_cptr shm3=(lds_cptr)shm;
  float*wsf=(float*)(shm+LDS_WS)+wid*64;
  const bf16*ksrc=Kh+(long)lane*DM+wid*8;
  const bf16*vsrc=Vh+(long)(16*(wid&3)+(lane>>2))*DM+(wid>>2)*32+(lane&3)*8;
  const unsigned kdst=lds0+LDS_K+wid*1024, vdst=lds0+LDS_V+wid*1024;
  #define DMA_K(t,slot) glds16(ksrc+(long)(t)*KVBLK*DM,(unsigned)__builtin_amdgcn_readfirstlane(kdst+(slot)))
  #define DMA_V(t,slot) glds16(vsrc+(long)(t)*KVBLK*DM,(unsigned)__builtin_amdgcn_readfirstlane(vdst+(slot)))
  const int vb0=(int)(lds0+LDS_V)+((lane>>4)&1)*32+(lane&3)*8+(4*hi+((lane&15)>>2))*64;
  const char*Kbase=shm+LDS_K; bf16x8 kf[8];
  const lds_cptr kp0=shm3+LDS_K+hi*1024+r32*16; const lds_cptr vp0=shm3+LDS_V+((lane>>4)&1)*32+(lane&3)*8+(4*hi+((lane&15)>>2))*64;
  const int NT=(q0+QB)/KVBLK-T0;
  { __attribute__((address_space(3))) u32x4* cx=(__attribute__((address_space(3))) u32x4*)(shm3+LDS_CL);
    for(int s1=64*T0+tid; s1<q0+QB; s1+=NW*64){ const float c=c2g[s1]; const unsigned h0=cvtpk_s(c,0.f)&0xffffu; const float r1=c-__uint_as_float(h0<<16);
      const unsigned h1=cvtpk_s(r1,0.f)&0xffffu; const float r2=r1-__uint_as_float(h1<<16); const unsigned h2=cvtpk_s(r2,0.f)&0xffffu;
      cx[s1]=(u32x4){h0|(h1<<16), h2|0x3f800000u, 0x3f803f80u, 0u}; } }
  float nm=c2g[q0+wid*QBLK+r32];
  DMA_K(0,0);DMA_V(0,0);DMA_K(1,SLOTB);
  bf16x8 qr[4];
  #pragma unroll
  for(int d0=0;d0<4;++d0)qr[d0]=*reinterpret_cast<const bf16x8*>(&Qw[(long)r32*DM+d0*16+hi*8]);
  float l_reg=0.f;f32x16 o[2];o[0]=f32x16{};o[1]=f32x16{};
  bf16x8 qx;
  #define QXBUILD() do{ const unsigned h0_=cvtpk_s(nm,0.f)&0xffffu; const float r1_=nm-__uint_as_float(h0_<<16); const unsigned h1_=cvtpk_s(r1_,0.f)&0xffffu; \
    const float r2_=r1_-__uint_as_float(h1_<<16); const unsigned h2_=cvtpk_s(r2_,0.f)&0xffffu; \
    u32x4 w_; w_[0]=hi?0u:0xbf80bf80u; w_[1]=hi?0u:(0xbf80u|(h0_<<16)); w_[2]=hi?0u:(h1_|(h2_<<16)); w_[3]=0u; qx=__builtin_bit_cast(bf16x8,w_); }while(0)
  #define CINIT(C0,C1,t) do{ const __attribute__((address_space(3))) bf16x8* cp_=(const __attribute__((address_space(3))) bf16x8*)(shm3+LDS_CL+(((t)+T0)*64+r32)*16); \
    const bf16x8 ka_=cp_[0], kb_=cp_[32];              \
    C0=__builtin_amdgcn_mfma_f32_32x32x16_bf16(ka_,qx,f32x16{},0,0,0); \
    C1=__builtin_amdgcn_mfma_f32_32x32x16_bf16(kb_,qx,f32x16{},0,0,0); }while(0)
  const int qrel=wid*QBLK+r32;
  #define CMASK(P0,P1,t) do{int jb_=(t)-(NT-4); if(jb_>=0)cmask(P0,P1,jb_,qrel,hi);}while(0)
  bool resc=false;
  #define START(P0,P1) do{ const float rm=rowmax(P0,P1); resc=false; \
    { const float dl=rm; nm=fsub_s(nm,dl); \
      _Pragma("unroll") for(int r=0;r<16;++r){P0[r]=fsub_s(P0[r],dl);P1[r]=fsub_s(P1[r],dl);} } \
    _Pragma("unroll") for(int r=0;r<16;++r)P0[r]=__builtin_amdgcn_exp2f(P0[r]); }while(0)
  #define RESC() do{ if(resc){ asm volatile("s_waitcnt lgkmcnt(0)":::"memory"); \
      _Pragma("unroll") for(int d_=0;d_<2;++d_) _Pragma("unroll") for(int r=0;r<16;++r)o[d_][r]*=wsf[crow(r,hi)]; } }while(0)
  f32x16 pA0,pA1,pB0,pB1;
  int sl_prev=0,sl_cur=0,sl_next=SLOTB;
  #define ROT() do{sl_prev=sl_cur;sl_cur=sl_next;sl_next=(sl_next==(NSLOT-1)*SLOTB)?0:sl_next+SLOTB;}while(0)
  DMA_K(2,2*SLOTB);
  WAIT_BAR(3);
  QXBUILD(); CINIT(pA0,pA1,0); qkt(pA0,pA1,Kbase,qr,r32,hi);asm volatile("s_nop 15\n\ts_nop 7":"+v"(pA0),"+v"(pA1));CMASK(pA0,pA1,0);
  START(pA0,pA1); QXBUILD();
  _Pragma("unroll") for(int r=0;r<16;++r)pA1[r]=__builtin_amdgcn_exp2f(pA1[r]);
  WAIT_BAR(0);
  DMA_K(3,0);DMA_V(1,SLOTB);
  ROT();
  kload8(kf,kp0+sl_cur);
  WAIT_BAR(2);
  s16x4 vlo[8],vhi[8]; u32x4 pw0,pw1,pw2,pw3;
  #define PKW(P,B) cvtpk_s(P[B],P[B+1])
  #define PAF(k) __builtin_bit_cast(bf16x8,pw##k)
  #define VFR(i) (bf16x8){vlo[i][0],vlo[i][1],vlo[i][2],vlo[i][3],vhi[i][0],vhi[i][1],vhi[i][2],vhi[i][3]}
  #define PIN(x) asm volatile("":"+v"(x))
  #define MX3(a,b,c) __builtin_fmaxf(__builtin_fmaxf((a),(b)),(c))
  #define GAPA(MF,A0,A1,A2,A3,W0,W1,PW) do{ MF; sacc+=A0; sacc+=A1; sacc+=A2; sacc+=A3; PIN(sacc); W0; W1; PIN(PW); SBAR(); }while(0)
  #define EX(v) __builtin_amdgcn_exp2f(v)
  #define GAPB(MF,X,B) do{ MF; X[B]=EX(X[B]); X[B+1]=EX(X[B+1]); X[B+2]=EX(X[B+2]); X[B+3]=EX(X[B+3]); PIN(X); SBAR(); }while(0)
  #define VRD(i) do{ vlo[i]=vtr(vp_+(((i)>>2)*4096+((i)&3)*1024)); vhi[i]=vtr(vp_+(((i)>>2)*4096+((i)&3)*1024+512)); }while(0)
  #define KRD(G,j) do{ if(G){ kload2(kf,kp0+sl_next,j); SBAR(); } }while(0)
  #define STEP(C0,C1,P0,P1,t,GK,GV,GL) do{ SBAR(); CINIT(C0,C1,t); SBAR(); \
    const lds_cptr vp_=vp0+sl_prev; \
    VRD(0); SBAR(); float sacc=(P0[0]+P0[1]); \
    GAPA(C0=__builtin_amdgcn_mfma_f32_32x32x16_bf16(kf[0],qr[0],C0,0,0,0), P0[2],P0[3],P0[4],P0[5],     pw0[0]=PKW(P0,0), pw0[1]=PKW(P0,2), pw0); \
    VRD(4); SBAR(); GAPA(C1=__builtin_amdgcn_mfma_f32_32x32x16_bf16(kf[1],qr[0],C1,0,0,0), P0[6],P0[7],P0[8],P0[9],     pw0[2]=PKW(P0,4), pw0[3]=PKW(P0,6), pw0); \
    VRD(1); SBAR(); GAPA(C0=__builtin_amdgcn_mfma_f32_32x32x16_bf16(kf[2],qr[1],C0,0,0,0),   P0[10],P0[11],P0[12],P0[13], pw1[0]=PKW(P0,8), pw1[1]=PKW(P0,10), pw1); \
    VRD(5); SBAR(); GAPA(C1=__builtin_amdgcn_mfma_f32_32x32x16_bf16(kf[3],qr[1],C1,0,0,0),   P0[14],P0[15],P1[0],P1[1],   pw1[2]=PKW(P0,12),pw1[3]=PKW(P0,14), pw1); \
    VRD(2); SBAR(); GAPA(C0=__builtin_amdgcn_mfma_f32_32x32x16_bf16(kf[4],qr[2],C0,0,0,0),   P1[2],P1[3],P1[4],P1[5],     pw2[0]=PKW(P1,0), pw2[1]=PKW(P1,2), pw2); \
    VRD(6); SBAR(); GAPA(C1=__builtin_amdgcn_mfma_f32_32x32x16_bf16(kf[5],qr[2],C1,0,0,0),   P1[6],P1[7],P1[8],P1[9],     pw2[2]=PKW(P1,4), pw2[3]=PKW(P1,6), pw2); \
    VRD(3); SBAR(); GAPA(C0=__builtin_amdgcn_mfma_f32_32x32x16_bf16(kf[6],qr[3],C0,0,0,0),   P1[10],P1[11],P1[12],P1[13], pw3[0]=PKW(P1,8), pw3[1]=PKW(P1,10), pw3); \
    VRD(7); SBAR(); GAPA(C1=__builtin_amdgcn_mfma_f32_32x32x16_bf16(kf[7],qr[3],C1,0,0,0),   P1[14],P1[15],0.f,0.f,       pw3[2]=PKW(P1,12),pw3[3]=PKW(P1,14), pw3); \
    l_reg+=sacc; \
    if(GK){DMA_K((t)+3,sl_cur);} if(GV){DMA_V((t)+1,sl_next);} \
    CMASK(C0,C1,t); \
    { float a=MX3(C0[0],C0[1],C1[0]),b=MX3(C0[2],C0[3],C1[1]); a=MX3(a,C1[2],C1[3]); \
      _Pragma("unroll") for(int r=4;r<16;r+=4){a=MX3(a,C0[r],C0[r+1]);b=MX3(b,C0[r+2],C0[r+3]);a=MX3(a,C1[r],C1[r+1]);b=MX3(b,C1[r+2],C1[r+3]);} \
      float rm=__builtin_fmaxf(a,b); { auto rr=__builtin_amdgcn_permlane32_swap(__float_as_uint(rm),__float_as_uint(rm),false,false); rm=__builtin_fmaxf(__uint_as_float(rr[0]),__uint_as_float(rr[1])); } \
      resc=false; \
      if(__builtin_expect(__any(rm>(float)THRL),0)){ const float dl=__builtin_fmaxf(rm,0.f); \
        { const u32x4 qw_=__builtin_bit_cast(u32x4,qx); nm=(__uint_as_float(qw_[1]&0xffff0000u)+__uint_as_float(qw_[2]<<16))+__uint_as_float(qw_[2]&0xffff0000u); } nm-=dl;     \
        _Pragma("unroll") for(int r=0;r<16;++r){C0[r]-=dl;C1[r]-=dl;} \
        const float f=__builtin_amdgcn_exp2f(-dl); l_reg*=f; if(hi==0)wsf[r32]=f; resc=true; QXBUILD(); } } \
    SBAR(); \
    GAPB(o[0]=__builtin_amdgcn_mfma_f32_32x32x16_bf16(PAF(0),VFR(0),o[0],0,0,0), C0,0); \
    GAPB(o[1]=__builtin_amdgcn_mfma_f32_32x32x16_bf16(PAF(0),VFR(4),o[1],0,0,0), C0,4); \
    KRD(GL,0); GAPB(o[0]=__builtin_amdgcn_mfma_f32_32x32x16_bf16(PAF(1),VFR(1),o[0],0,0,0), C0,8); \
    KRD(GL,1); GAPB(o[1]=__builtin_amdgcn_mfma_f32_32x32x16_bf16(PAF(1),VFR(5),o[1],0,0,0), C0,12); \
    KRD(GL,2); GAPB(o[0]=__builtin_amdgcn_mfma_f32_32x32x16_bf16(PAF(2),VFR(2),o[0],0,0,0), C1,0); \
    KRD(GL,3); GAPB(o[1]=__builtin_amdgcn_mfma_f32_32x32x16_bf16(PAF(2),VFR(6),o[1],0,0,0), C1,4); \
    GAPB(o[0]=__builtin_amdgcn_mfma_f32_32x32x16_bf16(PAF(3),VFR(3),o[0],0,0,0), C1,8); \
    GAPB(o[1]=__builtin_amdgcn_mfma_f32_32x32x16_bf16(PAF(3),VFR(7),o[1],0,0,0), C1,12); \
    }while(0)
  int t=1;
  #undef CMASK
  #define CMASK(P0,P1,t) do{}while(0)
  for(;t+5<NT;t+=2){
    STEP(pB0,pB1,pA0,pA1,t,true,true,true);     WAIT_BAR(2); RESC(); ROT();
    STEP(pA0,pA1,pB0,pB1,t+1,true,true,true);   WAIT_BAR(2); RESC(); ROT();
  }
  #undef CMASK
  #define CMASK(P0,P1,t) do{int jb_=(t)-(NT-4); if(jb_>=0)cmask(P0,P1,jb_,qrel,hi);}while(0)
  #define ENDW(tt) do{ if((tt)+3<NT){WAIT_BAR(2);} else if((tt)+2<NT){WAIT_BAR(1);} else {WAIT_BAR(0);} }while(0)
  for(;t+1<NT;t+=2){
    STEP(pB0,pB1,pA0,pA1,t,(t+3<NT),(t+1<NT),(t+1<NT));       ENDW(t);   RESC(); ROT();
    STEP(pA0,pA1,pB0,pB1,t+1,(t+4<NT),(t+2<NT),(t+2<NT));     ENDW(t+1); RESC(); ROT();
  }
  STEP(pB0,pB1,pA0,pA1,NT-1,false,false,false); RESC();
  { float sacc=pB0[0]+pB0[1]; _Pragma("unroll") for(int r=2;r<16;++r)sacc+=pB0[r]; _Pragma("unroll") for(int r=0;r<16;++r)sacc+=pB1[r]; l_reg+=sacc;
    pw0=(u32x4){PKW(pB0,0),PKW(pB0,2),PKW(pB0,4),PKW(pB0,6)};pw1=(u32x4){PKW(pB0,8),PKW(pB0,10),PKW(pB0,12),PKW(pB0,14)};pw2=(u32x4){PKW(pB1,0),PKW(pB1,2),PKW(pB1,4),PKW(pB1,6)};pw3=(u32x4){PKW(pB1,8),PKW(pB1,10),PKW(pB1,12),PKW(pB1,14)};
    SBAR(); pv(o,vb0+sl_cur,PAF(0),PAF(1),PAF(2),PAF(3)); }
  #undef PKW
  #undef PAF
  #undef VFR
  #undef PIN
  #undef MX3
  #undef GAPA
  #undef GAPB
  #undef EX
  #undef VRD
  #undef KRD
  #undef STEP
  #undef ENDW
  if(VERIFY){ volatile __attribute__((address_space(3))) float* vf=(volatile __attribute__((address_space(3))) float*)(shm3+LDS_VF);
    const u32x4 qw_=__builtin_bit_cast(u32x4,qx); float nmv=(__uint_as_float(qw_[1]&0xffff0000u)+__uint_as_float(qw_[2]<<16))+__uint_as_float(qw_[2]&0xffff0000u); if(hi)nmv=-3.0e38f;
    #pragma unroll
    for(int m_=1;m_<64;m_<<=1)nmv=__builtin_fmaxf(nmv,__shfl_xor(nmv,m_));
    if(lane==0)vf[wid]=nmv;
    asm volatile("s_waitcnt lgkmcnt(0)\n\ts_barrier":::"memory");
    float nmax=vf[0];
    #pragma unroll
    for(int w_=1;w_<NW;++w_)nmax=__builtin_fmaxf(nmax,vf[w_]);
    if(__builtin_expect(nmax>vf[9],0)){
      const float limr=nmax+vf[8]+(float)THRL; bool ok_=false; { int ln_=lane; asm volatile("":"+v"(ln_)); if(ln_<32){ const int t0c=2*ln_; ok_=(t0c==0)||(t0c<=4*qb && c2g[C2E_DELTA_FLOATS+64*t0c-1]>=limr); } }
      const unsigned long long mk_=__ballot(ok_); const int need_=2*(31-__builtin_clz((unsigned)(mk_&0xffffffffull)));
      if(need_<T0){ asm volatile("s_waitcnt lgkmcnt(0)\n\ts_barrier":::"memory"); return need_; } } }
  {auto rr=__builtin_amdgcn_permlane32_swap(__float_as_uint(l_reg),__float_as_uint(l_reg),false,false);l_reg=__uint_as_float(rr[0])+__uint_as_float(rr[1]);}
  if(hi==0)wsf[32+r32]=l_reg;asm volatile("s_waitcnt lgkmcnt(0)":::"memory");
  float rli[16];
  #pragma unroll
  for(int r=0;r<16;++r)rli[r]=__builtin_amdgcn_rcpf(wsf[32+crow(r,hi)]);
  bf16*Ow=O+(rowbase+q0+wid*QBLK)*DM+h*D;
  { bf16*stg=(bf16*)(shm+LDS_OST)+wid*2048;
    #pragma unroll
    for(int r=0;r<16;++r){const int orow=crow(r,hi);
      #pragma unroll
      for(int d0=0;d0<2;++d0)stg[orow*64+d0*32+r32]=__float2bfloat16(o[d0][r]*rli[r]);}
    asm volatile("s_waitcnt lgkmcnt(0)":::"memory");
    #pragma unroll
    for(int i=0;i<4;++i){const int row=i*8+(lane>>3),ch=lane&7; const u32x4 v=*(const u32x4*)(stg+row*64+ch*8); ATTN_STORE16(Ow+(long)row*DM+ch*8,v);} }
  asm volatile("s_waitcnt lgkmcnt(0)\n\ts_barrier":::"memory");
  #undef DMA_K
  #undef DMA_V
  #undef CMASK
  #undef CINIT
  #undef START
  #undef RESC
  #undef ROT
  return T0;
}
constexpr int ATTN_LDS_BYTES=LDS_BYTES;
struct AttnTensors { const bf16* Q; const bf16* K; const bf16* V; bf16* O; const float* C2; };
struct AttnUnit { int bh; int qb; int t0; };
struct StaticOrder {
  int vcu, G;
  __device__ __forceinline__ explicit StaticOrder(int grid,int block):vcu((grid%8==0)?(block%8)*(grid/8)+block/8:block),G(grid){}
  __device__ __forceinline__ bool next(int i,AttnUnit&u)const{
    if(G==256){ if(i>=8)return false; const int s=vcu&1, base=4*(i>>1); u.bh=vcu>>1; u.qb=(i&1)?base+3-s:base+s; u.t0=0; return true; }
    const int L=i*G+vcu; if(L>=BATCH*NHEAD*NQB)return false; u.bh=L/NQB; u.qb=L%NQB; u.t0=0; return true; }
  __device__ __forceinline__ void a_ready(const AttnUnit&)const{}
  __device__ __forceinline__ void done(const AttnUnit&)const{}
};
template<class Sched,int THRL=8> __device__ __forceinline__ void attn_phase(char*lds,const AttnTensors&T,const Sched&S){
  AttnUnit u;
  for(int i=0;S.next(i,u);++i){ S.a_ready(u); attn_unit<THRL>(u.bh/NHEAD,u.bh%NHEAD,u.qb,u.t0,T.Q,T.K,T.V,T.O,T.C2+(size_t)u.bh*SEQ,lds); S.done(u); }
}
constexpr float GUESS_SLACK=12.f;
constexpr float SKIP_THR=12.f;
template<int THRL=8> __device__ __forceinline__ void attn_phase_queue(char*lds,const AttnTensors&T,unsigned*ctr,const float*STAT,int ctl_off){
  const int tid=threadIdx.x,lane=tid&63;
  volatile __attribute__((address_space(3))) unsigned* slot=(volatile __attribute__((address_space(3))) unsigned*)((__attribute__((address_space(3))) char*)lds+ctl_off);
  if(tid==0) *(volatile __attribute__((address_space(3))) unsigned*)((__attribute__((address_space(3))) char*)lds+LDS_VF+64)=0u;
  for(;;){
    if(tid==0) slot[0]=__hip_atomic_fetch_add(ctr,1u,__ATOMIC_RELAXED,__HIP_MEMORY_SCOPE_AGENT);
    __syncthreads();
    const unsigned un=slot[0];
    __syncthreads();
    if(un>=(unsigned)(BATCH*NHEAD*NQB))break;
    const int qb=NQB-1-(int)(un>>7), bh=(int)(un&127), q0=qb*QB;
    const float*c2g=T.C2+(size_t)bh*SEQ;
    const float qq=STAT[bh*4+0]+STAT[bh*4+1], kk=STAT[bh*4+2]+STAT[bh*4+3];
    const float qk_thr=1.02f*sqrtf(qq*kk)+SKIP_THR, nm_guess=c2g[q0]+GUESS_SLACK;
    const float lim=nm_guess+qk_thr;
    volatile __attribute__((address_space(3))) float* vf=(volatile __attribute__((address_space(3))) float*)((__attribute__((address_space(3))) char*)lds+LDS_VF);
    if(tid==0){ vf[8]=qk_thr; vf[9]=nm_guess; }
    bool ok=false; { int ln_=lane; asm volatile("":"+v"(ln_)); if(ln_<32){ const int t0c=2*ln_; ok=(t0c==0)||(t0c<=4*qb && c2g[C2E_DELTA_FLOATS+64*t0c-1]>=lim); } }
    const unsigned long long mk=__ballot(ok);
    const int t0=2*(31-__builtin_clz((unsigned)(mk&0xffffffffull)));
    { const int need_=attn_unit<THRL,true>(bh/NHEAD,bh%NHEAD,qb,t0,T.Q,T.K,T.V,T.O,c2g,lds);
      if(need_<t0 && tid==0){ volatile __attribute__((address_space(3))) unsigned* fl=(volatile __attribute__((address_space(3))) unsigned*)(vf+16); const unsigned n_=fl[0]; fl[1+n_]=un|((unsigned)need_<<16); fl[0]=n_+1u; } }
  }
  __syncthreads();
  { volatile __attribute__((address_space(3))) unsigned* fl=(volatile __attribute__((address_space(3))) unsigned*)((__attribute__((address_space(3))) char*)lds+LDS_VF+64);
    const unsigned nf=fl[0];
    for(unsigned i=0;i<nf;++i){ const unsigned e=fl[1+i]; const unsigned un=e&0xffffu; const int need=(int)(e>>16); const int qb=NQB-1-(int)(un>>7), bh=(int)(un&127);
      attn_unit<THRL,false>(bh/NHEAD,bh%NHEAD,qb,need,T.Q,T.K,T.V,T.O,T.C2+(size_t)bh*SEQ,lds); } }
}
#undef SBAR
#undef WAIT_BAR
}
#define GAS __attribute__((address_space(1)))
#define LAS __attribute__((address_space(3)))
typedef unsigned short bf16;
typedef unsigned v4u __attribute__((ext_vector_type(4)));
typedef float f32x4 __attribute__((ext_vector_type(4)));
typedef short bf16x8 __attribute__((ext_vector_type(8)));
typedef GAS unsigned gu32;
typedef GAS unsigned long long gu64;
#define RLX_AGENT __ATOMIC_RELAXED, __HIP_MEMORY_SCOPE_AGENT
#define LDS_WAIT() asm volatile("s_waitcnt lgkmcnt(0)" ::: "memory")
#define VM_WAIT() asm volatile("s_waitcnt vmcnt(0)" ::: "memory")
__device__ __forceinline__ unsigned long long rt() { return __builtin_amdgcn_s_memrealtime(); }
__device__ __forceinline__ unsigned f2bf(float f) { unsigned u = __builtin_bit_cast(unsigned, f); return (u + 0x7fffu + ((u >> 16) & 1u)) >> 16; }
__device__ __forceinline__ unsigned pk2(float lo, float hi) { return f2bf(lo) | (f2bf(hi) << 16); }

#define XB_TMO      128
#define XB_XCNT(j)  (256  + 64 * (j))
#define XB_XSUB(j)  (1280 + 64 * (j))
#define XB_XGEN(j)  (2304 + 64 * (j))
#define XB_TOP      3328
#define XB_TOPGEN   3392
#define XCD_BAR_WORDS 3456
#define XB_SPIN_CAP (1u << 18)

__device__ __forceinline__ unsigned xb_ld(unsigned* p)              { return __hip_atomic_load(p, __ATOMIC_RELAXED, __HIP_MEMORY_SCOPE_AGENT); }
__device__ __forceinline__ unsigned xb_add(unsigned* p, unsigned v) { return __hip_atomic_fetch_add(p, v, __ATOMIC_RELAXED, __HIP_MEMORY_SCOPE_AGENT); }
__device__ __forceinline__ unsigned xb_xcc_id() { return (unsigned)__builtin_amdgcn_s_getreg((3 << 11) | 20) & 0xFu; }
#define XB_SPIN(cond, bar) do { unsigned _sp = 0; while (cond) { __builtin_amdgcn_s_sleep(1); \
    if ((++_sp & 255u) == 0u) { if (xb_ld(&(bar)[XB_TMO])) break; if (_sp > XB_SPIN_CAP) { atomicAdd(&(bar)[XB_TMO], 1u); break; } } } } while (0)

struct XcdBarrier {
    unsigned* bar; unsigned x;
    volatile LAS unsigned* st;
};

__device__ __forceinline__ XcdBarrier xcd_barrier_post(unsigned* bar, volatile LAS unsigned* st) {
    XcdBarrier b; b.bar = bar; b.x = xb_xcc_id(); b.st = st;
    if (threadIdx.x == 0) (void)xb_add(&bar[XB_XCNT(b.x)], 1u);
    return b;
}
__device__ __forceinline__ void xcd_barrier_complete(unsigned* bar, unsigned x, unsigned& nloc, unsigned& nx) {
    const unsigned G = gridDim.x * gridDim.y * gridDim.z;
    unsigned sum, cnt, mine, sp = 0u;
    for (;;) {
        sum = 0u; cnt = 0u; mine = 0u;
#pragma unroll
        for (unsigned j = 0; j < 16; ++j) { const unsigned c = xb_ld(&bar[XB_XCNT(j)]); sum += c; cnt += (c > 0u) ? 1u : 0u; mine = (j == x) ? c : mine; }
        if (sum == G) break;
        __builtin_amdgcn_s_sleep(1);
        if ((++sp & 255u) == 0u) { if (xb_ld(&bar[XB_TMO])) break; if (sp > XB_SPIN_CAP) { atomicAdd(&bar[XB_TMO], 1u); break; } }
    }
    nloc = mine > 0u ? mine : 1u; nx = cnt > 0u ? cnt : 1u;
}

__device__ __forceinline__ void xcd_barrier(const XcdBarrier& b) {
    asm volatile("s_waitcnt vmcnt(0)" ::: "memory");
    __syncthreads();
    if (threadIdx.x == 0) {
        unsigned* bar = b.bar;
        __builtin_amdgcn_s_waitcnt(0);
        unsigned nloc = b.st[0], nx = b.st[1];
        if (nloc == 0u) { xcd_barrier_complete(bar, b.x, nloc, nx); b.st[0] = nloc; b.st[1] = nx; }
        const unsigned old = xb_add(&bar[XB_XSUB(b.x)], 1u);
        const unsigned gen = old / nloc;
        if (old + 1u == (gen + 1u) * nloc) {
            __builtin_amdgcn_fence(__ATOMIC_RELEASE, "agent");
            asm volatile("s_waitcnt vmcnt(0)" ::: "memory");
            const unsigned og = xb_add(&bar[XB_TOP], 1u);
            const unsigned tg = og / nx;
            if (og + 1u == (tg + 1u) * nx) xb_add(&bar[XB_TOPGEN], 1u);
            else XB_SPIN(xb_ld(&bar[XB_TOPGEN]) == tg, bar);
            __builtin_amdgcn_fence(__ATOMIC_ACQUIRE, "agent");
            xb_add(&bar[XB_XGEN(b.x)], 1u);
            asm volatile("s_waitcnt vmcnt(0)" ::: "memory");
        } else {
            XB_SPIN(xb_ld(&bar[XB_XGEN(b.x)]) == gen, bar);
            __builtin_amdgcn_fence(__ATOMIC_ACQUIRE, "agent");
            asm volatile("s_waitcnt vmcnt(0)" ::: "memory");
        }
    }
    __syncthreads();
}

constexpr int BATCH = 8, SEQ = 4096, D = 1024, M = BATCH * SEQ, NHEADS = 16, HDIM = 64;
constexpr int INC = 7184, N1 = 7168;
constexpr int PHEADS = 8, PNK = 128, PDK = 256, PTOPK = 16, NQP = PHEADS * PDK, NEXP = PNK * PNK, NSEL = PHEADS * PTOPK;
constexpr float EPS = 1e-6f, LOG2E = 1.4426950408889634f;
constexpr float U_SCALE = 800.f, V_SCALE = 16.f, A_SCALE = 32.f;
constexpr int NWAVES = 8;

constexpr size_t MiB = 1u << 20;
constexpr size_t WS_CTL = 0, CTL_ZERO_BYTES = 1 * MiB;
constexpr size_t WS_LOGF = 1 * MiB;
constexpr size_t WS_C2 = 3 * MiB;
constexpr size_t WS_C2E = 6 * MiB;
static_assert(WS_C2E - WS_C2 == (size_t)C2E_DELTA_FLOATS * 4, "C2E sits a fixed distance behind C2");
constexpr size_t WS_K1 = 5 * MiB, WS_K2 = 5 * MiB + 256 * 1024;
constexpr size_t WS_WIN = 8 * MiB;
constexpr size_t WS_WC = 22 * MiB, WS_WF = 24 * MiB, WS_WO = 26 * MiB, WS_WQ = 28 * MiB;
constexpr size_t WS_U = 32 * MiB, WS_VT = 64 * MiB;
constexpr size_t WS_XN = 96 * MiB;
constexpr size_t WS_GLU = 160 * MiB;
constexpr size_t WS_QO = 224 * MiB, WS_K = 288 * MiB, WS_V = 352 * MiB;
constexpr size_t WS_QP = 96 * MiB;
constexpr size_t WS_IDX = 352 * MiB;
constexpr size_t WS_GATE = 360 * MiB;
constexpr size_t WS_ACT = 376 * MiB;
constexpr size_t WS_HHI = 224 * MiB, WS_HLO = 256 * MiB;
constexpr size_t WS_PART = 96 * MiB;
#ifndef PEER_SLICED
#define PEER_SLICED 1
#endif
constexpr size_t WS_END = 416 * MiB;

constexpr int CW_BAR = 4096, CW_ATTQ = 8192 + 64, CW_STAT = 16384, CW_RSS = 32768;

constexpr int RING_OFF = 0, RING_BYTES = 131072;
constexpr int LDS_BYTES = 155648, LDSCTL_OFF = 154624, MISC_OFF = LDSCTL_OFF + 320;
static_assert(MISC_OFF + 128 <= LDS_BYTES, "LDS map");

__device__ __forceinline__ float wave_sum(float v) {
#pragma unroll
    for (int o = 1; o < 64; o <<= 1) v += __shfl_xor(v, o);
    return v;
}
__device__ __forceinline__ float sigmoidf_(float x) { return __builtin_amdgcn_rcpf(1.f + __builtin_amdgcn_exp2f(-x * LOG2E)); }
__device__ __forceinline__ float bf_lo(unsigned v) { return __uint_as_float(v << 16); }
__device__ __forceinline__ float bf_hi(unsigned v) { return __uint_as_float(v & 0xffff0000u); }
typedef unsigned u32x2 __attribute__((ext_vector_type(2)));

__device__ __forceinline__ void p0_transpose_item(const float* W, int ldw, int col0, bf16* WT, int K, int drow0, LAS float* scr, int kb, int lane, const float* kscale = nullptr) {
    const int k0 = 64 * kb;
    float tv[32];
#pragma unroll
    for (int i = 0; i < 32; ++i) tv[i] = W[(size_t)(k0 + 2 * i + (lane >> 5)) * ldw + col0 + (lane & 31)];
    if (kscale) {
#pragma unroll
        for (int i = 0; i < 32; ++i) tv[i] *= kscale[k0 + 2 * i + (lane >> 5)]; }
#pragma unroll
    for (int i = 0; i < 32; ++i) scr[(2 * i + (lane >> 5)) * 33 + (lane & 31)] = tv[i];
    LDS_WAIT(); asm volatile("" ::: "memory");
    const int c = lane & 7;
#pragma unroll
    for (int j = 0; j < 4; ++j) { const int n = (lane >> 3) + 8 * j; const LAS float* s = scr + (8 * c) * 33 + n;
        v4u o; o.x = pk2(s[0 * 33], s[1 * 33]); o.y = pk2(s[2 * 33], s[3 * 33]); o.z = pk2(s[4 * 33], s[5 * 33]); o.w = pk2(s[6 * 33], s[7 * 33]);
        *(GAS v4u*)(WT + (size_t)(drow0 + n) * K + k0 + 8 * c) = o; }
    LDS_WAIT(); asm volatile("" ::: "memory");
}
__device__ __forceinline__ float log_sigmoid_(float z) { return fminf(z, 0.f) - log1pf(expf(-fabsf(z))); }

struct P0Args { const float *g2; const float *x, *g1, *w_in, *w_conv_out, *w_fox_out, *w_out, *peer_wq, *k1, *k2, *u, *v, *fox_bf;
                bf16 *WIN, *WC, *WF, *WO, *WQ, *K1b, *K2b; unsigned char *Uq, *Vq; bf16* XN; float* LOGF; };
constexpr int P0_I_U = NEXP * D / 4096;
__device__ __forceinline__ void p0_table_iter(const P0Args& a, int it, int lane) {
    f32x4 gq[4];
#pragma unroll
    for (int j = 0; j < 4; ++j) gq[j] = *(const GAS f32x4*)(a.g2 + 4 * lane + 256 * j);
    const bool isv = it >= P0_I_U; const int r = isv ? it - P0_I_U : it;
    const float* src = isv ? a.v : a.u; unsigned char* dst = isv ? a.Vq : a.Uq; const float sc = isv ? V_SCALE : U_SCALE;
    const size_t e0 = (size_t)r * 4096 + 4 * lane; f32x4 p[16];
#pragma unroll
    for (int k = 0; k < 16; ++k) p[k] = __builtin_nontemporal_load((const GAS f32x4*)(src + e0 + 256 * k));
#pragma unroll
    for (int k = 0; k < 16; ++k) { f32x4 t = p[k] * sc; if (PEER_SLICED && !isv) t = t * gq[k & 3]; int w = __builtin_amdgcn_cvt_pk_fp8_f32(t.x, t.y, 0, false); w = __builtin_amdgcn_cvt_pk_fp8_f32(t.z, t.w, w, true);
        if (PEER_SLICED && !isv) {
            const int q0 = (int)__builtin_rintf(fminf(fmaxf(t.x, -127.f), 127.f)), q1 = (int)__builtin_rintf(fminf(fmaxf(t.y, -127.f), 127.f)), q2 = (int)__builtin_rintf(fminf(fmaxf(t.z, -127.f), 127.f)), q3 = (int)__builtin_rintf(fminf(fmaxf(t.w, -127.f), 127.f));
            w = (q0 & 0xff) | ((q1 & 0xff) << 8) | ((q2 & 0xff) << 16) | (q3 << 24); }
        const size_t ee = e0 + 256 * k;
        if (PEER_SLICED) { const size_t erow = ee >> 10; const int dcol = (int)(ee & 1023); *(GAS unsigned*)(dst + (size_t)(dcol >> 7) * ((size_t)NEXP * 128) + erow * 128 + (dcol & 127)) = (unsigned)w; }
        else *(GAS unsigned*)(dst + ee) = (unsigned)w; }
}
struct TableOrder {
    pg8::StaticOrder S; P0Args a; int gw, ngw, lane, slot; mutable int cnt = 0;
    __device__ __forceinline__ bool next(int i, pg8::Unit& u) const { return S.next(i, u); }
    __device__ __forceinline__ void a_ready(const pg8::Unit&) const {}
    __device__ __forceinline__ void done(const pg8::Unit&) const { const int d = cnt++ - slot;
        if (d >= 0 && d < 12 && d % 3 == 0) { const int it = gw + (d / 3) * ngw; if (it < 2 * P0_I_U) p0_table_iter(a, it, lane); } }
};
__device__ __forceinline__ void p0_prologue(LAS unsigned char* lds, const P0Args& a, int vcu, int G, int tid, int parts = 15) {
    const int lane = tid & 63, wave = __builtin_amdgcn_readfirstlane(tid >> 6);
    LAS float* scr = (LAS float*)(lds + wave * 8704);
    LAS float* wfT = (LAS float*)(lds + 69632);
    const int gw = vcu * NWAVES + wave, NGW = G * NWAVES;
#pragma unroll
    for (int c = tid; c < 4096; c += NWAVES * 64) { const int d = c >> 2, q4 = c & 3; const f32x4 t = *(const GAS f32x4*)(a.w_in + (size_t)d * INC + 5120 + 4 * q4);
        wfT[(4 * q4 + 0) * 1024 + d] = t.x; wfT[(4 * q4 + 1) * 1024 + d] = t.y; wfT[(4 * q4 + 2) * 1024 + d] = t.z; wfT[(4 * q4 + 3) * 1024 + d] = t.w; }
    __syncthreads();
    if (parts & 1) {
        const GAS f32x4* gp = (const GAS f32x4*)a.g1 + lane; f32x4 gv[4];
#pragma unroll
        for (int j = 0; j < 4; ++j) gv[j] = gp[64 * j];
        const float fb = a.fox_bf[(lane >> 2) & 15];
        for (int m0 = gw * 4; m0 < M; m0 += NGW * 4) {
            f32x4 va[4][4];
#pragma unroll
            for (int rr = 0; rr < 4; ++rr) { const GAS f32x4* xr = (const GAS f32x4*)(a.x + (size_t)(m0 + rr) * D) + lane;
#pragma unroll
                for (int j = 0; j < 4; ++j) va[rr][j] = xr[64 * j]; }
#pragma unroll
            for (int rr = 0; rr < 4; ++rr) {
            const int m = m0 + rr;
            f32x4 v[4]; float s = 0.f;
#pragma unroll
            for (int j = 0; j < 4; ++j) { v[j] = va[rr][j]; s += (v[j].x * v[j].x + v[j].y * v[j].y) + (v[j].z * v[j].z + v[j].w * v[j].w); }
            const float rstd = 1.0f / sqrtf(wave_sum(s) * (1.f / D) + EPS);
#pragma unroll
            for (int j = 0; j < 4; ++j) v[j] = v[j] * rstd * gv[j];
            GAS unsigned long long* o8 = (GAS unsigned long long*)(a.XN + (size_t)m * D) + lane;
#pragma unroll
            for (int j = 0; j < 4; ++j) o8[64 * j] = (unsigned long long)pk2(v[j].x, v[j].y) | ((unsigned long long)pk2(v[j].z, v[j].w) << 32);
            float fp[16];
#pragma unroll
            for (int jj = 0; jj < 16; ++jj) { typedef float f32x2 __attribute__((ext_vector_type(2))); f32x2 t2 = {0.f, 0.f};
#pragma unroll
                for (int j = 0; j < 4; ++j) { const f32x4 w = *(const LAS f32x4*)(wfT + jj * 1024 + 256 * j + 4 * lane);
                    t2 = __builtin_elementwise_fma((f32x2){v[j].x, v[j].y}, (f32x2){w.x, w.y}, t2); t2 = __builtin_elementwise_fma((f32x2){v[j].z, v[j].w}, (f32x2){w.z, w.w}, t2); }
                fp[jj] = t2.x + t2.y; if (jj & 1) __builtin_amdgcn_sched_barrier(0); }
#pragma unroll
            for (int st = 0; st < 4; ++st) { const int msk = 32 >> st, n = 8 >> st; const bool up = (lane & msk) != 0;
#pragma unroll
                for (int i = 0; i < n; ++i) { float a_ = fp[i], b_ = fp[i + n]; asm volatile("" : "+v"(a_), "+v"(b_));
                    const float mine = up ? b_ : a_, theirs = up ? a_ : b_; fp[i] = mine + __shfl_xor(theirs, msk); } }
            float ft = fp[0]; ft += __shfl_xor(ft, 1); ft += __shfl_xor(ft, 2);
            if ((lane & 3) == 0) a.LOGF[((size_t)(m / SEQ) * 16 + ((lane >> 2) & 15)) * SEQ + (m & (SEQ - 1))] = log_sigmoid_(ft + fb);
            }
        }
    }
    if (parts & 2) for (int it = gw; it < 6144; it += NGW) {
        int r = it;
        if (r < 512)  { const int nb = r & 31, kb = r >> 5; p0_transpose_item(a.w_in, INC, 32 * nb, a.WIN, D, (nb >> 2) * 256 + (nb & 3) * 32, scr, kb, lane); continue; } r -= 512;
        if (r < 512)  { const int nb = r & 31, kb = r >> 5; p0_transpose_item(a.w_in, INC, 1024 + 32 * nb, a.WIN, D, (nb >> 2) * 256 + 128 + (nb & 3) * 32, scr, kb, lane); continue; } r -= 512;
        if (r < 1536) { const int nb = r % 96, kb = r / 96; p0_transpose_item(a.w_in, INC, 2048 + 32 * nb, a.WIN, D, 2048 + 32 * nb, scr, kb, lane); continue; } r -= 1536;
        if (r < 1024) { const int nb = r & 63, kb = r >> 6; p0_transpose_item(a.w_in, INC, 5136 + 32 * nb, a.WIN, D, 5120 + 32 * nb, scr, kb, lane); continue; } r -= 1024;
        if (r < 512)  { const int nb = r & 31, kb = r >> 5; p0_transpose_item(a.w_conv_out, D, 32 * nb, a.WC, D, 32 * nb, scr, kb, lane); continue; } r -= 512;
        if (r < 512)  { const int nb = r & 31, kb = r >> 5; p0_transpose_item(a.w_fox_out, D, 32 * nb, a.WF, D, 32 * nb, scr, kb, lane); continue; } r -= 512;
        if (r < 512)  { const int nb = r & 31, kb = r >> 5; p0_transpose_item(a.w_out, D, 32 * nb, a.WO, D, 32 * nb, scr, kb, lane); continue; } r -= 512;
        { const int nb = r & 63, kb = r >> 6; p0_transpose_item(a.peer_wq, NQP, 32 * nb, a.WQ, D, 32 * nb, scr, kb, lane, a.g2); }
    }
    constexpr int I_K = PHEADS * PNK * 128 / 512;
    if (parts & 4) for (int it = gw; it < 2 * I_K; it += NGW) {
        int r = it; const float* src; bf16* dst;
        if (r < I_K) { src = a.k1; dst = a.K1b; } else { r -= I_K; src = a.k2; dst = a.K2b; }
        const size_t e0 = (size_t)r * 512 + 8 * lane;
        const f32x4 p = *(const GAS f32x4*)(src + e0), q = *(const GAS f32x4*)(src + e0 + 4);
        v4u o; o.x = pk2(p.x, p.y); o.y = pk2(p.z, p.w); o.z = pk2(q.x, q.y); o.w = pk2(q.z, q.w);
        *(GAS v4u*)(dst + e0) = o;
    }
    if (parts & 8) for (int it = gw; it < 2 * P0_I_U; it += NGW) p0_table_iter(a, it, lane);
}

namespace pg8 {
struct EpiP1 {
    static constexpr bool PERM = true, AFTER_DRAIN = false;
    bf16_t *GLU, *Q, *K, *V, *GA, *GB; float qscale; unsigned* STAT;
    __device__ __forceinline__ void operator()(const f32x4 (&acc)[2][2][4][2], const Unit& u, int wr, int wc, int fr, int fq) const {
        const int row0 = u.pm * BM + wr * 64 + fr;
        if (u.pn < 8) {
            const int col = 128 * u.pn + wc * 32 + 8 * fq;
#pragma unroll
            for (int ai = 0; ai < 2; ++ai)
#pragma unroll
                for (int m = 0; m < 4; ++m) {
                    const f32x4 v0 = acc[ai][0][m][0], v1 = acc[ai][0][m][1], g0 = acc[ai][1][m][0], g1 = acc[ai][1][m][1];
                    u32x4 w;
                    w.x = cvt_pk_bf16(v0[0] * sigmoidf_(g0[0]), v0[1] * sigmoidf_(g0[1])); w.y = cvt_pk_bf16(v0[2] * sigmoidf_(g0[2]), v0[3] * sigmoidf_(g0[3]));
                    w.z = cvt_pk_bf16(v1[0] * sigmoidf_(g1[0]), v1[1] * sigmoidf_(g1[1])); w.w = cvt_pk_bf16(v1[2] * sigmoidf_(g1[2]), v1[3] * sigmoidf_(g1[3]));
                    *(u32x4*)(GLU + (size_t)(row0 + ai * HALF + m * 16) * 1024 + col) = w;
                }
        } else {
            const int t = (u.pn - 8) >> 2, colt = ((u.pn - 8) & 3) * 256 + wc * 32 + 8 * fq;
            bf16_t* base = t == 0 ? Q : t == 1 ? K : t == 2 ? V : t == 3 ? GA : GB;
            const float sc = t == 0 ? qscale : 1.f;
#pragma unroll
            for (int ai = 0; ai < 2; ++ai)
#pragma unroll
                for (int m = 0; m < 4; ++m) { bf16_t* rowp = base + (size_t)(row0 + ai * HALF + m * 16) * 1024 + colt;
#pragma unroll
                    for (int bj = 0; bj < 2; ++bj) { f32x4 v0 = acc[ai][bj][m][0], v1 = acc[ai][bj][m][1];
                        if (t >= 3) {
#pragma unroll
                            for (int i = 0; i < 4; ++i) { v0[i] = sigmoidf_(v0[i]); v1[i] = sigmoidf_(v1[i]); }
                        } else { v0 = v0 * sc; v1 = v1 * sc; }
                        u32x4 w; w.x = cvt_pk_bf16(v0[0], v0[1]); w.y = cvt_pk_bf16(v0[2], v0[3]); w.z = cvt_pk_bf16(v1[0], v1[1]); w.w = cvt_pk_bf16(v1[2], v1[3]);
                        *(u32x4*)(rowp + bj * HALF) = w; } }
            if (t <= 1) {
                float mx[2] = {0.f, 0.f};
#pragma unroll
                for (int ai = 0; ai < 2; ++ai)
#pragma unroll
                    for (int m = 0; m < 4; ++m)
#pragma unroll
                        for (int bj = 0; bj < 2; ++bj) { const f32x4 v0 = acc[ai][bj][m][0] * sc, v1 = acc[ai][bj][m][1] * sc;
                            float s = (v0[0] * v0[0] + v0[1] * v0[1]) + (v0[2] * v0[2] + v0[3] * v0[3]) + (v1[0] * v1[0] + v1[1] * v1[1]) + (v1[2] * v1[2] + v1[3] * v1[3]);
                            s += __shfl_xor(s, 16); s += __shfl_xor(s, 32); mx[bj] = fmaxf(mx[bj], s); }
#pragma unroll
                for (int bj = 0; bj < 2; ++bj) { float v = mx[bj];
#pragma unroll
                    for (int o = 1; o < 16; o <<= 1) v = fmaxf(v, __shfl_xor(v, o));
                    if ((fr | fq) == 0) atomicMax(STAT + ((u.pm >> 4) * 16 + ((u.pn - 8) & 3) * 4 + bj * 2 + (wc >> 1)) * 4 + 2 * t + (wc & 1), __float_as_uint(v)); }
            }
        }
    }
};
struct EpiDual {
    static constexpr bool PERM = true, AFTER_DRAIN = false;
    const bf16_t *GA, *GB; bf16_t* O;
    __device__ __forceinline__ void operator()(f32x4 (&acc)[2][2][4][2], const Unit& u, int wr, int wc, int fr, int fq) const {
        const int row0 = u.pm * BM + wr * 64 + fr, col0 = u.pn * BM + wc * 32 + 8 * fq;
#pragma unroll
        for (int ai = 0; ai < 2; ++ai)
#pragma unroll
            for (int m = 0; m < 4; ++m)
#pragma unroll
                for (int bj = 0; bj < 2; ++bj) {
                    const size_t off = (size_t)(row0 + ai * HALF + m * 16) * 1024 + col0 + bj * HALF;
                    const u32x4 gb = *(const u32x4*)(GB + off);
                    if (u.seg == 0) {
                        const u32x4 ga = *(const u32x4*)(GA + off);
#pragma unroll
                        for (int i = 0; i < 4; ++i) { const unsigned a_ = ga[i], b_ = gb[i]; const int n = i >> 1, e = (i & 1) * 2;
                            acc[ai][bj][m][n][e]     *= bf_lo(a_) * __builtin_amdgcn_rcpf(fmaxf(bf_lo(b_), 1e-30f));
                            acc[ai][bj][m][n][e + 1] *= bf_hi(a_) * __builtin_amdgcn_rcpf(fmaxf(bf_hi(b_), 1e-30f)); }
                    } else {
                        u32x4 w;
#pragma unroll
                        for (int i = 0; i < 4; ++i) { const unsigned b_ = gb[i]; const int n = i >> 1, e = (i & 1) * 2;
                            w[i] = cvt_pk_bf16(acc[ai][bj][m][n][e] * bf_lo(b_), acc[ai][bj][m][n][e + 1] * bf_hi(b_)); }
                        *(u32x4*)(O + off) = w;
                    }
                }
    }
};
struct DualOrder {
    StaticOrder S; int ntile, G, c;
    __device__ __forceinline__ void init(int M_, int N_, int G_, int c_) { S.init(M_, N_, G_, c_); ntile = S.nwg; G = G_; c = c_; }
    __device__ __forceinline__ bool next(int i, Unit& u) const { if (!S.next(i >> 1, u)) return false; u.seg = i & 1; return true; }
    __device__ __forceinline__ void a_ready(const Unit&) const {}
    __device__ __forceinline__ void done(const Unit&) const {}
};
typedef float pf32x2 __attribute__((ext_vector_type(2))); typedef unsigned pu32x2 __attribute__((ext_vector_type(2)));
struct EpiResNorm {
    static constexpr bool PERM = true, AFTER_DRAIN = false;
    const float* base; bf16_t* X1b; float* RSS; const float* g2; unsigned char *HHI, *HLO;
    __device__ __forceinline__ void operator()(const f32x4 (&acc)[2][2][4][2], const Unit& u, int wr, int wc, int fr, int fq) const {
        const int row0 = u.pm * BM + wr * 64 + fr, col0 = u.pn * BM + wc * 32 + 8 * fq;
#pragma unroll
        for (int ai = 0; ai < 2; ++ai)
#pragma unroll
            for (int m = 0; m < 4; ++m) { float ss = 0.f; const int row = row0 + ai * HALF + m * 16;
#pragma unroll
                for (int bj = 0; bj < 2; ++bj) {
                    const size_t off = (size_t)row * 1024 + col0 + bj * HALF;
                    const f32x4 x0 = *(const f32x4*)(base + off) + acc[ai][bj][m][0], x1 = *(const f32x4*)(base + off + 4) + acc[ai][bj][m][1];
                    ss += (x0[0] * x0[0] + x0[1] * x0[1]) + (x0[2] * x0[2] + x0[3] * x0[3]) + (x1[0] * x1[0] + x1[1] * x1[1]) + (x1[2] * x1[2] + x1[3] * x1[3]);
                    u32x4 w; w.x = cvt_pk_bf16(x0[0], x0[1]); w.y = cvt_pk_bf16(x0[2], x0[3]); w.z = cvt_pk_bf16(x1[0], x1[1]); w.w = cvt_pk_bf16(x1[2], x1[3]);
                    *(u32x4*)(X1b + off) = w;
                    if (HHI) {
                        const int cc = col0 + bj * HALF;
                        const f32x4 s0 = x0 * *(const f32x4*)(g2 + cc) * 16.f, s1 = x1 * *(const f32x4*)(g2 + cc + 4) * 16.f;
                        int a0 = __builtin_amdgcn_cvt_pk_fp8_f32(s0[0], s0[1], 0, false); a0 = __builtin_amdgcn_cvt_pk_fp8_f32(s0[2], s0[3], a0, true);
                        int a1 = __builtin_amdgcn_cvt_pk_fp8_f32(s1[0], s1[1], 0, false); a1 = __builtin_amdgcn_cvt_pk_fp8_f32(s1[2], s1[3], a1, true);
                        const pf32x2 d0 = __builtin_amdgcn_cvt_pk_f32_fp8(a0, false), d1 = __builtin_amdgcn_cvt_pk_f32_fp8(a0, true), d2 = __builtin_amdgcn_cvt_pk_f32_fp8(a1, false), d3 = __builtin_amdgcn_cvt_pk_f32_fp8(a1, true);
                        int b0 = __builtin_amdgcn_cvt_pk_fp8_f32((s0[0] - d0.x) * 16.f, (s0[1] - d0.y) * 16.f, 0, false); b0 = __builtin_amdgcn_cvt_pk_fp8_f32((s0[2] - d1.x) * 16.f, (s0[3] - d1.y) * 16.f, b0, true);
                        int b1 = __builtin_amdgcn_cvt_pk_fp8_f32((s1[0] - d2.x) * 16.f, (s1[1] - d2.y) * 16.f, 0, false); b1 = __builtin_amdgcn_cvt_pk_fp8_f32((s1[2] - d3.x) * 16.f, (s1[3] - d3.y) * 16.f, b1, true);
                        const size_t hoff = (size_t)(cc >> 7) * ((size_t)32768 * 128) + (size_t)row * 128 + (cc & 127);
                        *(pu32x2*)(HHI + hoff) = (pu32x2){(unsigned)a0, (unsigned)a1}; *(pu32x2*)(HLO + hoff) = (pu32x2){(unsigned)b0, (unsigned)b1};
                    }
                }
                ss += __shfl_xor(ss, 16); ss += __shfl_xor(ss, 32);
                if (fq == 0) unsafeAtomicAdd(RSS + row, ss);
            }
    }
};
struct EpiScaleRow {
    static constexpr bool PERM = true, AFTER_DRAIN = false;
    bf16_t* O; int ldc; const float* RSS;
    __device__ __forceinline__ void operator()(const f32x4 (&acc)[2][2][4][2], const Unit& u, int wr, int wc, int fr, int fq) const {
        const int row0 = u.pm * BM + wr * 64 + fr, col0 = u.pn * BM + wc * 32 + 8 * fq;
#pragma unroll
        for (int ai = 0; ai < 2; ++ai)
#pragma unroll
            for (int m = 0; m < 4; ++m) { const int row = row0 + ai * HALF + m * 16; const float rs = 1.0f / sqrtf(RSS[row] * (1.f / 1024.f) + 1e-6f);
#pragma unroll
                for (int bj = 0; bj < 2; ++bj) { const f32x4 v0 = acc[ai][bj][m][0] * rs, v1 = acc[ai][bj][m][1] * rs;
                    u32x4 w; w.x = cvt_pk_bf16(v0[0], v0[1]); w.y = cvt_pk_bf16(v0[2], v0[3]); w.z = cvt_pk_bf16(v1[0], v1[1]); w.w = cvt_pk_bf16(v1[2], v1[3]);
                    *(u32x4*)(O + (size_t)row * ldc + col0 + bj * HALF) = w; } }
    }
};
}

__device__ __forceinline__ void scan_unit(LAS unsigned char* lds, const float* LOGF, float* C2, int bh, int tid) {
    const int b = bh >> 4, h = bh & 15, lane = tid & 63, wave = tid >> 6;
    LAS float* wtot = (LAS float*)lds;
    float v[8]; float run = 0.f;
    { const f32x4 l0 = *(const f32x4*)(LOGF + (size_t)bh * SEQ + 8 * tid), l1 = *(const f32x4*)(LOGF + (size_t)bh * SEQ + 8 * tid + 4);
      const float lv[8] = {l0.x, l0.y, l0.z, l0.w, l1.x, l1.y, l1.z, l1.w};
#pragma unroll
      for (int i = 0; i < 8; ++i) { run += lv[i]; v[i] = run; } }
    float inc = run;
#pragma unroll
    for (int o = 1; o < 64; o <<= 1) { const float t = __shfl_up(inc, o); if (lane >= o) inc += t; }
    if (lane == 63) wtot[wave] = inc;
    __syncthreads();
    float base = inc - run;
    for (int w = 0; w < wave; ++w) base += wtot[w];
    f32x4 o0, o1;
    o0.x = (base + v[0]) * LOG2E; o0.y = (base + v[1]) * LOG2E; o0.z = (base + v[2]) * LOG2E; o0.w = (base + v[3]) * LOG2E;
    o1.x = (base + v[4]) * LOG2E; o1.y = (base + v[5]) * LOG2E; o1.z = (base + v[6]) * LOG2E; o1.w = (base + v[7]) * LOG2E;
    *(f32x4*)(C2 + (size_t)bh * SEQ + 8 * tid) = o0; *(f32x4*)(C2 + (size_t)bh * SEQ + 8 * tid + 4) = o1;
    __syncthreads();
#define LSE2(a_, b_) (fmaxf((a_), (b_)) + __builtin_amdgcn_logf(1.f + __builtin_amdgcn_exp2f(-fabsf((a_) - (b_)))))
    { const float x[8] = {-o0.x, -o0.y, -o0.z, -o0.w, -o1.x, -o1.y, -o1.z, -o1.w}; float l[8]; l[0] = x[0];
#pragma unroll
      for (int i = 1; i < 8; ++i) l[i] = LSE2(l[i - 1], x[i]);
      float tot = l[7], incl = tot;
#pragma unroll
      for (int o = 1; o < 64; o <<= 1) { const float t = __shfl_up(incl, o); if (lane >= o) incl = LSE2(incl, t); }
      if (lane == 63) wtot[wave] = incl;
      __syncthreads();
      float pre = __shfl_up(incl, 1); if (lane == 0) pre = -1.0e30f;
      for (int w = 0; w < wave; ++w) pre = LSE2(pre, wtot[w]);
      f32x4 e0, e1;
      e0.x = -LSE2(pre, l[0]); e0.y = -LSE2(pre, l[1]); e0.z = -LSE2(pre, l[2]); e0.w = -LSE2(pre, l[3]);
      e1.x = -LSE2(pre, l[4]); e1.y = -LSE2(pre, l[5]); e1.z = -LSE2(pre, l[6]); e1.w = -LSE2(pre, l[7]);
      float* C2E = C2 + C2E_DELTA_FLOATS;
      *(f32x4*)(C2E + (size_t)bh * SEQ + 8 * tid) = e0; *(f32x4*)(C2E + (size_t)bh * SEQ + 8 * tid + 4) = e1;
      __syncthreads(); }
#undef LSE2
}
__device__ __forceinline__ void conv_phase(LAS unsigned char* lds, const bf16* GLU, const float* conv_w, const float* conv_b, const float* ln_g, const float* ln_b, bf16* CZ, int vcu, int G, int tid) {
    typedef float f32x2 __attribute__((ext_vector_type(2)));
    LAS float* red = (LAS float*)lds;
    LAS float* fin = (LAS float*)(lds + 65536);
    f32x2 w2[31];
#pragma unroll
    for (int j = 0; j < 31; ++j) w2[j] = *(const f32x2*)(conv_w + j * 1024 + 2 * tid);
    const f32x2 cb = *(const f32x2*)(conv_b + 2 * tid), lg = *(const f32x2*)(ln_g + 2 * tid), lb = *(const f32x2*)(ln_b + 2 * tid);
    const unsigned* Gd = (const unsigned*)GLU; unsigned* Cd = (unsigned*)CZ;
#define CV_BAR() do { asm volatile("s_waitcnt lgkmcnt(0)" ::: "memory"); __builtin_amdgcn_s_barrier(); } while (0)
#define CV_LOADBLK(slot, k) do { _Pragma("unroll") for (int i_ = 0; i_ < 16; ++i_) { int r_ = t0 - 32 + 16 * (k) + i_; r_ = (r_ < M) ? r_ : M - 1; R[slot][i_] = Gd[(size_t)r_ * 512 + tid]; } } while (0)
#define CV_STEP(s4) do { const int s = 4 * half + (s4); \
        CV_LOADBLK(((s4) + 3) & 3, s + 3);                                  \
        float o0[16], o1[16]; \
        _Pragma("unroll") for (int tt = 0; tt < 16; ++tt) { f32x2 a_ = cb; \
            _Pragma("unroll") for (int j = 0; j < 31; ++j) { const int q = tt + j + 2; const unsigned v = R[((s4) + (q >> 4)) & 3][q & 15]; a_ = __builtin_elementwise_fma(w2[j], (f32x2){bf_lo(v), bf_hi(v)}, a_); } \
            const float a0 = a_.x, a1 = a_.y; o0[tt] = a0; o1[tt] = a1; red[tt * 512 + tid] = a0 + a1; red[(16 + tt) * 512 + tid] = a0 * a0 + a1 * a1; } \
        CV_BAR(); \
        { const int tk = tid >> 5, sg = tid & 31; float sm = 0.f, sq = 0.f;        \
          _Pragma("unroll") for (int i = 0; i < 4; ++i) { const f32x4 t = *(const LAS f32x4*)(red + tk * 512 + sg * 4 + 128 * i), u = *(const LAS f32x4*)(red + (16 + tk) * 512 + sg * 4 + 128 * i); \
              sm += (t.x + t.y) + (t.z + t.w); sq += (u.x + u.y) + (u.z + u.w); } \
          _Pragma("unroll") for (int m_ = 1; m_ < 32; m_ <<= 1) { sm += __shfl_xor(sm, m_); sq += __shfl_xor(sq, m_); } \
          if (sg == 0) { const float mean = sm * (1.f / 1024.f), var = sq * (1.f / 1024.f) - mean * mean; fin[tk] = mean; fin[16 + tk] = __builtin_amdgcn_rsqf(fmaxf(var, 0.f) + EPS); } } \
        CV_BAR(); \
        _Pragma("unroll") for (int tt = 0; tt < 16; ++tt) { \
            const float mean = fin[tt], rstd = fin[16 + tt]; \
            const float y0 = (o0[tt] - mean) * rstd * lg.x + lb.x, y1 = (o1[tt] - mean) * rstd * lg.y + lb.y; \
            Cd[(size_t)(t0 + 16 * s + tt) * 512 + tid] = pk2(y0 * sigmoidf_(y0), y1 * sigmoidf_(y1)); } \
          \
    } while (0)
    for (int c = vcu; c < M / 128; c += G) {
        const int t0 = c * 128, sloc = t0 & (SEQ - 1);
        unsigned R[4][16];
        if (sloc == 0) {
#pragma unroll
            for (int i = 0; i < 16; ++i) { R[0][i] = 0u; R[1][i] = 0u; }
        } else { CV_LOADBLK(0, 0); CV_LOADBLK(1, 1); }
        CV_LOADBLK(2, 2);
#pragma unroll 1
        for (int half = 0; half < 2; ++half) { CV_STEP(0); CV_STEP(1); CV_STEP(2); CV_STEP(3); }
    }
#undef CV_BAR
#undef CV_LOADBLK
#undef CV_STEP
}

__device__ __forceinline__ void norm2_phase(const float* X1, const float* g2, bf16* H2, int gw, int NGW, int lane) {
    const GAS f32x4* gp = (const GAS f32x4*)g2 + lane; f32x4 gv[4];
#pragma unroll
    for (int j = 0; j < 4; ++j) gv[j] = gp[64 * j];
    for (int m = gw; m < M; m += NGW) {
        const GAS f32x4* xr = (const GAS f32x4*)(X1 + (size_t)m * D) + lane;
        f32x4 v[4]; float s = 0.f;
#pragma unroll
        for (int j = 0; j < 4; ++j) { v[j] = xr[64 * j]; s += (v[j].x * v[j].x + v[j].y * v[j].y) + (v[j].z * v[j].z + v[j].w * v[j].w); }
        const float rstd = 1.0f / sqrtf(wave_sum(s) * (1.f / D) + EPS);
        GAS unsigned long long* o8 = (GAS unsigned long long*)(H2 + (size_t)m * D) + lane;
#pragma unroll
        for (int j = 0; j < 4; ++j) { const f32x4 t = v[j] * rstd * gv[j]; o8[64 * j] = (unsigned long long)pk2(t.x, t.y) | ((unsigned long long)pk2(t.z, t.w) << 32); }
    }
}

typedef float f32x16 __attribute__((ext_vector_type(16)));
__device__ __forceinline__ unsigned f_ord(float f) { return __float_as_uint(f); }
__device__ __forceinline__ float f_unord(unsigned k) { return __uint_as_float(k); }
constexpr unsigned KEY_MIN = 0xff800000u;
#define CE_DESC(a, b) do { unsigned hi_, lo_; asm("v_max_f32 %0, %2, %3\n\tv_min_f32 %1, %2, %3" : "=&v"(hi_), "=&v"(lo_) : "v"(a), "v"(b)); (a) = hi_; (b) = lo_; } while (0)
#define CE_ASC(a, b)  do { unsigned hi_, lo_; asm("v_max_f32 %0, %2, %3\n\tv_min_f32 %1, %2, %3" : "=&v"(hi_), "=&v"(lo_) : "v"(a), "v"(b)); (a) = lo_; (b) = hi_; } while (0)
__device__ __forceinline__ void sort16_desc(unsigned (&v)[16]) {
#pragma unroll
    for (int k = 2; k <= 16; k <<= 1)
#pragma unroll
        for (int j = k >> 1; j > 0; j >>= 1)
#pragma unroll
            for (int i = 0; i < 16; ++i) { const int l = i ^ j; if (l > i) { if ((i & k) == 0) CE_DESC(v[i], v[l]); else CE_ASC(v[i], v[l]); } }
}
__device__ __forceinline__ void merge16_desc(unsigned (&a)[16], const unsigned (&b)[16]) {
#pragma unroll
    for (int i = 0; i < 16; ++i) { unsigned m_; asm("v_max_f32 %0, %1, %2" : "=v"(m_) : "v"(a[i]), "v"(b[15 - i])); a[i] = m_; }
#pragma unroll
    for (int j = 8; j > 0; j >>= 1)
#pragma unroll
        for (int i = 0; i < 16; ++i) { const int l = i ^ j; if (l > i) CE_DESC(a[i], a[l]); }
}
__device__ __forceinline__ void xchg_merge16(unsigned (&a)[16]) {
    unsigned b[16];
#pragma unroll
    for (int i = 0; i < 16; ++i) { auto rr = __builtin_amdgcn_permlane32_swap(a[i], a[i], false, false); b[i] = (threadIdx.x & 32) ? rr[0] : rr[1]; }
    merge16_desc(a, b);
}
constexpr int RK_OFF = 8192, RK_ROWB = 272, RK_HALFB = 128 * RK_ROWB;
__device__ __forceinline__ void route_unit(LAS unsigned char* tabw, const LAS unsigned char* keys, const bf16* QP, unsigned short* IDX, float* GATE, int tok0, int head, int lane) {
    const int r = lane & 31, hi = lane >> 5;
    unsigned L[2][16];
    bf16x8 bqa[2][8];
#pragma unroll
    for (int half = 0; half < 2; ++half) { const bf16* qrow = QP + (size_t)(tok0 + r) * NQP + head * PDK + half * 128 + 8 * hi;
#pragma unroll
        for (int s = 0; s < 8; ++s) bqa[half][s] = *(const bf16x8*)(qrow + 16 * s); }
#pragma unroll
    for (int half = 0; half < 2; ++half) {
        const LAS unsigned char* kb = keys + half * RK_HALFB + r * RK_ROWB + 16 * hi;
        bf16x8 bq[8];
#pragma unroll
        for (int s = 0; s < 8; ++s) bq[s] = bqa[half][s];
        unsigned R[16];
#pragma unroll
        for (int i = 0; i < 16; ++i) R[i] = KEY_MIN;
#pragma unroll 1
        for (int nb = 0; nb < 4; ++nb) {
            f32x16 acc = f32x16{};
#pragma unroll
            for (int s = 0; s < 8; ++s) { const bf16x8 ak = *(const LAS bf16x8*)(kb + nb * 32 * RK_ROWB + 32 * s); acc = __builtin_amdgcn_mfma_f32_32x32x16_bf16(ak, bq[s], acc, 0, 0, 0); }
            unsigned g[16];
#pragma unroll
            for (int q = 0; q < 16; ++q) { const int n = 32 * nb + (q & 3) + 8 * (q >> 2) + 4 * hi; g[q] = (f_ord(acc[q]) & ~127u) | (unsigned)(127 - n); }
            sort16_desc(g);
            if (nb == 0) {
#pragma unroll
                for (int i = 0; i < 16; ++i) R[i] = g[i];
            } else merge16_desc(R, g);
        }
        xchg_merge16(R);
#pragma unroll
        for (int i = 0; i < 16; ++i) L[half][i] = R[i];
    }
    {
        LAS unsigned* tp = (LAS unsigned*)(tabw + r * 32 + hi * 16);
#pragma unroll
        for (int d = 0; d < 4; ++d) { unsigned w = 0;
#pragma unroll
            for (int b = 0; b < 4; ++b) { const unsigned k1 = L[0][4 * d + b], k2 = L[1][4 * d + b]; const unsigned n = 127u - ((hi ? k2 : k1) & 127u); w |= n << (8 * b); }
            tp[d] = w; }
    }
    float F1[16], F2[16];
#pragma unroll
    for (int i = 0; i < 16; ++i) { F1[i] = f_unord(L[0][i] & ~127u); F2[i] = f_unord(L[1][i] & ~127u); }
    unsigned c0[16], c1[16];
#define CAND(dst, ai, aj, bi, bj) do { const float f1_ = hi ? F1[bi] : F1[ai], f2_ = hi ? F2[bj] : F2[aj]; \
        dst = (f_ord(f1_ + f2_) & ~255u) | (hi ? (unsigned)(255 - ((bi) * 16 + (bj))) : (unsigned)(255 - ((ai) * 16 + (aj)))); } while (0)
    CAND(c0[0], 0, 0, 1, 0);  CAND(c0[1], 0, 1, 1, 1);  CAND(c0[2], 0, 2, 1, 2);  CAND(c0[3], 0, 3, 1, 3);
    CAND(c0[4], 0, 4, 1, 4);  CAND(c0[5], 0, 5, 1, 5);  CAND(c0[6], 0, 6, 1, 6);  CAND(c0[7], 0, 7, 1, 7);
    CAND(c0[8], 0, 8, 2, 0);  CAND(c0[9], 0, 9, 2, 1);  CAND(c0[10], 0, 10, 2, 2); CAND(c0[11], 0, 11, 2, 3);
    CAND(c0[12], 0, 12, 2, 4); CAND(c0[13], 0, 13, 3, 0); CAND(c0[14], 0, 14, 3, 1); CAND(c0[15], 0, 15, 3, 2);
    CAND(c1[0], 8, 0, 3, 3);  CAND(c1[1], 9, 0, 4, 1);  CAND(c1[2], 10, 0, 4, 2); CAND(c1[3], 11, 0, 5, 0);
    CAND(c1[4], 12, 0, 5, 1); CAND(c1[5], 13, 0, 6, 0); CAND(c1[6], 14, 0, 6, 1); CAND(c1[7], 15, 0, 7, 0);
    CAND(c1[8], 4, 0, 7, 1);
#undef CAND
#pragma unroll
    for (int s = 9; s < 16; ++s) c1[s] = KEY_MIN;
    sort16_desc(c0); sort16_desc(c1); merge16_desc(c0, c1); xchg_merge16(c0);
    float sc[16]; float ssum = 0.f;
#pragma unroll
    for (int k = 0; k < 16; ++k) { sc[k] = __builtin_amdgcn_exp2f((f_unord(c0[k] & ~255u) - f_unord(c0[0] & ~255u)) * LOG2E); ssum += sc[k]; }
    const float rs = 1.0f / ssum;
    const LAS unsigned char* tb = (const LAS unsigned char*)(tabw + r * 32);
    unsigned ew[4]; f32x4 g0, g1;
#pragma unroll
    for (int kk = 0; kk < 8; ++kk) {
        unsigned ka_ = c0[kk], kb_ = c0[8 + kk]; float sa_ = sc[kk], sb_ = sc[8 + kk];
        asm volatile("" : "+v"(ka_), "+v"(kb_), "+v"(sa_), "+v"(sb_));
        const unsigned key = hi ? kb_ : ka_; const float gt = (hi ? sb_ : sa_) * rs;
        const unsigned code = 255u - (key & 255u); const unsigned e1 = tb[code >> 4], e2 = tb[16 + (code & 15u)];
        const unsigned e = e1 * 128u + e2;
        if (kk & 1) ew[kk >> 1] |= e << 16; else ew[kk >> 1] = e;
        if (kk < 4) g0[kk] = gt; else g1[kk - 4] = gt;
    }
    const size_t o = (size_t)(tok0 + r) * NSEL + head * PTOPK + 8 * hi;
    *(v4u*)(IDX + o) = (v4u){ew[0], ew[1], ew[2], ew[3]};
    *(f32x4*)(GATE + o) = g0; *(f32x4*)(GATE + o + 4) = g1;
}

__device__ __forceinline__ float gelu_tanh(float x) {
    const float y = 0.7978845608028654f * (x + 0.044715f * x * x * x);
    const float t = 1.f - 2.f * __builtin_amdgcn_rcpf(1.f + __builtin_amdgcn_exp2f(2.f * LOG2E * y));
    return 0.5f * x * (1.f + t);
}
__device__ __forceinline__ float dot8(v4u a, v4u b, float acc) {
#pragma unroll
    for (int i = 0; i < 4; ++i) { acc += bf_lo(a[i]) * bf_lo(b[i]); acc += bf_hi(a[i]) * bf_hi(b[i]); }
    return acc;
}
typedef float f32x2 __attribute__((ext_vector_type(2)));
template <int MODE = 0> __device__ __forceinline__ void peer_phase(LAS unsigned char* wl, const bf16* H2, const unsigned char* Uq, const unsigned char* Vq, const unsigned short* IDX, const float* GATE, const float* RSS, const float* g2, float* XO, const float* gf, int gw, int NGW, int lane, unsigned emask = 0xffffu, unsigned eor = 0u, float* ACTg = nullptr) {
    LAS unsigned* lid = (LAS unsigned*)wl; LAS float* la = (LAS float*)(wl + 512);
    float g2v[16];
#pragma unroll
    for (int i = 0; i < 16; ++i) g2v[i] = g2[16 * lane + i];
    for (int tok = gw; tok < M; tok += NGW) {
        const float rs_u = (1.f / U_SCALE) / sqrtf(RSS[tok] * (1.f / D) + EPS);
        float h[16], x1v[16];
        { const v4u hA = *(const v4u*)(H2 + (size_t)tok * D + 16 * lane), hB = *(const v4u*)(H2 + (size_t)tok * D + 16 * lane + 8);
#pragma unroll
          for (int i = 0; i < 4; ++i) { x1v[2 * i] = bf_lo(hA[i]); x1v[2 * i + 1] = bf_hi(hA[i]); x1v[8 + 2 * i] = bf_lo(hB[i]); x1v[8 + 2 * i + 1] = bf_hi(hB[i]); }
#pragma unroll
          for (int i = 0; i < 16; ++i) h[i] = x1v[i] * g2v[i]; }
        lid[lane] = (IDX[(size_t)tok * NSEL + lane] & emask) | eor; lid[64 + lane] = (IDX[(size_t)tok * NSEL + 64 + lane] & emask) | eor;
#pragma unroll 1
        for (int b = 0; b < ((MODE == 1 || MODE == 4) ? 0 : 8); ++b) {
            const float gate = GATE[(size_t)tok * NSEL + 16 * b + ((lane >> 2) & 15)];
            float p[16];
#pragma unroll
            for (int e = 0; e < 16; ++e) {
                const unsigned eid = (unsigned)__builtin_amdgcn_readfirstlane((int)lid[16 * b + e]);
                const v4u w = *(const v4u*)(Uq + (size_t)eid * D + 16 * lane);
                float s = 0.f;
#pragma unroll
                for (int j = 0; j < 4; ++j) { const f32x2 lo = __builtin_amdgcn_cvt_pk_f32_fp8((int)w[j], false), hi2 = __builtin_amdgcn_cvt_pk_f32_fp8((int)w[j], true);
                    s += lo.x * h[4 * j] + lo.y * h[4 * j + 1] + hi2.x * h[4 * j + 2] + hi2.y * h[4 * j + 3]; }
                p[e] = s;
            }
#pragma unroll
            for (int st = 0; st < 4; ++st) { const int msk = 32 >> st, n = 8 >> st; const bool up = (lane & msk) != 0;
#pragma unroll
                for (int i = 0; i < n; ++i) { const float mine = up ? p[i + n] : p[i], theirs = up ? p[i] : p[i + n]; p[i] = mine + __shfl_xor(theirs, msk); } }
            float d = p[0]; d += __shfl_xor(d, 1); d += __shfl_xor(d, 2);
            if ((lane & 3) == 0) la[16 * b + ((lane >> 2) & 15)] = gelu_tanh(d * rs_u) * gate * (1.f / V_SCALE);
        }
        if (MODE == 3) { ACTg[(size_t)tok * NSEL + lane] = la[lane]; ACTg[(size_t)tok * NSEL + 64 + lane] = la[64 + lane]; continue; }
        if (MODE == 4) { la[lane] = ACTg[(size_t)tok * NSEL + lane]; la[64 + lane] = ACTg[(size_t)tok * NSEL + 64 + lane]; }
        float o[16];
#pragma unroll
        for (int i = 0; i < 16; ++i) o[i] = 0.f;
#pragma unroll 1
        for (int b = 0; b < (MODE == 2 ? 0 : 16); ++b) {
#pragma unroll
            for (int e = 0; e < 8; ++e) {
                const unsigned eid = (unsigned)__builtin_amdgcn_readfirstlane((int)lid[8 * b + e]);
                const float a = la[8 * b + e];
                const v4u w = *(const v4u*)(Vq + (size_t)eid * D + 16 * lane);
#pragma unroll
                for (int j = 0; j < 4; ++j) { const f32x2 lo = __builtin_amdgcn_cvt_pk_f32_fp8((int)w[j], false), hi2 = __builtin_amdgcn_cvt_pk_f32_fp8((int)w[j], true);
                    o[4 * j] += a * lo.x; o[4 * j + 1] += a * lo.y; o[4 * j + 2] += a * hi2.x; o[4 * j + 3] += a * hi2.y; }
            }
        }
        float* xr = XO + (size_t)tok * D + 16 * lane; const float* gp = gf + 16 * lane;
        f32x4 xv[4]; float s = 0.f;
#pragma unroll
        for (int j = 0; j < 4; ++j) { xv[j] = (f32x4){x1v[4 * j], x1v[4 * j + 1], x1v[4 * j + 2], x1v[4 * j + 3]} + (f32x4){o[4 * j], o[4 * j + 1], o[4 * j + 2], o[4 * j + 3]}; s += (xv[j].x * xv[j].x + xv[j].y * xv[j].y) + (xv[j].z * xv[j].z + xv[j].w * xv[j].w); }
        const float rstd = 1.0f / sqrtf(wave_sum(s) * (1.f / D) + EPS);
#pragma unroll
        for (int j = 0; j < 4; ++j) *(f32x4*)(xr + 4 * j) = xv[j] * rstd * *(const f32x4*)(gp + 4 * j);
    }
}

template <int UVAR = 0> __device__ __forceinline__ void peer_u_phase(const unsigned char* Uq, const bf16* X1b, const float* g2, const unsigned short* IDX, bf16* PART, LAS unsigned char* wl, LAS unsigned char* obuf, int x, int wrank, int nwv, int lane) {
    const int ip = lane >> 3, jd = lane & 7;
    const unsigned char* usl = Uq + (size_t)x * ((size_t)NEXP * 128); const unsigned voff0 = 16u * (unsigned)jd;
    const int tpw = (M + nwv - 1) / nwv, tbeg = wrank * tpw, tend = (tbeg + tpw < M) ? tbeg + tpw : M;
    if (tbeg >= tend || (UVAR & 8)) return;
    LAS float* ob = (LAS float*)obuf;
    (void)g2;
#define PU_STAGE(t0) do { const int t0_ = (t0); v4u si_[4], sx_[4]; \
        _Pragma("unroll") for (int j_ = 0; j_ < 4; ++j_) { si_[j_] = *(const v4u*)((const unsigned char*)IDX + (size_t)t0_ * 256 + 1024 * j_ + 16 * lane); \
            const int ta_ = (t0_ + 4 * j_ + (lane >> 4) < M) ? t0_ + 4 * j_ + (lane >> 4) : M - 1; sx_[j_] = *(const v4u*)(X1b + (size_t)ta_ * D + 128 * x + 8 * (lane & 15)); } \
        _Pragma("unroll") for (int j_ = 0; j_ < 4; ++j_) { *(LAS v4u*)(wl + 1024 * j_ + 16 * lane) = si_[j_]; \
              \
            float hf_[8]; _Pragma("unroll") for (int i_ = 0; i_ < 4; ++i_) { hf_[2 * i_] = bf_lo(sx_[j_][i_]); hf_[2 * i_ + 1] = bf_hi(sx_[j_][i_]); } \
            float am_ = fmaxf(fmaxf(fmaxf(fabsf(hf_[0]), fabsf(hf_[1])), fmaxf(fabsf(hf_[2]), fabsf(hf_[3]))), fmaxf(fmaxf(fabsf(hf_[4]), fabsf(hf_[5])), fmaxf(fabsf(hf_[6]), fabsf(hf_[7])))); \
            _Pragma("unroll") for (int m_ = 1; m_ < 16; m_ <<= 1) am_ = fmaxf(am_, __shfl_xor(am_, m_)); \
            am_ = fmaxf(am_, 1e-20f); const float qs_ = 127.f / am_; \
            int q_[8]; _Pragma("unroll") for (int i_ = 0; i_ < 8; ++i_) q_[i_] = (int)__builtin_rintf(hf_[i_] * qs_); \
            const unsigned w0_ = (unsigned)((q_[0] & 0xff) | ((q_[1] & 0xff) << 8) | ((q_[2] & 0xff) << 16) | (q_[3] << 24)), w1_ = (unsigned)((q_[4] & 0xff) | ((q_[5] & 0xff) << 8) | ((q_[6] & 0xff) << 16) | (q_[7] << 24)); \
            *(LAS u32x2*)(wl + 4096 + (4 * j_ + (lane >> 4)) * 128 + 8 * (lane & 15)) = (u32x2){w0_, w1_}; \
            *(LAS float*)(wl + 6144 + 4 * (4 * j_ + (lane >> 4))) = am_ * (1.f / 127.f); } } while (0)
#define PU_EID(i0, i1, ld) (((ld) < 8) ? (((ld) & 1) ? (i0[((ld) & 7) >> 1] >> 16) : (i0[((ld) & 7) >> 1] & 0xffffu)) : (((ld) & 1) ? (i1[((ld) & 7) >> 1] >> 16) : (i1[((ld) & 7) >> 1] & 0xffffu)))
#define PU_ROWS(sl, wv) do { const v4u i0_ = *(const LAS v4u*)(wl + (sl) * 256 + 32 * ip), i1_ = *(const LAS v4u*)(wl + (sl) * 256 + 32 * ip + 16); \
        _Pragma("unroll") for (int ld = 0; ld < 16; ++ld) wv[ld] = *(const v4u*)(usl + (PU_EID(i0_, i1_, ld) * 128u + voff0)); \
        __builtin_amdgcn_sched_barrier(0); } while (0)
#define PU_COMPUTE(wv, sl) do { \
        const v4u hq_ = *(const LAS v4u*)(wl + 4096 + (sl) * 128 + 16 * jd); const float hs_ = *(const LAS float*)(wl + 6144 + 4 * (sl)); \
        int p[16]; \
        _Pragma("unroll") for (int ld = 0; ld < 16; ++ld) { const v4u w = wv[ld]; int a_ = 0; \
            _Pragma("unroll") for (int j = 0; j < 4; ++j) a_ = __builtin_amdgcn_sdot4((int)w[j], (int)hq_[j], a_, false); \
            p[ld] = a_; } \
          \
        _Pragma("unroll") for (int st = 0; st < 3; ++st) { const int msk = 4 >> st, n = 8 >> st; const bool up = (lane & msk) != 0; \
            _Pragma("unroll") for (int j = 0; j < n; ++j) { int a_ = p[j], b_ = p[j + n]; asm volatile("" : "+v"(a_), "+v"(b_)); const int mine = up ? b_ : a_, theirs = up ? a_ : b_; p[j] = mine + __shfl_xor(theirs, msk); } } \
        *(LAS f32x2*)(ob + (sl) * 128 + 16 * ip + 8 * ((jd >> 2) & 1) + 4 * ((jd >> 1) & 1) + 2 * (jd & 1)) = (f32x2){(float)p[0] * hs_, (float)p[1] * hs_}; \
        __builtin_amdgcn_sched_barrier(0); \
    } while (0)
    for (int t0 = tbeg; t0 < tend; t0 += 16) {
        const int nb = (tend - t0 < 16) ? tend - t0 : 16;
        PU_STAGE(t0);
        v4u wA[16], wB[16];
        PU_ROWS(0, wA);
        if (nb == 16) {
#pragma unroll
            for (int s = 0; s < 16; s += 2) {
                PU_ROWS(s + 1, wB);
                PU_COMPUTE(wA, s);
                if (s + 2 < 16) PU_ROWS(s + 2, wA);
                PU_COMPUTE(wB, s + 1);
            }
        } else {
#pragma unroll 1
            for (int s = 0; s < nb; ++s) { PU_ROWS(s, wA); PU_COMPUTE(wA, s); }
        }
        { bf16* dst_ = PART + ((size_t)x * M + t0) * NSEL; const int n8_ = nb * 16;
#pragma unroll
          for (int j = 0; j < 4; ++j) { const int c_ = j * 64 + lane; if (c_ < n8_) { const f32x4 a_ = *(const LAS f32x4*)(ob + 8 * c_), b_ = *(const LAS f32x4*)(ob + 8 * c_ + 4);
              *(v4u*)(dst_ + 8 * c_) = (v4u){pk2(a_.x, a_.y), pk2(a_.z, a_.w), pk2(b_.x, b_.y), pk2(b_.z, b_.w)}; } } }
    }
#undef PU_STAGE
#undef PU_EID
#undef PU_ROWS
#undef PU_COMPUTE
}
__device__ __forceinline__ void peer_c_phase(const bf16* PART, const float* GATE, const float* RSS, bf16* ACT, int gtid, int ngt) {
    constexpr int NIT = M * (NSEL / 8);
    for (int it0 = gtid; it0 < NIT; it0 += 4 * ngt) {
        v4u pv[4][8]; f32x4 g0[4], g1[4]; float rss[4];
#pragma unroll
        for (int u = 0; u < 4; ++u) { const int it = (it0 + u * ngt < NIT) ? it0 + u * ngt : it0, tok = it >> 4, k8 = (it & 15) * 8;
#pragma unroll
            for (int xx = 0; xx < 8; ++xx) pv[u][xx] = *(const v4u*)(PART + ((size_t)xx * M + tok) * NSEL + k8);
            g0[u] = *(const f32x4*)(GATE + (size_t)tok * NSEL + k8); g1[u] = *(const f32x4*)(GATE + (size_t)tok * NSEL + k8 + 4); rss[u] = RSS[tok]; }
#pragma unroll
        for (int u = 0; u < 4; ++u) { const int it = (it0 + u * ngt < NIT) ? it0 + u * ngt : it0, tok = it >> 4, k8 = (it & 15) * 8;
            const float rs = (1.f / U_SCALE) / sqrtf(rss[u] * (1.f / D) + EPS);
            float s[8];
#pragma unroll
            for (int i = 0; i < 8; ++i) s[i] = 0.f;
#pragma unroll
            for (int xx = 0; xx < 8; ++xx)
#pragma unroll
                for (int i = 0; i < 4; ++i) { s[2 * i] += bf_lo(pv[u][xx][i]); s[2 * i + 1] += bf_hi(pv[u][xx][i]); }
            float o[8];
#pragma unroll
            for (int i = 0; i < 4; ++i) { o[i] = fminf(gelu_tanh(s[i] * rs) * g0[u][i] * A_SCALE, 440.f); o[4 + i] = fminf(gelu_tanh(s[4 + i] * rs) * g1[u][i] * A_SCALE, 440.f); }
            int w0 = __builtin_amdgcn_cvt_pk_fp8_f32(o[0], o[1], 0, false); w0 = __builtin_amdgcn_cvt_pk_fp8_f32(o[2], o[3], w0, true);
            int w1 = __builtin_amdgcn_cvt_pk_fp8_f32(o[4], o[5], 0, false); w1 = __builtin_amdgcn_cvt_pk_fp8_f32(o[6], o[7], w1, true);
            *(u32x2*)((unsigned char*)ACT + (size_t)tok * NSEL + k8) = (u32x2){(unsigned)w0, (unsigned)w1}; }
    }
}
__device__ __forceinline__ void peer_v_phase(const unsigned char* Vq, const unsigned short* IDX, const bf16* ACT, bf16* PO, LAS unsigned char* wl, LAS unsigned char* obuf, int x, int wrank, int nwv, int lane) {
    const int ip = lane >> 3, jd = lane & 7;
    const unsigned char* vsl = Vq + (size_t)x * ((size_t)NEXP * 128); const unsigned voff0 = 16u * (unsigned)jd;
    const int tpw = (M + nwv - 1) / nwv, tbeg = wrank * tpw, tend = (tbeg + tpw < M) ? tbeg + tpw : M;
    if (tbeg >= tend) return;
    LAS float* ob = (LAS float*)obuf;
#define PV_STAGE(t0) do { const int t0_ = (t0); \
        const v4u s0_ = *(const v4u*)((const unsigned char*)IDX + (size_t)t0_ * 256 + 16 * lane), s1_ = *(const v4u*)((const unsigned char*)IDX + (size_t)t0_ * 256 + 1024 + 16 * lane); \
        const v4u s2a_ = *(const v4u*)((const unsigned char*)IDX + (size_t)t0_ * 256 + 2048 + 16 * lane), s3a_ = *(const v4u*)((const unsigned char*)IDX + (size_t)t0_ * 256 + 3072 + 16 * lane); \
        const v4u a0_ = *(const v4u*)((const unsigned char*)ACT + (size_t)t0_ * 128 + 16 * lane), a1_ = *(const v4u*)((const unsigned char*)ACT + (size_t)t0_ * 128 + 1024 + 16 * lane); \
        *(LAS v4u*)(wl + 16 * lane) = s0_; *(LAS v4u*)(wl + 1024 + 16 * lane) = s1_; *(LAS v4u*)(wl + 2048 + 16 * lane) = s2a_; *(LAS v4u*)(wl + 3072 + 16 * lane) = s3a_; \
        *(LAS v4u*)(wl + 4096 + 16 * lane) = a0_; *(LAS v4u*)(wl + 5120 + 16 * lane) = a1_; } while (0)
#define PV_EID(i0, i1, ld) (((ld) < 8) ? (((ld) & 1) ? (i0[((ld) & 7) >> 1] >> 16) : (i0[((ld) & 7) >> 1] & 0xffffu)) : (((ld) & 1) ? (i1[((ld) & 7) >> 1] >> 16) : (i1[((ld) & 7) >> 1] & 0xffffu)))
#define PV_ROWS(sl, wv) do { const v4u i0_ = *(const LAS v4u*)(wl + (sl) * 256 + 32 * ip), i1_ = *(const LAS v4u*)(wl + (sl) * 256 + 32 * ip + 16); \
        _Pragma("unroll") for (int ld = 0; ld < 16; ++ld) wv[ld] = *(const v4u*)(vsl + (PV_EID(i0_, i1_, ld) * 128u + voff0)); \
        __builtin_amdgcn_sched_barrier(0); } while (0)
#define PV_COMPUTE(wv, sl) do { \
          \
        const v4u ab_ = *(const LAS v4u*)(wl + 4096 + (sl) * 128 + 16 * ip); \
        f32x4 c1_ = (f32x4){0.f, 0.f, 0.f, 0.f}, c2_ = (f32x4){0.f, 0.f, 0.f, 0.f}; \
        _Pragma("unroll") for (int ld = 0; ld < 16; ++ld) { const unsigned sft_ = ((ab_[ld >> 2] >> (8 * (ld & 3))) & 0xffu) << sh8; \
            const unsigned alo_ = jhi ? 0u : sft_, ahi_ = jhi ? sft_ : 0u; \
            const long A_ = (long)(((unsigned long long)ahi_ << 32) | alo_); const v4u w = wv[ld]; \
            c1_ = __builtin_amdgcn_mfma_f32_16x16x32_fp8_fp8(A_, (long)(((unsigned long long)w.y << 32) | w.x), c1_, 0, 0, 0); \
            c2_ = __builtin_amdgcn_mfma_f32_16x16x32_fp8_fp8(A_, (long)(((unsigned long long)w.w << 32) | w.z), c2_, 0, 0, 0); } \
        float r_[8] = {c1_[0], c1_[1], c1_[2], c1_[3], c2_[0], c2_[1], c2_[2], c2_[3]}; \
        _Pragma("unroll") for (int i = 0; i < 8; ++i) r_[i] = (r_[i] + __shfl(r_[i], plane)) * (1.f / (A_SCALE * V_SCALE)); \
        { LAS unsigned char* op_ = obase + (sl) * ostride; *(LAS f32x4*)op_ = (f32x4){r_[0], r_[1], r_[2], r_[3]}; *(LAS f32x4*)(op_ + 32) = (f32x4){r_[4], r_[5], r_[6], r_[7]}; } \
        __builtin_amdgcn_sched_barrier(0); \
    } while (0)
    const unsigned sh8 = 8u * (unsigned)(jd & 3); const bool jhi = (jd & 4) != 0; const int plane = (lane + 40) & 63;
    const bool ovalid = ((lane & 15) < 8) && (lane < 32);
    LAS unsigned char* obase = ovalid ? obuf + 4 * (16 * (lane & 15) + 4 * (lane >> 4)) : wl + 6144 + 16 * lane; const int ostride = ovalid ? 512 : 0;
    for (int t0 = tbeg; t0 < tend; t0 += 16) {
        const int nb = (tend - t0 < 16) ? tend - t0 : 16;
        PV_STAGE(t0);
        v4u wA[16], wB[16];
        PV_ROWS(0, wA);
        if (nb == 16) {
#pragma unroll
            for (int s = 0; s < 16; s += 2) {
                PV_ROWS(s + 1, wB);
                PV_COMPUTE(wA, s);
                if (s + 2 < 16) PV_ROWS(s + 2, wA);
                PV_COMPUTE(wB, s + 1);
            }
        } else {
#pragma unroll 1
            for (int s = 0; s < nb; ++s) { PV_ROWS(s, wA); PV_COMPUTE(wA, s); }
        }
        { bf16* dst_ = PO + ((size_t)x * M + t0) * 128; const int n8_ = nb * 16;
#pragma unroll
          for (int j = 0; j < 4; ++j) { const int c_ = j * 64 + lane; if (c_ < n8_) { const f32x4 a_ = *(const LAS f32x4*)(ob + 8 * c_), b_ = *(const LAS f32x4*)(ob + 8 * c_ + 4);
              *(v4u*)(dst_ + 8 * c_) = (v4u){pk2(a_.x, a_.y), pk2(a_.z, a_.w), pk2(b_.x, b_.y), pk2(b_.z, b_.w)}; } } }
    }
#undef PV_STAGE
#undef PV_EID
#undef PV_ROWS
#undef PV_COMPUTE
}
__device__ __forceinline__ void peer_f_phase(const bf16* X1b, const bf16* PO, float* XO, const float* gf, int gw, int NGW, int lane) {
    const GAS f32x4* gp = (const GAS f32x4*)gf + lane; f32x4 gv[4];
#pragma unroll
    for (int j = 0; j < 4; ++j) gv[j] = gp[64 * j];
    for (int m0 = gw * 4; m0 < M; m0 += NGW * 4) {
        u32x2 xb[4][4], pb[4][4];
#pragma unroll
        for (int rr = 0; rr < 4; ++rr)
#pragma unroll
            for (int j = 0; j < 4; ++j) { const int dd = 4 * lane + 256 * j; const int m = m0 + rr; xb[rr][j] = *(const u32x2*)(X1b + (size_t)m * D + dd);
                pb[rr][j] = *(const u32x2*)(PO + ((size_t)(dd >> 7) * M + m) * 128 + (dd & 127)); }
#pragma unroll
        for (int rr = 0; rr < 4; ++rr) { const int m = m0 + rr;
            GAS f32x4* xr = (GAS f32x4*)(XO + (size_t)m * D) + lane;
            f32x4 v[4]; float s = 0.f;
#pragma unroll
            for (int j = 0; j < 4; ++j) {
                v[j] = (f32x4){bf_lo(xb[rr][j].x), bf_hi(xb[rr][j].x), bf_lo(xb[rr][j].y), bf_hi(xb[rr][j].y)} + (f32x4){bf_lo(pb[rr][j].x), bf_hi(pb[rr][j].x), bf_lo(pb[rr][j].y), bf_hi(pb[rr][j].y)};
                s += (v[j].x * v[j].x + v[j].y * v[j].y) + (v[j].z * v[j].z + v[j].w * v[j].w); }
            const float rstd = 1.0f / sqrtf(wave_sum(s) * (1.f / D) + EPS);
#pragma unroll
            for (int j = 0; j < 4; ++j) xr[64 * j] = v[j] * rstd * gv[j]; }
    }
}

#ifndef PEER_SPLIT
#define PEER_SPLIT 0
#endif
constexpr int N_PHASES = PEER_SLICED ? 12 : (PEER_SPLIT ? 10 : 9);
#ifndef MK_FUSED
#define MK_FUSED 1
#endif
struct Args { const float* in[18]; float* out; unsigned char* ws; int ph_lo, ph_hi; };
__global__ void __launch_bounds__(NWAVES * 64, 2) hyb_fwd(Args args) {
    extern __shared__ __attribute__((aligned(16))) unsigned char lds[];
    LAS unsigned char* L = (LAS unsigned char*)lds;
    volatile LAS unsigned* MISC = (volatile LAS unsigned*)(L + MISC_OFF);
    const int tid = threadIdx.x, lane = tid & 63, wave = __builtin_amdgcn_readfirstlane(tid >> 6);
    const int G = gridDim.x; const int bx = blockIdx.x; const int vcu = (G % 8 == 0) ? (bx % 8) * (G / 8) + bx / 8 : bx;
    const int gw = vcu * NWAVES + wave, NGW = G * NWAVES;
    unsigned char* ws = args.ws;
    gu32* ctl = (gu32*)(ws + WS_CTL);
    const float* x = args.in[0]; float* out = args.out;
    bf16 *WIN = (bf16*)(ws + WS_WIN), *WC = (bf16*)(ws + WS_WC), *WF = (bf16*)(ws + WS_WF), *WO = (bf16*)(ws + WS_WO), *WQ = (bf16*)(ws + WS_WQ);
    bf16 *K1b = (bf16*)(ws + WS_K1), *K2b = (bf16*)(ws + WS_K2); unsigned char *Uq = ws + WS_U, *Vq = ws + WS_VT;
    bf16 *XN = (bf16*)(ws + WS_XN), *CZ = XN, *GLU = (bf16*)(ws + WS_GLU), *MM = GLU, *QO = (bf16*)(ws + WS_QO), *KB = (bf16*)(ws + WS_K), *H2 = KB, *VB = (bf16*)(ws + WS_V);
    bf16 *QP = (bf16*)(ws + WS_QP), *GA = (bf16*)out, *GB = (bf16*)out + (size_t)M * D;
    float *LOGF = (float*)(ws + WS_LOGF), *C2 = (float*)(ws + WS_C2), *GATE = (float*)(ws + WS_GATE);
    unsigned short* IDX = (unsigned short*)(ws + WS_IDX);
    for (int u = tid; u < (LDS_BYTES - LDSCTL_OFF) / 4; u += NWAVES * 64) ((LAS unsigned*)(L + LDSCTL_OFF))[u] = 0u;
    __syncthreads();
#if MK_FUSED
    XcdBarrier bar = xcd_barrier_post((unsigned*)(ctl + CW_BAR), MISC + 8);
#define GRID_BAR() xcd_barrier(bar)
#else
#define GRID_BAR() do {} while (0)
    (void)MISC; (void)ctl;
#endif
    const int lo = args.ph_lo, hi = args.ph_hi;
#ifdef ONLY_PHASE
#define IN(k) ((k) == ONLY_PHASE)
#else
#define IN(k) (lo <= (k) && (k) < hi)
#endif
#define BOTH(k) (IN(k) && IN((k) + 1))
#ifdef REP_PHASE
#define REPS(k) for (int rep_ = ((k) == REP_PHASE) ? 0 : 1; rep_ < 2; ++rep_)
#define REP_BAR() do { if (rep_ == 0) GRID_BAR(); } while (0)
#else
#define REPS(k)
#define REP_BAR() do {} while (0)
constexpr int rep_ = 1;
#endif
#ifndef P0_PARTS
#define P0_PARTS 15
#endif
#ifndef TABLES_IN_GEMM1
#define TABLES_IN_GEMM1 1
#endif
#ifndef REP_EMASK
#define REP_EMASK 0xffffu
#define REP_ESTRIDE 0u
#endif

    if (IN(0)) REPS(0) {
        P0Args a{args.in[11], x, args.in[1], args.in[2], args.in[7], args.in[9], args.in[10], args.in[12], args.in[13], args.in[14], args.in[15], args.in[16], args.in[8],
                 WIN, WC, WF, WO, WQ, K1b, K2b, Uq, Vq, XN, LOGF};
        p0_prologue(L, a, vcu, G, tid, rep_ ? (TABLES_IN_GEMM1 ? 7 : 15) : P0_PARTS); REP_BAR();
        if (rep_ && BOTH(0)) GRID_BAR();
    }
    if (IN(1)) REPS(1) {
        pg8::Gemm g{XN, XN, WIN, WIN, M, N1, D}; pg8::StaticOrder S; S.init(M, N1, G, bx);
        pg8::EpiP1 E{GLU, QO, KB, VB, GA, GB, attn_body::C2, (unsigned*)(ctl + CW_STAT)};
#if TABLES_IN_GEMM1
        TableOrder TS{S, P0Args{args.in[11], x, args.in[1], args.in[2], args.in[7], args.in[9], args.in[10], args.in[12], args.in[13], args.in[14], args.in[15], args.in[16], args.in[8],
                                WIN, WC, WF, WO, WQ, K1b, K2b, Uq, Vq, XN, LOGF}, vcu * NWAVES + wave, G * NWAVES, lane, (vcu >> 3) % 3};
        pg8::gemm_phase<pg8::EpiP1, TableOrder, true, true>(L + RING_OFF, g, TS, E); REP_BAR();
        __syncthreads();
        for (int bh = vcu; bh < BATCH * NHEADS; bh += G) scan_unit(L, LOGF, C2, bh, tid);
#else
        pg8::gemm_phase<pg8::EpiP1, pg8::StaticOrder, true, true>(L + RING_OFF, g, S, E); REP_BAR();
#endif
        if (rep_ && BOTH(1)) GRID_BAR();
    }
    if (IN(2)) REPS(2) {
#if !TABLES_IN_GEMM1
        for (int bh = vcu; bh < BATCH * NHEADS; bh += G) scan_unit(L, LOGF, C2, bh, tid);
#endif
        conv_phase(L, GLU, args.in[3], args.in[4], args.in[5], args.in[6], CZ, vcu, G, tid); REP_BAR();
#if TABLES_IN_GEMM1 && MK_FUSED
        if (rep_ && BOTH(2)) __syncthreads();
#else
        if (rep_ && BOTH(2)) GRID_BAR();
#endif
    }
    if (IN(3)) REPS(3) {
        const attn_body::AttnTensors AT{(const attn_body::bf16*)QO, (const attn_body::bf16*)KB, (const attn_body::bf16*)VB, (attn_body::bf16*)(rep_ ? QO : GLU), C2};
#if MK_FUSED
        attn_body::attn_phase_queue<8>((char*)lds + RING_OFF, AT, (unsigned*)(ctl + CW_ATTQ) + (rep_ ? 0 : 64), (const float*)(ctl + CW_STAT), LDSCTL_OFF + 64); REP_BAR();
#else
        const attn_body::StaticOrder S(G, bx);
        attn_body::attn_phase<attn_body::StaticOrder>((char*)lds + RING_OFF, AT, S); REP_BAR();
#endif
        if (rep_ && BOTH(3)) GRID_BAR();
    }
    if (IN(4)) REPS(4) {
        pg8::Gemm g{CZ, QO, WC, WF, M, D, D}; pg8::DualOrder S; S.init(M, D, G, bx);
        pg8::EpiDual E{GA, GB, MM};
        pg8::gemm_phase<pg8::EpiDual, pg8::DualOrder, true, true>(L + RING_OFF, g, S, E); REP_BAR();
        if (rep_ && BOTH(4)) GRID_BAR();
    }
    if (IN(5)) REPS(5) {
        pg8::Gemm g{MM, MM, WO, WO, M, D, D}; pg8::StaticOrder S; S.init(M, D, G, bx);
        pg8::EpiResNorm E{x, H2, (float*)(ctl + CW_RSS), args.in[11], nullptr, nullptr};
        pg8::gemm_phase<pg8::EpiResNorm, pg8::StaticOrder, true, true>(L + RING_OFF, g, S, E); REP_BAR();
        if (rep_ && BOTH(5)) GRID_BAR();
    }
    if (IN(6)) REPS(6) {
        pg8::Gemm g{H2, H2, WQ, WQ, M, NQP, D}; pg8::StaticOrder S; S.init(M, NQP, G, bx);
        pg8::EpiScaleRow E{QP, NQP, (const float*)(ctl + CW_RSS)};
        pg8::gemm_phase<pg8::EpiScaleRow, pg8::StaticOrder, true, true>(L + RING_OFF, g, S, E); REP_BAR();
        if (rep_ && BOTH(6)) GRID_BAR();
    }
    if (IN(7)) REPS(7) {
        const int head = bx & 7, nwg_h = (G - head + 7) >> 3;
        for (int ci = tid; ci < 4096; ci += NWAVES * 64) { const int half = ci >> 11, row = (ci >> 4) & 127, c16 = ci & 15;
            *(LAS v4u*)(L + RK_OFF + half * RK_HALFB + row * RK_ROWB + c16 * 16) = *(const v4u*)((half ? K2b : K1b) + (size_t)(head * PNK + row) * 128 + c16 * 8); }
        __syncthreads();
        for (int tg = (bx >> 3) * NWAVES + wave; tg < M / 32; tg += nwg_h * NWAVES) route_unit(L + wave * 1024, L + RK_OFF, QP, IDX, GATE, tg * 32, head, lane);
        __syncthreads(); REP_BAR();
        if (rep_ && BOTH(7)) GRID_BAR();
    }
#if PEER_SLICED
    {
        const int xs = bx & 7, nwg_x = (G - xs + 7) >> 3, wrank = (bx >> 3) * NWAVES + wave, nwv = nwg_x * NWAVES;
        bf16 *PART = (bf16*)(ws + WS_PART), *PO = (bf16*)(ws + WS_PART), *ACT = (bf16*)(ws + WS_ACT);
        if (IN(8)) REPS(8) {
#ifdef PROBE_UVAR
            if (!rep_) { peer_u_phase<PROBE_UVAR>(Uq, H2, args.in[11], IDX, PART, L + wave * 8192, L + 65536 + wave * 8192, xs, wrank, nwv, lane); REP_BAR(); continue; }
#endif
            peer_u_phase(Uq, H2, args.in[11], IDX, PART, L + wave * 8192, L + 65536 + wave * 8192, xs, wrank, nwv, lane); REP_BAR(); if (rep_ && BOTH(8)) GRID_BAR(); }
        if (IN(9)) REPS(9) { peer_c_phase(PART, GATE, (const float*)(ctl + CW_RSS), ACT, gw * 64 + lane, NGW * 64); REP_BAR(); if (rep_ && BOTH(9)) GRID_BAR(); }
        if (IN(10)) REPS(10) { peer_v_phase(Vq, IDX, ACT, PO, L + wave * 8192, L + 65536 + wave * 8192, xs, wrank, nwv, lane); REP_BAR(); if (rep_ && BOTH(10)) GRID_BAR(); }
        if (IN(11)) REPS(11) { peer_f_phase(H2, PO, out, args.in[17], gw, NGW, lane); REP_BAR(); }
    }
#elif PEER_SPLIT
    if (IN(8)) { peer_phase<3>(L + wave * 1024, H2, Uq, Vq, IDX, GATE, (const float*)(ctl + CW_RSS), args.in[11], out, args.in[17], gw, NGW, lane, 0xffffu, 0u, (float*)(ws + WS_ACT)); if (BOTH(8)) GRID_BAR(); }
    if (IN(9)) peer_phase<4>(L + wave * 1024, H2, Uq, Vq, IDX, GATE, (const float*)(ctl + CW_RSS), args.in[11], out, args.in[17], gw, NGW, lane, 0xffffu, 0u, (float*)(ws + WS_ACT));
#else
    if (IN(8)) REPS(8) {
#ifdef PROBE_MODE
        if (!rep_) { peer_phase<PROBE_MODE>(L + wave * 1024, H2, Uq, Vq, IDX, GATE, (const float*)(ctl + CW_RSS), args.in[11], (float*)QP, args.in[17], gw, NGW, lane, REP_EMASK, (unsigned)(bx & 7) * REP_ESTRIDE); REP_BAR(); continue; }
#endif
        peer_phase(L + wave * 1024, H2, Uq, Vq, IDX, GATE, (const float*)(ctl + CW_RSS), args.in[11], rep_ ? out : (float*)QP, args.in[17], gw, NGW, lane, rep_ ? 0xffffu : REP_EMASK, rep_ ? 0u : (unsigned)(bx & 7) * REP_ESTRIDE); REP_BAR(); }
#endif
#undef IN
#undef BOTH
}

extern "C" void kernel_launch(void* const* d_in, const int* in_sizes, int n_in, void* d_out, int out_size, void* d_ws, size_t ws_size, hipStream_t stream) {
    static int grid = 0;
    if (grid == 0) {
        if (n_in != 18 || in_sizes[0] != M * D || out_size != M * D || ws_size < WS_END) { fprintf(stderr, "kernel_launch: unexpected shapes (n_in %d, ws %zu)\n", n_in, ws_size); grid = -1; return; }
        int dev = 0, cus = 0, per_cu = 0;
        if (hipGetDevice(&dev) != hipSuccess || hipDeviceGetAttribute(&cus, hipDeviceAttributeMultiprocessorCount, dev) != hipSuccess) { grid = -1; return; }
        if (hipFuncSetAttribute((const void*)hyb_fwd, hipFuncAttributeMaxDynamicSharedMemorySize, LDS_BYTES) != hipSuccess) { fprintf(stderr, "kernel_launch: hipFuncSetAttribute failed\n"); grid = -1; return; }
        if (hipOccupancyMaxActiveBlocksPerMultiprocessor(&per_cu, (const void*)hyb_fwd, NWAVES * 64, LDS_BYTES) != hipSuccess || per_cu < 1) { fprintf(stderr, "kernel_launch: occupancy query says %d\n", per_cu); per_cu = 1; }
        (void)hipGetLastError();
        grid = cus;
    }
    if (grid < 0) return;
    Args a{};
    for (int i = 0; i < 18; ++i) a.in[i] = (const float*)d_in[i];
    a.out = (float*)d_out; a.ws = (unsigned char*)d_ws;
    (void)hipMemsetAsync((char*)d_ws + WS_CTL, 0, CTL_ZERO_BYTES, stream);
#if MK_FUSED
    a.ph_lo = 0; a.ph_hi = N_PHASES;
    void* kargs[] = {&a};
    hipError_t e = hipLaunchCooperativeKernel((const void*)hyb_fwd, dim3(grid), dim3(NWAVES * 64), kargs, LDS_BYTES, stream);
    if (e != hipSuccess) fprintf(stderr, "kernel_launch: cooperative launch failed: %s\n", hipGetErrorString(e));
#else
    for (int p = 0; p < N_PHASES; ++p) { a.ph_lo = p; a.ph_hi = p + 1; hipLaunchKernelGGL(hyb_fwd, dim3(grid), dim3(NWAVES * 64), LDS_BYTES, stream, a); }
#endif
}
```
